# Optimizing an MI355X kernel written in HIP

```python
import math
import jax, jax.numpy as jnp
from jax import lax
import numpy as np

D_MODEL = 1024
BATCH = 8
SEQ = 8192
DEPTH = 2

MIX_WIDTH = D_MODEL
CONV_CH = 512
CONV_WIDTH = 31
RET_HEADS = 4
RET_HEAD_DIM = 128
RET_WIDTH = RET_HEADS * RET_HEAD_DIM
RET_CHUNK = 128
ROPE_BASE = 10000.0
D_FF = 4 * D_MODEL
PLE_DIM = 256
IN_COLS = 2 * CONV_CH + 4 * RET_WIDTH
RMS_EPS = 1e-6
LN_EPS = 1e-5

kernel_name = "hybrid_conformer_conv_retention_block"


def rms_norm(x, g):
    xf = x.astype(jnp.float32)
    y = xf * lax.rsqrt(jnp.mean(xf * xf, axis=-1, keepdims=True) + RMS_EPS)
    return (y * g.astype(jnp.float32)).astype(x.dtype)


def layer_norm_f32(x, g, b):
    xf = x.astype(jnp.float32)
    mu = jnp.mean(xf, axis=-1, keepdims=True)
    var = jnp.mean(jnp.square(xf - mu), axis=-1, keepdims=True)
    return (xf - mu) * lax.rsqrt(var + LN_EPS) * g.astype(jnp.float32) + b.astype(jnp.float32)


def rotary(t, positions):
    half = t.shape[-1] // 2
    inv_freq = 1.0 / (ROPE_BASE ** (jnp.arange(0, half, dtype=jnp.float32) * (2.0 / t.shape[-1])))
    ang = positions.astype(jnp.float32)[..., None] * inv_freq
    cos = jnp.cos(ang)[:, :, None, :]
    sin = jnp.sin(ang)[:, :, None, :]
    t1, t2 = t[..., :half], t[..., half:]
    return jnp.concatenate([t1 * cos - t2 * sin, t2 * cos + t1 * sin], axis=-1)


def conv_module(u, dw_w, dw_b, ln_g, ln_b):
    a, b = jnp.split(u, 2, axis=-1)
    h = a * jax.nn.sigmoid(b)
    h = lax.conv_general_dilated(
        h, dw_w[:, None, :].astype(h.dtype), window_strides=(1,),
        padding=[(CONV_WIDTH - 1, 0)],
        dimension_numbers=('NWC', 'WIO', 'NWC'),
        feature_group_count=CONV_CH) + dw_b
    h = layer_norm_f32(h, ln_g, ln_b)
    return jax.nn.silu(h).astype(u.dtype)


def chunkwise_retention(q, k, v, positions):
    B, S = q.shape[0], q.shape[1]
    n_chunks = S // RET_CHUNK
    shp = (B, S, RET_HEADS, RET_HEAD_DIM)
    qf = rotary(q.astype(jnp.float32).reshape(shp), positions)
    kf = rotary(k.astype(jnp.float32).reshape(shp), positions) * (RET_HEAD_DIM ** -0.5)
    vf = v.astype(jnp.float32).reshape(shp)

    def to_chunks(t):
        return t.reshape(B, n_chunks, RET_CHUNK, RET_HEADS, RET_HEAD_DIM).transpose(1, 0, 3, 2, 4)

    qc, kc, vc = to_chunks(qf), to_chunks(kf), to_chunks(vf)

    log_g = jnp.log(1.0 - jnp.exp2(-5.0 - jnp.arange(RET_HEADS, dtype=jnp.float32)))
    idx = jnp.arange(RET_CHUNK, dtype=jnp.float32)
    diff = idx[:, None] - idx[None, :]
    decay_mask = jnp.where(diff[None] >= 0,
                           jnp.exp(jnp.maximum(diff, 0.0)[None] * log_g[:, None, None]), 0.0)
    zeta = jnp.exp((RET_CHUNK - 1 - idx)[None, :] * log_g[:, None])
    xi = jnp.exp((idx + 1.0)[None, :] * log_g[:, None])
    chunk_decay = jnp.exp(RET_CHUNK * log_g)

    def step(state, inp):
        qi, ki, vi = inp
        scores = jnp.einsum('bhqd,bhkd->bhqk', qi, ki) * decay_mask
        inner = jnp.einsum('bhqk,bhkd->bhqd', scores, vi)
        cross = jnp.einsum('bhqd,bhde->bhqe', qi, state) * xi[None, :, :, None]
        new_state = state * chunk_decay[None, :, None, None] + jnp.einsum(
            'bhkd,bhke->bhde', ki * zeta[None, :, :, None], vi)
        return new_state, inner + cross

    state0 = jnp.zeros((B, RET_HEADS, RET_HEAD_DIM, RET_HEAD_DIM), jnp.float32)
    _, out = lax.scan(step, state0, (qc, kc, vc))
    return out.transpose(1, 0, 3, 2, 4).reshape(shp)


def setup_inputs(seed: int = 0) -> dict:
    key = jax.random.key(seed)
    ks = jax.random.split(key, 20)
    f32 = jnp.float32

    def nrm(k, shape, scale):
        return jax.random.normal(k, shape, f32) * scale

    def gain(k, shape):
        return 1.0 + 0.02 * jax.random.normal(k, shape, f32)

    x = jax.random.normal(ks[0], (BATCH, SEQ, D_MODEL), f32)
    p = jax.random.normal(ks[1], (DEPTH, BATCH, SEQ, PLE_DIM), f32)
    positions = jnp.broadcast_to(jnp.arange(SEQ, dtype=jnp.int32)[None, :], (BATCH, SEQ))
    return {
        "x": x,
        "p": p,
        "positions": positions,
        "norm_mix_g": gain(ks[2], (DEPTH, D_MODEL)),
        "w_in": nrm(ks[3], (DEPTH, D_MODEL, IN_COLS), D_MODEL ** -0.5),
        "conv_dw_w": nrm(ks[4], (DEPTH, CONV_WIDTH, CONV_CH), CONV_WIDTH ** -0.5),
        "conv_dw_b": nrm(ks[5], (DEPTH, CONV_CH), 0.02),
        "conv_ln_g": gain(ks[6], (DEPTH, CONV_CH)),
        "conv_ln_b": nrm(ks[7], (DEPTH, CONV_CH), 0.02),
        "ret_gn_g": gain(ks[8], (DEPTH, RET_WIDTH)),
        "ret_gn_b": nrm(ks[9], (DEPTH, RET_WIDTH), 0.02),
        "w_out": nrm(ks[10], (DEPTH, MIX_WIDTH, D_MODEL), MIX_WIDTH ** -0.5),
        "norm_ffn_g": gain(ks[11], (DEPTH, D_MODEL)),
        "w_ff1": nrm(ks[12], (DEPTH, D_MODEL, D_FF), D_MODEL ** -0.5),
        "w_ff2": nrm(ks[13], (DEPTH, D_FF, D_MODEL), D_FF ** -0.5),
        "norm_ple_g": gain(ks[14], (DEPTH, D_MODEL)),
        "w_ple_gate": nrm(ks[15], (DEPTH, D_MODEL, D_MODEL), D_MODEL ** -0.5),
        "w_ple_proj": nrm(ks[16], (DEPTH, PLE_DIM, D_MODEL), PLE_DIM ** -0.5),
        "final_norm_g": gain(ks[17], (D_MODEL,)),
    }


def reference(x, p, positions, norm_mix_g, w_in, conv_dw_w, conv_dw_b, conv_ln_g, conv_ln_b,
              ret_gn_g, ret_gn_b, w_out, norm_ffn_g, w_ff1, w_ff2, norm_ple_g,
              w_ple_gate, w_ple_proj, final_norm_g):
    B, S = x.shape[0], x.shape[1]
    splits = [2 * CONV_CH, 2 * CONV_CH + RET_WIDTH, 2 * CONV_CH + 2 * RET_WIDTH,
              2 * CONV_CH + 3 * RET_WIDTH]
    for i in range(DEPTH):
        h = rms_norm(x, norm_mix_g[i])
        z = h @ w_in[i]
        u_conv, q, k, v, g = jnp.split(z, splits, axis=-1)
        conv_out = conv_module(u_conv, conv_dw_w[i], conv_dw_b[i], conv_ln_g[i], conv_ln_b[i])
        ret = chunkwise_retention(q, k, v, positions)
        mu = jnp.mean(ret, axis=-1, keepdims=True)
        var = jnp.mean(jnp.square(ret - mu), axis=-1, keepdims=True)
        ret = ((ret - mu) * lax.rsqrt(var + LN_EPS)).reshape(B, S, RET_WIDTH)
        ret = ret * ret_gn_g[i].astype(jnp.float32) + ret_gn_b[i].astype(jnp.float32)
        ret_out = (jax.nn.silu(g.astype(jnp.float32)) * ret).astype(x.dtype)
        mix = jnp.concatenate([conv_out, ret_out], axis=-1) @ w_out[i]
        x = x + mix
        h = rms_norm(x, norm_ffn_g[i])
        x = x + jnp.square(jax.nn.relu(h @ w_ff1[i])) @ w_ff2[i]
        h = rms_norm(x, norm_ple_g[i])
        x = x + jax.nn.sigmoid(h @ w_ple_gate[i]) * (p[i] @ w_ple_proj[i])
    return rms_norm(x, final_norm_g)
```

```cpp
#include <hip/hip_runtime.h>
#include <cstdio>
#include <cmath>

namespace {
constexpr int B_ = 8, S_ = 8192, D_ = 1024, DEPTH_ = 2, CCH = 512, CW = 31, RH = 4, RD = 128, RW = 512, RC = 128, FF = 4096, PLE = 256, INC = 3072;
constexpr float RMS_EPS = 1e-6f, LN_EPS = 1e-5f;

__device__ __forceinline__ float wave_sum(float v) {
#pragma unroll
    for (int o = 1; o < 64; o <<= 1) v += __shfl_xor(v, o);
    return v;
}
__device__ __forceinline__ float sigmoidf_(float x) { return 1.0f / (1.0f + expf(-x)); }

__global__ __launch_bounds__(256) void k_rmsnorm(const float* x, const float* g, float* out, int rows) {
    const int row = blockIdx.x * 4 + (threadIdx.x >> 6), lane = threadIdx.x & 63;
    if (row >= rows) return;
    const float4* xr = (const float4*)(x + (size_t)row * D_);
    float4 v[4]; float s = 0.f;
#pragma unroll
    for (int j = 0; j < 4; ++j) { v[j] = xr[lane + 64 * j]; s += v[j].x * v[j].x + v[j].y * v[j].y + v[j].z * v[j].z + v[j].w * v[j].w; }
    const float rstd = rsqrtf(wave_sum(s) * (1.0f / D_) + RMS_EPS);
    float4* orow = (float4*)(out + (size_t)row * D_);
#pragma unroll
    for (int j = 0; j < 4; ++j) { const float4 gg = ((const float4*)g)[lane + 64 * j]; float4 o; o.x = v[j].x * rstd * gg.x; o.y = v[j].y * rstd * gg.y; o.z = v[j].z * rstd * gg.z; o.w = v[j].w * rstd * gg.w; orow[lane + 64 * j] = o; }
}

__global__ __launch_bounds__(256) void k_gemm(const float* __restrict__ A, const float* __restrict__ W, float* __restrict__ C, int M, int N, int K) {
    __shared__ float As[8][132];
    __shared__ float Bs[8][132];
    const int t = threadIdx.x, tx = t & 15, ty = t >> 4;
    const int bm = blockIdx.y * 128, bn = blockIdx.x * 128;
    float acc[8][8];
#pragma unroll
    for (int i = 0; i < 8; ++i)
#pragma unroll
        for (int j = 0; j < 8; ++j) acc[i][j] = 0.f;
    const int ar = t >> 1, ak = (t & 1) * 4, br = t >> 5, bc = (t & 31) * 4;
    for (int k0 = 0; k0 < K; k0 += 8) {
        const float4 a = *(const float4*)(A + (size_t)(bm + ar) * K + k0 + ak);
        const float4 b = *(const float4*)(W + (size_t)(k0 + br) * N + bn + bc);
        As[ak + 0][ar] = a.x; As[ak + 1][ar] = a.y; As[ak + 2][ar] = a.z; As[ak + 3][ar] = a.w;
        *(float4*)&Bs[br][bc] = b;
        __syncthreads();
#pragma unroll
        for (int kk = 0; kk < 8; ++kk) {
            float av[8], bv[8];
            *(float4*)&av[0] = *(const float4*)&As[kk][ty * 8]; *(float4*)&av[4] = *(const float4*)&As[kk][ty * 8 + 4];
            *(float4*)&bv[0] = *(const float4*)&Bs[kk][tx * 8]; *(float4*)&bv[4] = *(const float4*)&Bs[kk][tx * 8 + 4];
#pragma unroll
            for (int i = 0; i < 8; ++i)
#pragma unroll
                for (int j = 0; j < 8; ++j) acc[i][j] += av[i] * bv[j];
        }
        __syncthreads();
    }
#pragma unroll
    for (int i = 0; i < 8; ++i) {
        float* cr = C + (size_t)(bm + ty * 8 + i) * N + bn + tx * 8;
        *(float4*)cr = make_float4(acc[i][0], acc[i][1], acc[i][2], acc[i][3]);
        *(float4*)(cr + 4) = make_float4(acc[i][4], acc[i][5], acc[i][6], acc[i][7]);
    }
}

__global__ void k_glu(const float* Z, float* H, int rows) {
    const size_t i = (size_t)blockIdx.x * blockDim.x + threadIdx.x;
    if (i >= (size_t)rows * CCH) return;
    const size_t t = i / CCH; const int c = (int)(i % CCH);
    H[i] = Z[t * INC + c] * sigmoidf_(Z[t * INC + CCH + c]);
}
__global__ __launch_bounds__(256) void k_conv_ln_silu(const float* H, const float* dw_w, const float* dw_b, const float* ln_g, const float* ln_b, float* MIX) {
    __shared__ float red[8];
    const int t = blockIdx.x, tid = threadIdx.x;
    float v[2];
#pragma unroll
    for (int u = 0; u < 2; ++u) {
        const int c = tid + 256 * u; float a = dw_b[c];
        for (int j = 0; j < CW; ++j) { const int tt = t - (CW - 1) + j; if (tt >= 0) a += dw_w[j * CCH + c] * H[(size_t)tt * CCH + c]; }
        v[u] = a;
    }
    float s = wave_sum(v[0] + v[1]);
    if ((tid & 63) == 0) red[tid >> 6] = s;
    __syncthreads();
    const float mean = (red[0] + red[1] + red[2] + red[3]) * (1.0f / CCH);
    const float d0 = v[0] - mean, d1 = v[1] - mean;
    float q = wave_sum(d0 * d0 + d1 * d1);
    if ((tid & 63) == 0) red[4 + (tid >> 6)] = q;
    __syncthreads();
    const float rstd = rsqrtf((red[4] + red[5] + red[6] + red[7]) * (1.0f / CCH) + LN_EPS);
#pragma unroll
    for (int u = 0; u < 2; ++u) { const int c = tid + 256 * u; const float y = (v[u] - mean) * rstd * ln_g[c] + ln_b[c]; MIX[(size_t)t * D_ + c] = y * sigmoidf_(y); }
}
__global__ void k_rope(const float* Z, const int* pos, float* Qr, float* Kr, int rows) {
    const size_t i = (size_t)blockIdx.x * blockDim.x + threadIdx.x;
    if (i >= (size_t)rows * RH * 64) return;
    const int d = (int)(i & 63), h = (int)((i >> 6) & 3); const size_t t = i >> 8;
    const float inv_freq = 1.0f / powf(10000.0f, (float)d * (2.0f / RD));
    const float ang = (float)pos[t] * inv_freq, c = cosf(ang), s = sinf(ang);
    const float* zq = Z + t * INC + 2 * CCH + h * RD; const float* zk = zq + RW;
    const float q1 = zq[d], q2 = zq[d + 64], k1 = zk[d], k2 = zk[d + 64];
    const float sc = 0.088388347648318447f;
    Qr[t * RW + h * RD + d] = q1 * c - q2 * s; Qr[t * RW + h * RD + d + 64] = q2 * c + q1 * s;
    Kr[t * RW + h * RD + d] = (k1 * c - k2 * s) * sc; Kr[t * RW + h * RD + d + 64] = (k2 * c + k1 * s) * sc;
}
__device__ __forceinline__ float log_gamma(int h) { return logf(1.0f - exp2f(-5.0f - (float)h)); }
__global__ __launch_bounds__(256) void k_ret_U(const float* Kr, const float* Z, float* U) {
    const int unit = blockIdx.x, c = unit >> 2, h = unit & 3, e = threadIdx.x & 127, d = blockIdx.y * 2 + (threadIdx.x >> 7);
    const float lg = log_gamma(h);
    float a = 0.f;
    for (int k = 0; k < RC; ++k) {
        const size_t t = (size_t)c * RC + k;
        a += expf((float)(RC - 1 - k) * lg) * Kr[t * RW + h * RD + d] * Z[t * INC + 2 * CCH + 2 * RW + h * RD + e];
    }
    U[((size_t)unit * RD + d) * RD + e] = a;
}
__global__ void k_ret_scan(const float* U, float* Sst) {
    const int i = blockIdx.x * blockDim.x + threadIdx.x;
    const int h = i >> 14, de = i & 16383;
    const float cd = expf((float)RC * log_gamma(h));
    float s = 0.f;
    for (int c = 0; c < S_ / RC; ++c) { const size_t o = ((size_t)(c * 4 + h) << 14) + de; Sst[o] = s; s = s * cd + U[o]; }
}
__global__ __launch_bounds__(256) void k_ret_out(const float* Qr, const float* Kr, const float* Z, const float* Sst, const float* gn_g, const float* gn_b, float* MIX) {
    extern __shared__ float P[];
    __shared__ float stat[128][2];
    const int unit = blockIdx.x, c = unit >> 2, h = unit & 3, tid = threadIdx.x;
    const float lg = log_gamma(h);
    const size_t t0 = (size_t)c * RC;
    {
        const int q = tid >> 1, kb = (tid & 1) * 64;
        const float* qp = Qr + (t0 + q) * RW + h * RD;
        for (int kk = 0; kk < 64; ++kk) { const int k = kb + kk; float dot = 0.f;
            if (k <= q) { const float* kp = Kr + (t0 + k) * RW + h * RD; for (int d = 0; d < RD; ++d) dot += qp[d] * kp[d]; dot *= expf((float)(q - k) * lg); }
            P[q * 129 + k] = dot; }
    }
    __syncthreads();
    const int e = tid & 127, qh = (tid >> 7) * 64;
    float acc[64];
#pragma unroll
    for (int i = 0; i < 64; ++i) acc[i] = 0.f;
    for (int d = 0; d < RD; ++d) {
        const float s = Sst[((size_t)unit * RD + d) * RD + e];
#pragma unroll
        for (int i = 0; i < 64; ++i) acc[i] += Qr[(t0 + qh + i) * RW + h * RD + d] * s;
    }
#pragma unroll
    for (int i = 0; i < 64; ++i) acc[i] *= expf((float)(qh + i + 1) * lg);
    for (int k = 0; k < RC; ++k) {
        const float v = Z[(t0 + k) * INC + 2 * CCH + 2 * RW + h * RD + e];
#pragma unroll
        for (int i = 0; i < 64; ++i) acc[i] += P[(qh + i) * 129 + k] * v;
    }
    __syncthreads();
#pragma unroll
    for (int i = 0; i < 64; ++i) P[(qh + i) * 129 + e] = acc[i];
    __syncthreads();
    if (tid < 128) { float s = 0.f; for (int j = 0; j < RD; ++j) s += P[tid * 129 + j]; const float mean = s * (1.0f / RD); float q2 = 0.f; for (int j = 0; j < RD; ++j) { const float dd = P[tid * 129 + j] - mean; q2 += dd * dd; }
        stat[tid][0] = mean; stat[tid][1] = rsqrtf(q2 * (1.0f / RD) + LN_EPS); }
    __syncthreads();
    const float gg = gn_g[h * RD + e], gb = gn_b[h * RD + e];
    for (int i = 0; i < 64; ++i) { const int q = qh + i; const float y = (P[q * 129 + e] - stat[q][0]) * stat[q][1] * gg + gb;
        const float g = Z[(t0 + q) * INC + 2 * CCH + 3 * RW + h * RD + e];
        MIX[(t0 + q) * D_ + CCH + h * RD + e] = g * sigmoidf_(g) * y; }
}
__global__ void k_add(float* x, const float* t, size_t n) { const size_t i = (size_t)blockIdx.x * blockDim.x + threadIdx.x; if (i < n) x[i] += t[i]; }
__global__ void k_relu2(float* x, size_t n) { const size_t i = (size_t)blockIdx.x * blockDim.x + threadIdx.x; if (i < n) { const float v = fmaxf(x[i], 0.f); x[i] = v * v; } }
__global__ void k_ple(float* x, const float* gate, const float* proj, size_t n) { const size_t i = (size_t)blockIdx.x * blockDim.x + threadIdx.x; if (i < n) x[i] += sigmoidf_(gate[i]) * proj[i]; }
}

extern "C" void kernel_launch(void* const* d_in, const int* in_sizes, int n_in, void* d_out, int out_size, void* d_ws, size_t ws_size, hipStream_t stream) {
    const float* x = (const float*)d_in[0]; const float* p = (const float*)d_in[1]; const int* pos = (const int*)d_in[2];
    const float* norm_mix_g = (const float*)d_in[3]; const float* w_in = (const float*)d_in[4]; const float* dw_w = (const float*)d_in[5]; const float* dw_b = (const float*)d_in[6];
    const float* ln_g = (const float*)d_in[7]; const float* ln_b = (const float*)d_in[8]; const float* gn_g = (const float*)d_in[9]; const float* gn_b = (const float*)d_in[10];
    const float* w_out = (const float*)d_in[11]; const float* norm_ffn_g = (const float*)d_in[12]; const float* w_ff1 = (const float*)d_in[13]; const float* w_ff2 = (const float*)d_in[14];
    const float* norm_ple_g = (const float*)d_in[15]; const float* w_gate = (const float*)d_in[16]; const float* w_proj = (const float*)d_in[17]; const float* final_g = (const float*)d_in[18];
    float* out = (float*)d_out;
    const size_t MiB = 1u << 20;
    if (ws_size < 512 * MiB) { fprintf(stderr, "ws too small: %zu\n", ws_size); return; }
    unsigned char* ws = (unsigned char*)d_ws;
    float* H = (float*)(ws + 0 * MiB);
    float* Z = (float*)(ws + 32 * MiB);
    float* CONVH = (float*)(ws + 128 * MiB);
    float* MIX = (float*)(ws + 144 * MiB);
    float* Qr = (float*)(ws + 176 * MiB);
    float* Kr = (float*)(ws + 192 * MiB);
    float* U = (float*)(ws + 208 * MiB);
    float* Sst = (float*)(ws + 224 * MiB);
    float* TMP = (float*)(ws + 240 * MiB);
    float* GATE = (float*)(ws + 272 * MiB);
    float* HID = (float*)(ws + 304 * MiB);
    static bool attr = false;
    if (!attr) { (void)hipFuncSetAttribute((const void*)k_ret_out, hipFuncAttributeMaxDynamicSharedMemorySize, 128 * 129 * 4); attr = true; }
    (void)hipMemcpyAsync(out, x, (size_t)B_ * S_ * D_ * 4, hipMemcpyDeviceToDevice, stream);
    const int R = S_;
    const size_t nx = (size_t)R * D_;
    for (int l = 0; l < DEPTH_; ++l) {
        for (int b = 0; b < B_; ++b) {
            float* xb = out + (size_t)b * nx;
            k_rmsnorm<<<R / 4, 256, 0, stream>>>(xb, norm_mix_g + l * D_, H, R);
            k_gemm<<<dim3(INC / 128, R / 128), 256, 0, stream>>>(H, w_in + (size_t)l * D_ * INC, Z, R, INC, D_);
            k_glu<<<(R * CCH) / 256, 256, 0, stream>>>(Z, CONVH, R);
            k_conv_ln_silu<<<R, 256, 0, stream>>>(CONVH, dw_w + l * CW * CCH, dw_b + l * CCH, ln_g + l * CCH, ln_b + l * CCH, MIX);
            k_rope<<<(R * RH * 64) / 256, 256, 0, stream>>>(Z, pos + (size_t)b * S_, Qr, Kr, R);
            k_ret_U<<<dim3(256, 64), 256, 0, stream>>>(Kr, Z, U);
            k_ret_scan<<<(4 * 16384) / 256, 256, 0, stream>>>(U, Sst);
            k_ret_out<<<256, 256, 128 * 129 * 4, stream>>>(Qr, Kr, Z, Sst, gn_g + l * RW, gn_b + l * RW, MIX);
            k_gemm<<<dim3(D_ / 128, R / 128), 256, 0, stream>>>(MIX, w_out + (size_t)l * D_ * D_, TMP, R, D_, D_);
            k_add<<<(unsigned)(nx / 256), 256, 0, stream>>>(xb, TMP, nx);
            k_rmsnorm<<<R / 4, 256, 0, stream>>>(xb, norm_ffn_g + l * D_, H, R);
            k_gemm<<<dim3(FF / 128, R / 128), 256, 0, stream>>>(H, w_ff1 + (size_t)l * D_ * FF, HID, R, FF, D_);
            k_relu2<<<(unsigned)((size_t)R * FF / 256), 256, 0, stream>>>(HID, (size_t)R * FF);
            k_gemm<<<dim3(D_ / 128, R / 128), 256, 0, stream>>>(HID, w_ff2 + (size_t)l * FF * D_, TMP, R, D_, FF);
            k_add<<<(unsigned)(nx / 256), 256, 0, stream>>>(xb, TMP, nx);
            k_rmsnorm<<<R / 4, 256, 0, stream>>>(xb, norm_ple_g + l * D_, H, R);
            k_gemm<<<dim3(D_ / 128, R / 128), 256, 0, stream>>>(H, w_gate + (size_t)l * D_ * D_, GATE, R, D_, D_);
            k_gemm<<<dim3(D_ / 128, R / 128), 256, 0, stream>>>(p + ((size_t)l * B_ + b) * S_ * PLE, w_proj + (size_t)l * PLE * D_, TMP, R, D_, PLE);
            k_ple<<<(unsigned)(nx / 256), 256, 0, stream>>>(xb, GATE, TMP, nx);
        }
    }
    k_rmsnorm<<<(B_ * S_) / 4, 256, 0, stream>>>(out, final_g, out, B_ * S_);
}
```

```cpp
#include <hip/hip_runtime.h>
#include <cstdio>
#include <cstdint>
namespace pg8 {
#define PG8_LAS __attribute__((address_space(3)))
typedef unsigned short bf16_t;
typedef short bf16x8 __attribute__((ext_vector_type(8)));
typedef float f32x4 __attribute__((ext_vector_type(4)));
typedef unsigned u32x4 __attribute__((ext_vector_type(4)));
typedef unsigned u32x2 __attribute__((ext_vector_type(2)));
constexpr int BM = 256, BK = 64, HALF = 128, HTB = HALF * BK * 2  , STAGE_BYTES = 8 * HTB, NXCD = 8, WGM = 8;

__host__ __device__ __forceinline__ int lds_byte(int r, int c) { const int st = (r >> 4) * 2 + (c >> 5), rr = r & 15, cc = c & 31, ob = rr * 64 + cc * 2; return st * 1024 + (ob ^ (((ob >> 9) & 1) << 5)); }
__host__ __device__ __forceinline__ void stage_rc(int b, int& R, int& C) { const int st = b / 1024, sb = b % 1024, swz = sb ^ (((sb >> 9) & 1) << 5); R = (st >> 1) * 16 + swz / 64; C = (st & 1) * 32 + (swz % 64) / 2; }
__host__ __device__ __forceinline__ int perm32(int rho) { const int n = rho >> 4, i = rho & 15; return 8 * (i >> 2) + 4 * n + (i & 3); }

struct Unit { int pm, pn; };
struct Gemm { const bf16_t* A; const bf16_t* Bt; int M, N, K; };

struct StaticOrder {
    int nM, nN, nwg, G, c;
    __host__ __device__ void init(int M, int N, int G_, int c_) { nM = M / BM; nN = N / BM; nwg = nM * nN; G = G_; c = c_; }
    __host__ __device__ bool next(int i, Unit& u) const {
        const long L = (long)i * G + c; if (L >= nwg) return false;
        int wgid = (int)L; { const int q = nwg / NXCD, r = nwg % NXCD, xcd = wgid % NXCD, off = wgid / NXCD; wgid = (xcd < r ? xcd * (q + 1) : r * (q + 1) + (xcd - r) * q) + off; }
        const int nig = WGM * nN, gid = wgid / nig, fm = gid * WGM, gsz = (nM - fm) < WGM ? (nM - fm) : WGM;
        u.pm = fm + ((wgid % nig) % gsz); u.pn = (wgid % nig) / gsz; return true;
    }
    __device__ __forceinline__ void a_ready(const Unit&) const {}
    __device__ __forceinline__ void done(const Unit&) const {}
};

__device__ __forceinline__ unsigned cvt_pk_bf16(float lo, float hi) { unsigned r; asm volatile("v_cvt_pk_bf16_f32 %0, %1, %2" : "=v"(r) : "v"(lo), "v"(hi)); return r; }
__device__ __forceinline__ u32x4 pack8(const f32x4 a, const f32x4 b) { u32x4 w; w.x = cvt_pk_bf16(a[0], a[1]); w.y = cvt_pk_bf16(a[2], a[3]); w.z = cvt_pk_bf16(b[0], b[1]); w.w = cvt_pk_bf16(b[2], b[3]); return w; }
__device__ __forceinline__ float fast_sigmoid(float x) { return __builtin_amdgcn_rcpf(1.0f + __expf(-x)); }
__device__ __forceinline__ f32x4 sig4(const f32x4 v) { return (f32x4){fast_sigmoid(v[0]), fast_sigmoid(v[1]), fast_sigmoid(v[2]), fast_sigmoid(v[3])}; }
constexpr int SSP = 16;
constexpr float RMS_EPS_ = 1e-6f;
__device__ __forceinline__ float rstd_of(const float* ss, int row) {
    const f32x4* p = (const f32x4*)(ss + (size_t)row * SSP); const f32x4 a = p[0], b = p[1], c = p[2], d = p[3];
    const f32x4 s = (a + b) + (c + d); return rsqrtf(((s[0] + s[1]) + (s[2] + s[3])) * (1.0f / 1024.0f) + RMS_EPS_);
}
typedef _Float16 f16x2 __attribute__((ext_vector_type(2)));

struct EpiInProj {
    static constexpr bool PERM = true, AFTER_DRAIN = false;
    bf16_t* ZB; const float* ss; const unsigned* rope;
    static constexpr int ZP = 2560;
    __device__ __forceinline__ void operator()(const f32x4 (&acc)[2][2][4][2], const Unit& u, int wr, int wc, int fr, int fq) const {
        const int row0 = u.pm * BM + wr * 64 + fr, pn = u.pn, lc = wc * 32 + 8 * fq;
        if (pn < 4) {
#pragma unroll
            for (int ai = 0; ai < 2; ++ai)
#pragma unroll
                for (int m = 0; m < 4; ++m) { const int row = row0 + ai * HALF + m * 16; const float rs = rstd_of(ss, row);
                    const f32x4 h0 = (acc[ai][0][m][0] * rs) * sig4(acc[ai][1][m][0] * rs), h1 = (acc[ai][0][m][1] * rs) * sig4(acc[ai][1][m][1] * rs);
                    *(u32x4*)(ZB + (size_t)row * ZP + pn * 128 + lc) = pack8(h0, h1); asm volatile("" ::: "memory"); }
        } else if (pn < 8) {
            const int head = 2 * (pn & 1) + (wc >> 1), d0 = lc & 63, colb = (pn < 6 ? 512 : 1024) + head * 128 + d0;
#pragma unroll
            for (int ai = 0; ai < 2; ++ai)
#pragma unroll
                for (int m = 0; m < 4; ++m) { const int row = row0 + ai * HALF + m * 16; const float rs = rstd_of(ss, row);
                    const u32x4* rp = (const u32x4*)(rope + (size_t)row * 64 + d0); const u32x4 r0 = rp[0], r1 = rp[1];
                    f32x4 o1[2], o2[2];
                    const unsigned rv[8] = {r0.x, r0.y, r0.z, r0.w, r1.x, r1.y, r1.z, r1.w};
#pragma unroll
                    for (int n = 0; n < 2; ++n) {
#pragma unroll
                        for (int i = 0; i < 4; ++i) { const f16x2 cs = __builtin_bit_cast(f16x2, rv[4 * n + i]); const float c = (float)cs[0], s = (float)cs[1];
                            const float t1 = acc[ai][0][m][n][i] * rs, t2 = acc[ai][1][m][n][i] * rs; o1[n][i] = t1 * c - t2 * s; o2[n][i] = t2 * c + t1 * s; } }
                    bf16_t* zp = ZB + (size_t)row * ZP + colb; *(u32x4*)zp = pack8(o1[0], o1[1]); *(u32x4*)(zp + 64) = pack8(o2[0], o2[1]); asm volatile("" ::: "memory"); }
        } else {
            const int colb = (pn < 10 ? 1536 + (pn - 8) * 256 : 2048 + (pn - 10) * 256) + lc; const bool act = pn >= 10;
#pragma unroll
            for (int ai = 0; ai < 2; ++ai)
#pragma unroll
                for (int m = 0; m < 4; ++m) { const int row = row0 + ai * HALF + m * 16; const float rs = rstd_of(ss, row);
#pragma unroll
                    for (int bj = 0; bj < 2; ++bj) { f32x4 v0 = acc[ai][bj][m][0] * rs, v1 = acc[ai][bj][m][1] * rs;
                        if (act) { v0 = v0 * sig4(v0); v1 = v1 * sig4(v1); }
                        *(u32x4*)(ZB + (size_t)row * ZP + colb + bj * HALF) = pack8(v0, v1); } asm volatile("" ::: "memory"); }
        }
    }
};
template <int MODE> struct EpiResid {
    static constexpr bool PERM = true, AFTER_DRAIN = false;
    const float* base; float* XF; bf16_t* XB; float* ss_out; const float* ss_in; const bf16_t* proj;
    __device__ __forceinline__ void operator()(const f32x4 (&acc)[2][2][4][2], const Unit& u, int wr, int wc, int fr, int fq) const {
        const int row0 = u.pm * BM + wr * 64 + fr, col0 = u.pn * BM + wc * 32 + 8 * fq;
#pragma unroll
        for (int ai = 0; ai < 2; ++ai)
#pragma unroll
            for (int m = 0; m < 4; ++m) { const int row = row0 + ai * HALF + m * 16; const size_t off = (size_t)row * 1024 + col0; float q = 0.f;
                float rs = 1.f; if (MODE == 1) rs = rstd_of(ss_in, row);
#pragma unroll
                for (int bj = 0; bj < 2; ++bj) { const f32x4 b0 = *(const f32x4*)(base + off + bj * HALF), b1 = *(const f32x4*)(base + off + bj * HALF + 4);
                    f32x4 v0, v1;
                    if (MODE == 1) { const u32x4 pw = *(const u32x4*)(proj + off + bj * HALF);
                        const f32x4 p0 = (f32x4){__uint_as_float(pw.x << 16), __uint_as_float(pw.x & 0xffff0000u), __uint_as_float(pw.y << 16), __uint_as_float(pw.y & 0xffff0000u)};
                        const f32x4 p1 = (f32x4){__uint_as_float(pw.z << 16), __uint_as_float(pw.z & 0xffff0000u), __uint_as_float(pw.w << 16), __uint_as_float(pw.w & 0xffff0000u)};
                        v0 = b0 + sig4(acc[ai][bj][m][0] * rs) * p0; v1 = b1 + sig4(acc[ai][bj][m][1] * rs) * p1; }
                    else { v0 = b0 + acc[ai][bj][m][0]; v1 = b1 + acc[ai][bj][m][1]; }
                    *(f32x4*)(XF + off + bj * HALF) = v0; *(f32x4*)(XF + off + bj * HALF + 4) = v1;
                    *(u32x4*)(XB + off + bj * HALF) = pack8(v0, v1);
                    q += (v0[0] * v0[0] + v0[1] * v0[1]) + (v0[2] * v0[2] + v0[3] * v0[3]) + (v1[0] * v1[0] + v1[1] * v1[1]) + (v1[2] * v1[2] + v1[3] * v1[3]); }
                q += __shfl_xor(q, 16); q += __shfl_xor(q, 32);
                if (fq == 0) ss_out[(size_t)row * SSP + u.pn * 4 + wc] = q; asm volatile("" ::: "memory"); }
    }
};
struct EpiFF1 {
    static constexpr bool PERM = true, AFTER_DRAIN = false;
    bf16_t* H; const float* ss;
    __device__ __forceinline__ void operator()(const f32x4 (&acc)[2][2][4][2], const Unit& u, int wr, int wc, int fr, int fq) const {
        const int row0 = u.pm * BM + wr * 64 + fr, col0 = u.pn * BM + wc * 32 + 8 * fq;
#pragma unroll
        for (int ai = 0; ai < 2; ++ai)
#pragma unroll
            for (int m = 0; m < 4; ++m) { const int row = row0 + ai * HALF + m * 16; const float rs = rstd_of(ss, row);
#pragma unroll
                for (int bj = 0; bj < 2; ++bj) { f32x4 v0 = acc[ai][bj][m][0] * rs, v1 = acc[ai][bj][m][1] * rs;
                    v0 = __builtin_elementwise_max(v0, (f32x4){0.f, 0.f, 0.f, 0.f}); v1 = __builtin_elementwise_max(v1, (f32x4){0.f, 0.f, 0.f, 0.f}); v0 = v0 * v0; v1 = v1 * v1;
                    *(u32x4*)(H + (size_t)row * 4096 + col0 + bj * HALF) = pack8(v0, v1); } asm volatile("" ::: "memory"); }
    }
};
struct EpiPlain {
    static constexpr bool PERM = true, AFTER_DRAIN = false;
    bf16_t* O;
    __device__ __forceinline__ void operator()(const f32x4 (&acc)[2][2][4][2], const Unit& u, int wr, int wc, int fr, int fq) const {
        const int row0 = u.pm * BM + wr * 64 + fr, col0 = u.pn * BM + wc * 32 + 8 * fq;
#pragma unroll
        for (int ai = 0; ai < 2; ++ai)
#pragma unroll
            for (int m = 0; m < 4; ++m) { const int row = row0 + ai * HALF + m * 16;
#pragma unroll
                for (int bj = 0; bj < 2; ++bj) *(u32x4*)(O + (size_t)row * 1024 + col0 + bj * HALF) = pack8(acc[ai][bj][m][0], acc[ai][bj][m][1]); }
    }
};

template <class Epi, class Sched, bool ALIGN_EPI = false, bool SP2 = false>
__device__ __forceinline__ void gemm_phase(PG8_LAS unsigned char* lds, const Gemm g, const Sched& S, const Epi& E, const int wave_id) {
    unsigned z_ = 0u; asm volatile("" : "+v"(z_)); const int tid_ = wave_id * 64 + (int)__builtin_amdgcn_mbcnt_hi(~0u, __builtin_amdgcn_mbcnt_lo(~0u, z_));
    const int tid = tid_, wid = wave_id, lane = tid & 63, wr = wid >> 2, wc = wid & 3, fr = lane & 15, fq = lane >> 4;
    const int K = g.K, nt = K / BK;
    unsigned voffA[2], voffB[2];
#pragma unroll
    for (int i = 0; i < 2; ++i) { int R, C; stage_rc(tid * 16 + i * 8192, R, C); const int Rb = Epi::PERM ? ((R & ~31) + perm32(R & 31)) : R;
        voffA[i] = (unsigned)(R * K + C) * 2u; voffB[i] = (unsigned)(Rb * K + C) * 2u; }
    const size_t kstep = (size_t)(BK * 2);
    const size_t hstep = (size_t)HALF * K * 2;
    const size_t tstep = 2 * hstep;
    const unsigned ldsw = (unsigned)wid * 1024u;
    const int aoff = lds_byte(wr * 64 + fr, fq * 8), boff = lds_byte(wc * 32 + fr, fq * 8);
#define PG8_SA(b, h) (((b) * 2 + (h)) * HTB)
#define PG8_SB(b, h) ((4 + (b) * 2 + (h)) * HTB)
#define PG8_STAGE(bufoff, gbase, voff) do { _Pragma("unroll") for (int _i = 0; _i < 2; ++_i) \
        __builtin_amdgcn_global_load_lds((const unsigned*)((const char*)(gbase) + (voff)[_i]), (PG8_LAS unsigned*)(lds + (bufoff) + ldsw + _i * 8192), 16, 0, 0); } while (0)
#define PG8_LDA(dst, b, h) do { _Pragma("unroll") for (int m = 0; m < 4; ++m) _Pragma("unroll") for (int k = 0; k < 2; ++k) dst[m][k] = *(const PG8_LAS bf16x8*)(lds + PG8_SA(b, h) + aoff + m * 2048 + k * 1024); } while (0)
#define PG8_LDB(dst, b, h) do { _Pragma("unroll") for (int n = 0; n < 2; ++n) _Pragma("unroll") for (int k = 0; k < 2; ++k) dst[n][k] = *(const PG8_LAS bf16x8*)(lds + PG8_SB(b, h) + boff + n * 2048 + k * 1024); } while (0)
#define PG8_MMA(ai, bj, At, Bt) do { __builtin_amdgcn_s_setprio(1); _Pragma("unroll") for (int m = 0; m < 4; ++m) _Pragma("unroll") for (int n = 0; n < 2; ++n) _Pragma("unroll") for (int k = 0; k < 2; ++k) \
        acc[ai][bj][m][n] = __builtin_amdgcn_mfma_f32_16x16x32_bf16(Bt[n][k], At[m][k], acc[ai][bj][m][n], 0, 0, 0); __builtin_amdgcn_s_setprio(0); } while (0)
#define PG8_WAIT_V(n) asm volatile("s_waitcnt vmcnt(" #n ")" ::: "memory")
#define PG8_WAIT_L(n) asm volatile("s_waitcnt lgkmcnt(" #n ")" ::: "memory")
#define PG8_BAR __builtin_amdgcn_s_barrier()
#define PG8_SCHED __builtin_amdgcn_sched_barrier(0)
    Unit cur, nxt; int ui = 0;
    if (!S.next(0, cur)) return;
    f32x4 acc[2][2][4][2];
#pragma unroll
    for (int a = 0; a < 2; ++a)
#pragma unroll
        for (int b = 0; b < 2; ++b)
#pragma unroll
            for (int m = 0; m < 4; ++m)
#pragma unroll
                for (int n = 0; n < 2; ++n) acc[a][b][m][n] = (f32x4){0.f, 0.f, 0.f, 0.f};
    bf16x8 At[4][2], B0[2][2], B1[2][2];
    const char* cA = (const char*)g.A + (size_t)cur.pm * tstep; const char* cB = (const char*)g.Bt + (size_t)cur.pn * tstep;
    S.a_ready(cur);
    if constexpr (SP2) {
        PG8_STAGE(PG8_SB(0, 0), cB, voffB); PG8_STAGE(PG8_SB(0, 1), cB + hstep, voffB); PG8_STAGE(PG8_SA(0, 0), cA, voffA); PG8_STAGE(PG8_SA(0, 1), cA + hstep, voffA);
        if (wr == 1) PG8_BAR;
        PG8_WAIT_V(2); PG8_BAR;
        PG8_STAGE(PG8_SB(1, 0), cB + kstep, voffB); PG8_STAGE(PG8_SA(1, 0), cA + kstep, voffA); PG8_STAGE(PG8_SB(1, 1), cB + hstep + kstep, voffB);
        PG8_WAIT_V(6); PG8_BAR;
    } else {
        PG8_STAGE(PG8_SB(0, 0), cB, voffB); PG8_STAGE(PG8_SA(0, 0), cA, voffA); PG8_STAGE(PG8_SB(0, 1), cB + hstep, voffB); PG8_STAGE(PG8_SA(0, 1), cA + hstep, voffA);
        if (wr == 1) PG8_BAR;
        PG8_WAIT_V(4); PG8_BAR;
        PG8_STAGE(PG8_SB(1, 0), cB + kstep, voffB); PG8_STAGE(PG8_SA(1, 0), cA + kstep, voffA); PG8_STAGE(PG8_SB(1, 1), cB + hstep + kstep, voffB);
        PG8_WAIT_V(6); PG8_BAR;
    }
    for (;;) {
        const bool has_next = S.next(ui + 1, nxt);
        const char* nA = has_next ? (const char*)g.A + (size_t)nxt.pm * tstep : cA; const char* nB = has_next ? (const char*)g.Bt + (size_t)nxt.pn * tstep : cB;
        for (int t = 0; t < nt; t += 2) {
            const bool last = (t == nt - 2);
            const char* a1 = cA + (size_t)(t + 1) * kstep;
            const char* a2 = last ? nA : cA + (size_t)(t + 2) * kstep; const char* b2 = last ? nB : cB + (size_t)(t + 2) * kstep;
            const char* a3 = a2 + kstep; const char* b3 = b2 + kstep;
            if (last && has_next) S.a_ready(nxt);
            if constexpr (SP2) {
            PG8_LDB(B0, 0, 0); PG8_LDB(B1, 0, 1); PG8_SCHED; PG8_LDA(At, 0, 0); PG8_STAGE(PG8_SA(1, 1), a1 + hstep, voffA);
            PG8_WAIT_V(8); PG8_WAIT_L(0); PG8_BAR; PG8_MMA(0, 0, At, B0); PG8_MMA(0, 1, At, B1); PG8_BAR; PG8_SCHED;
            PG8_LDA(At, 0, 1); PG8_STAGE(PG8_SB(0, 0), b2, voffB); PG8_STAGE(PG8_SB(0, 1), b2 + hstep, voffB); PG8_STAGE(PG8_SA(0, 0), a2, voffA);
            PG8_WAIT_V(8); PG8_WAIT_L(0); PG8_BAR; PG8_MMA(1, 0, At, B0); PG8_MMA(1, 1, At, B1); PG8_BAR; PG8_SCHED;
            PG8_LDB(B0, 1, 0); PG8_LDB(B1, 1, 1); PG8_SCHED; PG8_LDA(At, 1, 0); PG8_STAGE(PG8_SA(0, 1), a2 + hstep, voffA);
            PG8_WAIT_V(8); PG8_WAIT_L(0); PG8_BAR; PG8_MMA(0, 0, At, B0); PG8_MMA(0, 1, At, B1); PG8_BAR; PG8_SCHED;
            PG8_LDA(At, 1, 1); PG8_STAGE(PG8_SB(1, 0), b3, voffB); PG8_STAGE(PG8_SB(1, 1), b3 + hstep, voffB); PG8_STAGE(PG8_SA(1, 0), a3, voffA);
            PG8_WAIT_V(8); PG8_WAIT_L(0); PG8_BAR; PG8_MMA(1, 0, At, B0); PG8_MMA(1, 1, At, B1); PG8_BAR; PG8_SCHED;
            } else {
            PG8_LDB(B0, 0, 0); PG8_SCHED; PG8_LDA(At, 0, 0); PG8_STAGE(PG8_SA(1, 1), a1 + hstep, voffA);
            PG8_WAIT_L(8); PG8_BAR; PG8_WAIT_L(0); PG8_MMA(0, 0, At, B0); PG8_BAR; PG8_SCHED;
            PG8_LDB(B1, 0, 1); PG8_STAGE(PG8_SB(0, 0), b2, voffB);
            PG8_BAR; PG8_WAIT_L(0); PG8_MMA(0, 1, At, B1); PG8_BAR;
            PG8_LDA(At, 0, 1); PG8_STAGE(PG8_SA(0, 0), a2, voffA);
            PG8_BAR; PG8_WAIT_L(0); PG8_MMA(1, 0, At, B0); PG8_BAR; PG8_SCHED;
            PG8_STAGE(PG8_SB(0, 1), b2 + hstep, voffB);
            PG8_WAIT_V(6); PG8_BAR; PG8_MMA(1, 1, At, B1); PG8_BAR;
            PG8_LDB(B0, 1, 0); PG8_SCHED; PG8_LDA(At, 1, 0); PG8_STAGE(PG8_SA(0, 1), a2 + hstep, voffA);
            PG8_WAIT_L(8); PG8_BAR; PG8_WAIT_L(0); PG8_MMA(0, 0, At, B0); PG8_BAR; PG8_SCHED;
            PG8_LDB(B1, 1, 1); PG8_STAGE(PG8_SB(1, 0), b3, voffB);
            PG8_BAR; PG8_WAIT_L(0); PG8_MMA(0, 1, At, B1); PG8_BAR;
            PG8_LDA(At, 1, 1); PG8_STAGE(PG8_SA(1, 0), a3, voffA);
            PG8_BAR; PG8_WAIT_L(0); PG8_MMA(1, 0, At, B0); PG8_BAR; PG8_SCHED;
            PG8_STAGE(PG8_SB(1, 1), b3 + hstep, voffB);
            PG8_WAIT_V(6); PG8_BAR; PG8_MMA(1, 1, At, B1); PG8_BAR;
            }
        }
        if constexpr (ALIGN_EPI) { if (wr == 0) PG8_BAR; }
        if constexpr (!Epi::AFTER_DRAIN) { E(acc, cur, wr, wc, fr, fq); S.done(cur); }
        if (!has_next) break;
#pragma unroll
        for (int a = 0; a < 2; ++a)
#pragma unroll
            for (int b = 0; b < 2; ++b)
#pragma unroll
                for (int m = 0; m < 4; ++m)
#pragma unroll
                    for (int n = 0; n < 2; ++n) acc[a][b][m][n] = (f32x4){0.f, 0.f, 0.f, 0.f};
        cur = nxt; cA = nA; cB = nB; ++ui;
        if constexpr (ALIGN_EPI) { if (wr == 1) PG8_BAR; }
    }
    PG8_WAIT_V(0);
    if constexpr (!ALIGN_EPI) { if (wr == 0) PG8_BAR; }
    PG8_BAR;
    if constexpr (Epi::AFTER_DRAIN) { E.fused(acc, cur, wr, wc, fr, fq, lds, wid, lane); S.done(cur); }
#undef PG8_SA
#undef PG8_SB
#undef PG8_STAGE
#undef PG8_LDA
#undef PG8_LDB
#undef PG8_MMA
#undef PG8_WAIT_V
#undef PG8_WAIT_L
#undef PG8_BAR
#undef PG8_SCHED
}
}

constexpr int NWAVES = 8;
constexpr int NB = 8, SEQ = 8192, D = 1024, DEPTH = 2, CCH = 512, CONVW = 31, RH = 4, RD = 128, RW = 512, RC = 128, FF = 4096, PLE = 256, INC = 3072;
constexpr int M = NB * SEQ;
constexpr int ZP = 2560;
constexpr float LN_EPS = 1e-5f;
constexpr size_t MiB = 1u << 20;
constexpr size_t WS_CTL = 0, CTL_ZERO_BYTES = 1 * MiB;
constexpr size_t WS_W = 2 * MiB, W_LAYER = 27 * MiB;
constexpr size_t WO_IN = 0, WO_OUT = 6 * MiB, WO_FF1 = 8 * MiB, WO_FF2 = 16 * MiB, WO_GATE = 24 * MiB, WO_PROJ = 26 * MiB;
constexpr size_t WS_SS = 56 * MiB, SS_SITE = 4 * MiB;
constexpr size_t WS_ROPE = 84 * MiB;
constexpr size_t WS_XB = 100 * MiB;
constexpr size_t WS_PB = 228 * MiB;
constexpr size_t WS_PROJ = 292 * MiB;
constexpr size_t WS_ZB = 420 * MiB;
constexpr size_t WS_T = 740 * MiB;
constexpr size_t WS_MIX = 756 * MiB;
constexpr size_t WS_HID = 420 * MiB;
constexpr size_t WS_END = 932 * MiB;
constexpr size_t WS_U = WS_XB, WS_S = WS_PROJ;
constexpr int CW_TMO = 0, CW_BAR = 4096;
constexpr int LDS_BYTES = 163840, RING_OFF = 0, MISC_OFF = 163840 - 256;

#define GAS __attribute__((address_space(1)))
#define LAS __attribute__((address_space(3)))
typedef unsigned short bf16;
typedef unsigned v4u __attribute__((ext_vector_type(4)));
typedef float f32x4 __attribute__((ext_vector_type(4)));
typedef GAS unsigned gu32;
#define RLX_AGENT __ATOMIC_RELAXED, __HIP_MEMORY_SCOPE_AGENT
#define LDS_WAIT() asm volatile("s_waitcnt lgkmcnt(0)" ::: "memory")
__device__ __forceinline__ unsigned f2bf(float f) { unsigned u = __builtin_bit_cast(unsigned, f); return (u + 0x7fffu + ((u >> 16) & 1u)) >> 16; }
__device__ __forceinline__ unsigned pk2(float lo, float hi) { return f2bf(lo) | (f2bf(hi) << 16); }
__device__ __forceinline__ float bf2f(unsigned short b) { return __uint_as_float(((unsigned)b) << 16); }

#define XB_TMO      128
#define XB_XCNT(j)  (256  + 64 * (j))
#define XB_XSUB(j)  (1280 + 64 * (j))
#define XB_XGEN(j)  (2304 + 64 * (j))
#define XB_TOP      3328
#define XB_TOPGEN   3392
#define XCD_BAR_WORDS 3456
#define XB_SPIN_CAP (1u << 18)

__device__ __forceinline__ unsigned xb_ld(unsigned* p)              { return __hip_atomic_load(p, __ATOMIC_RELAXED, __HIP_MEMORY_SCOPE_AGENT); }
__device__ __forceinline__ unsigned xb_add(unsigned* p, unsigned v) { return __hip_atomic_fetch_add(p, v, __ATOMIC_RELAXED, __HIP_MEMORY_SCOPE_AGENT); }
__device__ __forceinline__ unsigned xb_xcc_id() { return (unsigned)__builtin_amdgcn_s_getreg((3 << 11) | 20) & 0xFu; }
#define XB_SPIN(cond, bar) do { unsigned _sp = 0; while (cond) { __builtin_amdgcn_s_sleep(1); \
    if ((++_sp & 255u) == 0u) { if (xb_ld(&(bar)[XB_TMO])) break; if (_sp > XB_SPIN_CAP) { atomicAdd(&(bar)[XB_TMO], 1u); break; } } } } while (0)

__device__ __forceinline__ int xb_fresh_lane() { unsigned z = 0u; asm volatile("" : "+v"(z)); return (int)__builtin_amdgcn_mbcnt_hi(~0u, __builtin_amdgcn_mbcnt_lo(~0u, z)); }
struct XcdBarrier {
    unsigned* bar; unsigned x; int wave;
    volatile LAS unsigned* st;
};

__device__ __forceinline__ XcdBarrier xcd_barrier_post(unsigned* bar, volatile LAS unsigned* st, int wave) {
    XcdBarrier b; b.bar = bar; b.x = xb_xcc_id(); b.st = st; b.wave = wave;
    if (wave == 0 && xb_fresh_lane() == 0) (void)xb_add(&bar[XB_XCNT(b.x)], 1u);
    return b;
}
__device__ __forceinline__ void xcd_barrier_complete(unsigned* bar, unsigned x, unsigned& nloc, unsigned& nx) {
    const unsigned G = gridDim.x * gridDim.y * gridDim.z;
    unsigned sum, cnt, mine, sp = 0u;
    for (;;) {
        sum = 0u; cnt = 0u; mine = 0u;
#pragma unroll
        for (unsigned j = 0; j < 16; ++j) { const unsigned c = xb_ld(&bar[XB_XCNT(j)]); sum += c; cnt += (c > 0u) ? 1u : 0u; mine = (j == x) ? c : mine; }
        if (sum == G) break;
        __builtin_amdgcn_s_sleep(1);
        if ((++sp & 255u) == 0u) { if (xb_ld(&bar[XB_TMO])) break; if (sp > XB_SPIN_CAP) { atomicAdd(&bar[XB_TMO], 1u); break; } }
    }
    nloc = mine > 0u ? mine : 1u; nx = cnt > 0u ? cnt : 1u;
}

__device__ __forceinline__ void xcd_barrier(const XcdBarrier& b) {
    asm volatile("s_waitcnt vmcnt(0)" ::: "memory");
    __syncthreads();
    if (b.wave == 0 && xb_fresh_lane() == 0) {
        unsigned* bar = b.bar;
        __builtin_amdgcn_s_waitcnt(0);
        unsigned nloc = b.st[0], nx = b.st[1];
        if (nloc == 0u) { xcd_barrier_complete(bar, b.x, nloc, nx); b.st[0] = nloc; b.st[1] = nx; }
        const unsigned old = xb_add(&bar[XB_XSUB(b.x)], 1u);
        const unsigned gen = old / nloc;
        if (old + 1u == (gen + 1u) * nloc) {
            __builtin_amdgcn_fence(__ATOMIC_RELEASE, "agent");
            asm volatile("s_waitcnt vmcnt(0)" ::: "memory");
            const unsigned og = xb_add(&bar[XB_TOP], 1u);
            const unsigned tg = og / nx;
            if (og + 1u == (tg + 1u) * nx) xb_add(&bar[XB_TOPGEN], 1u);
            else XB_SPIN(xb_ld(&bar[XB_TOPGEN]) == tg, bar);
            __builtin_amdgcn_fence(__ATOMIC_ACQUIRE, "agent");
            xb_add(&bar[XB_XGEN(b.x)], 1u);
            asm volatile("s_waitcnt vmcnt(0)" ::: "memory");
        } else {
            XB_SPIN(xb_ld(&bar[XB_XGEN(b.x)]) == gen, bar);
            __builtin_amdgcn_fence(__ATOMIC_ACQUIRE, "agent");
            asm volatile("s_waitcnt vmcnt(0)" ::: "memory");
        }
    }
    __syncthreads();
}

struct Args {
    const float* x; const float* p; const int* pos; const float* norm_mix_g; const float* w_in; const float* dw_w; const float* dw_b; const float* ln_g; const float* ln_b;
    const float* gn_g; const float* gn_b; const float* w_out; const float* norm_ffn_g; const float* w_ff1; const float* w_ff2; const float* norm_ple_g; const float* w_gate; const float* w_proj;
    const float* final_g; float* out; unsigned char* ws; int ph_lo, ph_hi, li, pad;
};
__device__ __forceinline__ float wave_sum(float v) {
#pragma unroll
    for (int o = 1; o < 64; o <<= 1) v += __shfl_xor(v, o);
    return v;
}
__device__ __forceinline__ int inmap(int s) {
    if (s < 512) return 256 * (s >> 7) + (s & 127);
    if (s < 1024) { const int ch = s - 512; return 256 * (ch >> 7) + 128 + (ch & 127); }
    if (s < 2048) { const int k = s >= 1536, r = s - (k ? 1536 : 1024), hq = r >> 7, dd = r & 127; return 256 * ((k ? 6 : 4) + (hq >> 1)) + 128 * (dd >> 6) + 64 * (hq & 1) + (dd & 63); }
    return s;
}
template <bool INMAP> __device__ __forceinline__ void tr_item(const float* W, int K, int N, const float* gain, bf16* WT, LAS float* scr, int item, int lane) {
    const int nblk = N / 32, kb = item / nblk, nb = item % nblk, k0 = 64 * kb, n0 = 32 * nb;
#pragma unroll 8
    for (int i = 0; i < 32; ++i) { const int kk = 2 * i + (lane >> 5); scr[kk * 33 + (lane & 31)] = W[(size_t)(k0 + kk) * N + n0 + (lane & 31)] * (gain ? gain[k0 + kk] : 1.0f); }
    LDS_WAIT(); asm volatile("" ::: "memory");
    const int c = lane & 7;
#pragma unroll
    for (int j = 0; j < 4; ++j) { const int n = (lane >> 3) + 8 * j; const LAS float* s = scr + (8 * c) * 33 + n;
        const int src = n0 + n; const int r = INMAP ? inmap(src) : src; const float cs = (INMAP && src >= 1536 && src < 2048) ? 0.088388347648318447f : 1.0f;
        v4u o; o.x = pk2(s[0 * 33] * cs, s[1 * 33] * cs); o.y = pk2(s[2 * 33] * cs, s[3 * 33] * cs); o.z = pk2(s[4 * 33] * cs, s[5 * 33] * cs); o.w = pk2(s[6 * 33] * cs, s[7 * 33] * cs);
        *(GAS v4u*)(WT + (size_t)r * K + k0 + 8 * c) = o; }
    LDS_WAIT(); asm volatile("" ::: "memory");
}

__global__ void __launch_bounds__(NWAVES * 64, 2) mk_fwd(Args a) {
    extern __shared__ __attribute__((aligned(16))) unsigned char lds[];
    LAS unsigned char* const L = (LAS unsigned char*)lds;
    volatile LAS unsigned* MISC = (volatile LAS unsigned*)(L + MISC_OFF);
    const int wave = __builtin_amdgcn_readfirstlane(threadIdx.x >> 6);
#define LANE_ID() xb_fresh_lane()
    const int G = gridDim.x, bx = blockIdx.x;
    unsigned char* ws = a.ws;
    gu32* ctl = (gu32*)(ws + WS_CTL);
    if (threadIdx.x < 64) MISC[threadIdx.x] = 0u;
    __syncthreads();
    XcdBarrier bar = xcd_barrier_post((unsigned*)(ctl + CW_BAR) + a.li * XCD_BAR_WORDS, MISC + 8, wave);
    const int lo = a.ph_lo, hi = a.ph_hi;
#define IN(k) (lo <= (k) && (k) < hi)
#define SEAM(k) do { if (IN(k) && IN((k) + 1)) xcd_barrier(bar); } while (0)
    const int gw = bx * NWAVES + wave, NGW = G * NWAVES;
    const size_t NGT = (size_t)G * NWAVES * 64;
    bf16* const XB = (bf16*)(ws + WS_XB); bf16* const ZB = (bf16*)(ws + WS_ZB); bf16* const MIXB = (bf16*)(ws + WS_MIX); bf16* const HID = (bf16*)(ws + WS_HID);
    bf16* const XBN = (bf16*)(ws + WS_MIX);
    bf16* const PROJ = (bf16*)(ws + WS_PROJ); bf16* const PB = (bf16*)(ws + WS_PB); unsigned* const ROPE = (unsigned*)(ws + WS_ROPE);

    if (IN(0)) {
        const int lane = LANE_ID(); const size_t gt = (size_t)bx * (NWAVES * 64) + wave * 64 + lane;
        LAS float* scr = (LAS float*)(L + RING_OFF + wave * 16384);
        constexpr int I_IN = (D / 64) * (INC / 32), I_OUT = (D / 64) * (D / 32), I_F1 = (D / 64) * (FF / 32), I_F2 = (FF / 64) * (D / 32), I_G = I_OUT, I_P = (PLE / 64) * (D / 32);
        constexpr int I_LAYER = I_IN + I_OUT + I_F1 + I_F2 + I_G + I_P;
        for (int it = gw; it < DEPTH * I_LAYER; it += NGW) {
            const int l = it / I_LAYER; int r = it % I_LAYER; unsigned char* wl = ws + WS_W + (size_t)l * W_LAYER;
            if (r < I_IN) { tr_item<true>(a.w_in + (size_t)l * D * INC, D, INC, a.norm_mix_g + l * D, (bf16*)(wl + WO_IN), scr, r, lane); continue; } r -= I_IN;
            if (r < I_OUT) { tr_item<false>(a.w_out + (size_t)l * D * D, D, D, nullptr, (bf16*)(wl + WO_OUT), scr, r, lane); continue; } r -= I_OUT;
            if (r < I_F1) { tr_item<false>(a.w_ff1 + (size_t)l * D * FF, D, FF, a.norm_ffn_g + l * D, (bf16*)(wl + WO_FF1), scr, r, lane); continue; } r -= I_F1;
            if (r < I_F2) { tr_item<false>(a.w_ff2 + (size_t)l * FF * D, FF, D, nullptr, (bf16*)(wl + WO_FF2), scr, r, lane); continue; } r -= I_F2;
            if (r < I_G) { tr_item<false>(a.w_gate + (size_t)l * D * D, D, D, a.norm_ple_g + l * D, (bf16*)(wl + WO_GATE), scr, r, lane); continue; } r -= I_G;
            tr_item<false>(a.w_proj + (size_t)l * PLE * D, PLE, D, nullptr, (bf16*)(wl + WO_PROJ), scr, r, lane);
        }
        float* ss0 = (float*)(ws + WS_SS);
        for (int m = gw; m < M; m += NGW) {
            const GAS f32x4* xr = (const GAS f32x4*)(a.x + (size_t)m * D) + lane; f32x4 v[4]; float s = 0.f;
#pragma unroll
            for (int j = 0; j < 4; ++j) { v[j] = xr[64 * j]; s += (v[j].x * v[j].x + v[j].y * v[j].y) + (v[j].z * v[j].z + v[j].w * v[j].w); }
            s = wave_sum(s);
            GAS unsigned long long* o8 = (GAS unsigned long long*)(XB + (size_t)m * D) + lane;
#pragma unroll
            for (int j = 0; j < 4; ++j) o8[64 * j] = (unsigned long long)pk2(v[j].x, v[j].y) | ((unsigned long long)pk2(v[j].z, v[j].w) << 32);
            if (lane < 16) ss0[(size_t)m * 16 + lane] = lane == 0 ? s : 0.f;
        }
        for (size_t i = gt; i < (size_t)DEPTH * M * PLE / 8; i += NGT) {
            const f32x4 p0 = *(const GAS f32x4*)(a.p + i * 8), p1 = *(const GAS f32x4*)(a.p + i * 8 + 4);
            v4u o; o.x = pk2(p0.x, p0.y); o.y = pk2(p0.z, p0.w); o.z = pk2(p1.x, p1.y); o.w = pk2(p1.z, p1.w);
            *(GAS v4u*)(PB + i * 8) = o;
        }
        for (size_t i = gt; i < (size_t)M * 64; i += NGT) {
            const int d = (int)(i & 63); const size_t m = i >> 6;
            const float inv_freq = 1.0f / powf(10000.0f, (float)d * (2.0f / RD)), ang = (float)a.pos[m] * inv_freq;
            const pg8::f16x2 cs = {(_Float16)cosf(ang), (_Float16)sinf(ang)};
            ROPE[i] = __builtin_bit_cast(unsigned, cs);
        }
    }
    SEAM(0);
#pragma clang loop unroll(full)
    for (int l = 0; l < DEPTH; ++l) {
        const int pb = 1 + 8 * l;
        unsigned char* wl = ws + WS_W + (size_t)l * W_LAYER;
        float* const ss_a = (float*)(ws + WS_SS + (size_t)(3 * l + 0) * SS_SITE);
        float* const ss_b = (float*)(ws + WS_SS + (size_t)(3 * l + 1) * SS_SITE);
        float* const ss_c = (float*)(ws + WS_SS + (size_t)(3 * l + 2) * SS_SITE);
        float* const ss_d = (float*)(ws + WS_SS + (size_t)(3 * l + 3) * SS_SITE);
        if (IN(pb + 0)) {
            pg8::Gemm g{l == 0 ? XB : XBN, (const bf16*)(wl + WO_IN), M, INC, D}; pg8::StaticOrder S; S.init(M, INC, G, bx);
            pg8::EpiInProj E{ZB, ss_a, ROPE};
            pg8::gemm_phase<pg8::EpiInProj, pg8::StaticOrder, true, true>(L + RING_OFF, g, S, E, wave);
        }
        SEAM(pb + 0);
        SEAM(pb + 1);
        SEAM(pb + 2);
        if (IN(pb + 3)) {
            pg8::Gemm g{MIXB, (const bf16*)(wl + WO_OUT), M, D, D}; pg8::StaticOrder S; S.init(M, D, G, bx);
            pg8::EpiResid<0> E{l == 0 ? a.x : a.out, a.out, XB, ss_b, nullptr, nullptr};
            pg8::gemm_phase<pg8::EpiResid<0>, pg8::StaticOrder, true, true>(L + RING_OFF, g, S, E, wave);
        }
        SEAM(pb + 3);
        if (IN(pb + 4)) {
            pg8::Gemm g{XB, (const bf16*)(wl + WO_FF1), M, FF, D}; pg8::StaticOrder S; S.init(M, FF, G, bx);
            pg8::EpiFF1 E{HID, ss_b};
            pg8::gemm_phase<pg8::EpiFF1, pg8::StaticOrder, true, true>(L + RING_OFF, g, S, E, wave);
        }
        SEAM(pb + 4);
        if (IN(pb + 5)) {
            pg8::Gemm g{HID, (const bf16*)(wl + WO_FF2), M, D, FF}; pg8::StaticOrder S; S.init(M, D, G, bx);
            pg8::EpiResid<0> E{a.out, a.out, XB, ss_c, nullptr, nullptr};
            pg8::gemm_phase<pg8::EpiResid<0>, pg8::StaticOrder, true, true>(L + RING_OFF, g, S, E, wave);
        }
        SEAM(pb + 5);
        if (IN(pb + 6)) {
            pg8::Gemm g{PB + (size_t)l * M * PLE, (const bf16*)(wl + WO_PROJ), M, D, PLE}; pg8::StaticOrder S; S.init(M, D, G, bx);
            pg8::EpiPlain E{PROJ};
            pg8::gemm_phase<pg8::EpiPlain, pg8::StaticOrder, true, true>(L + RING_OFF, g, S, E, wave);
        }
        SEAM(pb + 6);
        if (IN(pb + 7)) {
            pg8::Gemm g{XB, (const bf16*)(wl + WO_GATE), M, D, D}; pg8::StaticOrder S; S.init(M, D, G, bx);
            pg8::EpiResid<1> E{a.out, a.out, XBN, ss_d, ss_c, PROJ};
            pg8::gemm_phase<pg8::EpiResid<1>, pg8::StaticOrder, true, true>(L + RING_OFF, g, S, E, wave);
        }
        SEAM(pb + 7);
    }
    if (IN(17)) {
        const int lane = LANE_ID();
        const float* ssf = (const float*)(ws + WS_SS + (size_t)6 * SS_SITE);
        for (int m = gw; m < M; m += NGW) {
            const float rs = pg8::rstd_of(ssf, m);
            GAS f32x4* xr = (GAS f32x4*)(a.out + (size_t)m * D) + lane; const GAS f32x4* gr = (const GAS f32x4*)a.final_g + lane;
#pragma unroll
            for (int j = 0; j < 4; ++j) { const f32x4 v = xr[64 * j], gg = gr[64 * j]; xr[64 * j] = v * rs * gg; }
        }
    }
#undef IN
#undef SEAM
}

namespace nv {
__device__ __forceinline__ float sigm(float x) { return 1.0f / (1.0f + expf(-x)); }
__device__ __forceinline__ float log_gamma(int h) { return logf(1.0f - exp2f(-5.0f - (float)h)); }
__global__ __launch_bounds__(256) void k_conv(const bf16* ZB, const float* dw_w, const float* dw_b, const float* ln_g, const float* ln_b, bf16* MIX) {
    __shared__ float red[8];
    const int m = blockIdx.x, t = m % SEQ, tid = threadIdx.x;
    float v[2];
#pragma unroll
    for (int u = 0; u < 2; ++u) {
        const int c = tid + 256 * u; float acc = dw_b[c];
        for (int j = 0; j < CONVW; ++j) { const int tt = t - (CONVW - 1) + j; if (tt >= 0) acc += dw_w[j * CCH + c] * bf2f(ZB[(size_t)(m - (CONVW - 1) + j) * ZP + c]); }
        v[u] = acc;
    }
    float s = wave_sum(v[0] + v[1]);
    if ((tid & 63) == 0) red[tid >> 6] = s;
    __syncthreads();
    const float mean = (red[0] + red[1] + red[2] + red[3]) * (1.0f / CCH);
    const float d0 = v[0] - mean, d1 = v[1] - mean;
    float q = wave_sum(d0 * d0 + d1 * d1);
    if ((tid & 63) == 0) red[4 + (tid >> 6)] = q;
    __syncthreads();
    const float rstd = rsqrtf((red[4] + red[5] + red[6] + red[7]) * (1.0f / CCH) + LN_EPS);
#pragma unroll
    for (int u = 0; u < 2; ++u) { const int c = tid + 256 * u; const float y = (v[u] - mean) * rstd * ln_g[c] + ln_b[c]; MIX[(size_t)m * D + c] = (bf16)f2bf(y * sigm(y)); }
}
__global__ __launch_bounds__(256) void k_ret_U(const bf16* ZB, float* U) {
    const int unit = blockIdx.x, h = unit & 3, bc = unit >> 2, e = threadIdx.x & 127, d = blockIdx.y * 2 + (threadIdx.x >> 7);
    const float lg = log_gamma(h); const size_t m0 = (size_t)bc * RC;
    float acc = 0.f;
    for (int k = 0; k < RC; ++k) { const bf16* zr = ZB + (m0 + k) * ZP; acc += expf((float)(RC - 1 - k) * lg) * bf2f(zr[1024 + h * RD + d]) * bf2f(zr[1536 + h * RD + e]); }
    U[((size_t)unit * RD + d) * RD + e] = acc;
}
__global__ void k_ret_scan(const float* U, float* S) {
    const int i = blockIdx.x * blockDim.x + threadIdx.x;
    const int de = i & 16383, h = (i >> 14) & 3, b = i >> 16;
    const float cd = expf((float)RC * log_gamma(h));
    float s = 0.f;
    for (int c = 0; c < SEQ / RC; ++c) { const size_t o = ((size_t)((b * 64 + c) * 4 + h) << 14) + de; S[o] = s; s = s * cd + U[o]; }
}
__global__ __launch_bounds__(256) void k_ret_out(const bf16* ZB, const float* S, const float* gn_g, const float* gn_b, bf16* MIX) {
    extern __shared__ float P[];
    __shared__ float stat[128][2];
    const int unit = blockIdx.x, h = unit & 3, bc = unit >> 2, tid = threadIdx.x;
    const float lg = log_gamma(h);
    const size_t m0 = (size_t)bc * RC;
    {
        const int q = tid >> 1, kb = (tid & 1) * 64;
        const bf16* qp = ZB + (m0 + q) * ZP + 512 + h * RD;
        for (int kk = 0; kk < 64; ++kk) { const int k = kb + kk; float dot = 0.f;
            if (k <= q) { const bf16* kp = ZB + (m0 + k) * ZP + 1024 + h * RD; for (int d = 0; d < RD; ++d) dot += bf2f(qp[d]) * bf2f(kp[d]); dot *= expf((float)(q - k) * lg); }
            P[q * 129 + k] = dot; }
    }
    __syncthreads();
    const int e = tid & 127, qh = (tid >> 7) * 64;
    float acc[64];
#pragma unroll
    for (int i = 0; i < 64; ++i) acc[i] = 0.f;
    for (int d = 0; d < RD; ++d) {
        const float s = S[((size_t)unit * RD + d) * RD + e];
#pragma unroll
        for (int i = 0; i < 64; ++i) acc[i] += bf2f(ZB[(m0 + qh + i) * ZP + 512 + h * RD + d]) * s;
    }
#pragma unroll
    for (int i = 0; i < 64; ++i) acc[i] *= expf((float)(qh + i + 1) * lg);
    for (int k = 0; k < RC; ++k) {
        const float v = bf2f(ZB[(m0 + k) * ZP + 1536 + h * RD + e]);
#pragma unroll
        for (int i = 0; i < 64; ++i) acc[i] += P[(qh + i) * 129 + k] * v;
    }
    __syncthreads();
#pragma unroll
    for (int i = 0; i < 64; ++i) P[(qh + i) * 129 + e] = acc[i];
    __syncthreads();
    if (tid < 128) { float s = 0.f; for (int j = 0; j < RD; ++j) s += P[tid * 129 + j]; const float mean = s * (1.0f / RD); float q2 = 0.f; for (int j = 0; j < RD; ++j) { const float dd = P[tid * 129 + j] - mean; q2 += dd * dd; }
        stat[tid][0] = mean; stat[tid][1] = rsqrtf(q2 * (1.0f / RD) + LN_EPS); }
    __syncthreads();
    const float gg = gn_g[h * RD + e], gb = gn_b[h * RD + e];
    for (int i = 0; i < 64; ++i) { const int q = qh + i; const float y = (P[q * 129 + e] - stat[q][0]) * stat[q][1] * gg + gb;
        MIX[(m0 + q) * D + CCH + h * RD + e] = (bf16)f2bf(bf2f(ZB[(m0 + q) * ZP + 2048 + h * RD + e]) * y); }
}
}

extern "C" void kernel_launch(void* const* d_in, const int* in_sizes, int n_in, void* d_out, int out_size, void* d_ws, size_t ws_size, hipStream_t stream) {
    static int grid = 0;
    if (grid == 0) {
        if (n_in != 19 || out_size != M * D || ws_size < WS_END) { fprintf(stderr, "kernel_launch: unexpected problem (n_in %d, out %d, ws %zu < %zu); nothing launched\n", n_in, out_size, ws_size, (size_t)WS_END); grid = -1; return; }
        int dev = 0, cus = 0;
        if (hipGetDevice(&dev) != hipSuccess || hipDeviceGetAttribute(&cus, hipDeviceAttributeMultiprocessorCount, dev) != hipSuccess) { grid = -1; return; }
        if (hipFuncSetAttribute((const void*)mk_fwd, hipFuncAttributeMaxDynamicSharedMemorySize, LDS_BYTES) != hipSuccess) { fprintf(stderr, "kernel_launch: hipFuncSetAttribute failed\n"); grid = -1; return; }
        (void)hipFuncSetAttribute((const void*)nv::k_ret_out, hipFuncAttributeMaxDynamicSharedMemorySize, 128 * 129 * 4);
        int per_cu = 0;
        if (hipOccupancyMaxActiveBlocksPerMultiprocessor(&per_cu, (const void*)mk_fwd, NWAVES * 64, LDS_BYTES) != hipSuccess || per_cu < 1) fprintf(stderr, "kernel_launch: occupancy query says %d\n", per_cu);
        (void)hipGetLastError();
        grid = cus;
    }
    if (grid < 0) return;
    (void)hipMemsetAsync((char*)d_ws + WS_CTL, 0, CTL_ZERO_BYTES, stream);
    Args a{};
    a.x = (const float*)d_in[0]; a.p = (const float*)d_in[1]; a.pos = (const int*)d_in[2]; a.norm_mix_g = (const float*)d_in[3]; a.w_in = (const float*)d_in[4]; a.dw_w = (const float*)d_in[5];
    a.dw_b = (const float*)d_in[6]; a.ln_g = (const float*)d_in[7]; a.ln_b = (const float*)d_in[8]; a.gn_g = (const float*)d_in[9]; a.gn_b = (const float*)d_in[10]; a.w_out = (const float*)d_in[11];
    a.norm_ffn_g = (const float*)d_in[12]; a.w_ff1 = (const float*)d_in[13]; a.w_ff2 = (const float*)d_in[14]; a.norm_ple_g = (const float*)d_in[15]; a.w_gate = (const float*)d_in[16];
    a.w_proj = (const float*)d_in[17]; a.final_g = (const float*)d_in[18]; a.out = (float*)d_out; a.ws = (unsigned char*)d_ws;
    unsigned char* ws = (unsigned char*)d_ws;
    const bf16* ZB = (const bf16*)(ws + WS_ZB); bf16* MIXB = (bf16*)(ws + WS_MIX); float* U = (float*)(ws + WS_U); float* S = (float*)(ws + WS_S);
    const int cuts[4] = {0, 2, 10, 18};
    for (int li = 0; li < 3; ++li) {
        a.ph_lo = cuts[li]; a.ph_hi = cuts[li + 1]; a.li = li;
        hipLaunchKernelGGL(mk_fwd, dim3(grid), dim3(NWAVES * 64), LDS_BYTES, stream, a);
        if (li < 2) {
            const int l = li;
            hipLaunchKernelGGL(nv::k_conv, dim3(M), dim3(256), 0, stream, ZB, a.dw_w + l * CONVW * CCH, a.dw_b + l * CCH, a.ln_g + l * CCH, a.ln_b + l * CCH, MIXB);
            hipLaunchKernelGGL(nv::k_ret_U, dim3(NB * 64 * 4, 64), dim3(256), 0, stream, ZB, U);
            hipLaunchKernelGGL(nv::k_ret_scan, dim3(NB * 4 * 16384 / 256), dim3(256), 0, stream, (const float*)U, S);
            hipLaunchKernelGGL(nv::k_ret_out, dim3(NB * 64 * 4), dim3(256), 128 * 129 * 4, stream, ZB, (const float*)S, a.gn_g + l * RW, a.gn_b + l * RW, MIXB);
        }
    }
}
```

```cpp
#include <hip/hip_runtime.h>
#include <cstdio>
#include <cstdint>
namespace pg8 {
#define PG8_LAS __attribute__((address_space(3)))
typedef unsigned short bf16_t;
typedef short bf16x8 __attribute__((ext_vector_type(8)));
typedef float f32x4 __attribute__((ext_vector_type(4)));
typedef unsigned u32x4 __attribute__((ext_vector_type(4)));
typedef unsigned u32x2 __attribute__((ext_vector_type(2)));
constexpr int BM = 256, BK = 64, HALF = 128, HTB = HALF * BK * 2  , STAGE_BYTES = 8 * HTB, NXCD = 8, WGM = 8;

__host__ __device__ __forceinline__ int lds_byte(int r, int c) { const int st = (r >> 4) * 2 + (c >> 5), rr = r & 15, cc = c & 31, ob = rr * 64 + cc * 2; return st * 1024 + (ob ^ (((ob >> 9) & 1) << 5)); }
__host__ __device__ __forceinline__ void stage_rc(int b, int& R, int& C) { const int st = b / 1024, sb = b % 1024, swz = sb ^ (((sb >> 9) & 1) << 5); R = (st >> 1) * 16 + swz / 64; C = (st & 1) * 32 + (swz % 64) / 2; }
__host__ __device__ __forceinline__ int perm32(int rho) { const int n = rho >> 4, i = rho & 15; return 8 * (i >> 2) + 4 * n + (i & 3); }

struct Unit { int pm, pn; };
struct Gemm { const bf16_t* A; const bf16_t* Bt; int M, N, K; };

struct StaticOrder {
    int nM, nN, nwg, G, c;
    __host__ __device__ void init(int M, int N, int G_, int c_) { nM = M / BM; nN = N / BM; nwg = nM * nN; G = G_; c = c_; }
    __host__ __device__ bool next(int i, Unit& u) const {
        const long L = (long)i * G + c; if (L >= nwg) return false;
        int wgid = (int)L; { const int q = nwg / NXCD, r = nwg % NXCD, xcd = wgid % NXCD, off = wgid / NXCD; wgid = (xcd < r ? xcd * (q + 1) : r * (q + 1) + (xcd - r) * q) + off; }
        const int nig = WGM * nN, gid = wgid / nig, fm = gid * WGM, gsz = (nM - fm) < WGM ? (nM - fm) : WGM;
        u.pm = fm + ((wgid % nig) % gsz); u.pn = (wgid % nig) / gsz; return true;
    }
    __device__ __forceinline__ void a_ready(const Unit&) const {}
    __device__ __forceinline__ void done(const Unit&) const {}
};

__device__ __forceinline__ unsigned cvt_pk_bf16(float lo, float hi) { unsigned r; asm volatile("v_cvt_pk_bf16_f32 %0, %1, %2" : "=v"(r) : "v"(lo), "v"(hi)); return r; }
__device__ __forceinline__ u32x4 pack8(const f32x4 a, const f32x4 b) { u32x4 w; w.x = cvt_pk_bf16(a[0], a[1]); w.y = cvt_pk_bf16(a[2], a[3]); w.z = cvt_pk_bf16(b[0], b[1]); w.w = cvt_pk_bf16(b[2], b[3]); return w; }
__device__ __forceinline__ float fast_sigmoid(float x) { return __builtin_amdgcn_rcpf(1.0f + __expf(-x)); }
__device__ __forceinline__ f32x4 sig4(const f32x4 v) { return (f32x4){fast_sigmoid(v[0]), fast_sigmoid(v[1]), fast_sigmoid(v[2]), fast_sigmoid(v[3])}; }
constexpr int SSP = 16;
constexpr float RMS_EPS_ = 1e-6f;
__device__ __forceinline__ float rstd_of(const float* ss, int row) {
    const f32x4* p = (const f32x4*)(ss + (size_t)row * SSP); const f32x4 a = p[0], b = p[1], c = p[2], d = p[3];
    const f32x4 s = (a + b) + (c + d); return rsqrtf(((s[0] + s[1]) + (s[2] + s[3])) * (1.0f / 1024.0f) + RMS_EPS_);
}
typedef _Float16 f16x2 __attribute__((ext_vector_type(2)));

struct EpiInProj {
    static constexpr bool PERM = true, AFTER_DRAIN = false;
    bf16_t* ZB; const float* ss; const unsigned* rope;
    static constexpr int ZP = 2560;
    __device__ __forceinline__ void operator()(const f32x4 (&acc)[2][2][4][2], const Unit& u, int wr, int wc, int fr, int fq) const {
        const int row0 = u.pm * BM + wr * 64 + fr, pn = u.pn, lc = wc * 32 + 8 * fq;
        if (pn < 4) {
#pragma unroll
            for (int ai = 0; ai < 2; ++ai)
#pragma unroll
                for (int m = 0; m < 4; ++m) { const int row = row0 + ai * HALF + m * 16; const float rs = rstd_of(ss, row);
                    const f32x4 h0 = (acc[ai][0][m][0] * rs) * sig4(acc[ai][1][m][0] * rs), h1 = (acc[ai][0][m][1] * rs) * sig4(acc[ai][1][m][1] * rs);
                    *(u32x4*)(ZB + (size_t)row * ZP + pn * 128 + lc) = pack8(h0, h1); asm volatile("" ::: "memory"); }
        } else if (pn < 8) {
            const int head = 2 * (pn & 1) + (wc >> 1), d0 = lc & 63, colb = (pn < 6 ? 512 : 1024) + head * 128 + d0;
#pragma unroll
            for (int ai = 0; ai < 2; ++ai)
#pragma unroll
                for (int m = 0; m < 4; ++m) { const int row = row0 + ai * HALF + m * 16; const float rs = rstd_of(ss, row);
                    const u32x4* rp = (const u32x4*)(rope + (size_t)row * 64 + d0); const u32x4 r0 = rp[0], r1 = rp[1];
                    f32x4 o1[2], o2[2];
                    const unsigned rv[8] = {r0.x, r0.y, r0.z, r0.w, r1.x, r1.y, r1.z, r1.w};
#pragma unroll
                    for (int n = 0; n < 2; ++n) {
#pragma unroll
                        for (int i = 0; i < 4; ++i) { const f16x2 cs = __builtin_bit_cast(f16x2, rv[4 * n + i]); const float c = (float)cs[0], s = (float)cs[1];
                            const float t1 = acc[ai][0][m][n][i] * rs, t2 = acc[ai][1][m][n][i] * rs; o1[n][i] = t1 * c - t2 * s; o2[n][i] = t2 * c + t1 * s; } }
                    bf16_t* zp = ZB + (size_t)row * ZP + colb; *(u32x4*)zp = pack8(o1[0], o1[1]); *(u32x4*)(zp + 64) = pack8(o2[0], o2[1]); asm volatile("" ::: "memory"); }
        } else {
            const int colb = (pn < 10 ? 1536 + (pn - 8) * 256 : 2048 + (pn - 10) * 256) + lc; const bool act = pn >= 10;
#pragma unroll
            for (int ai = 0; ai < 2; ++ai)
#pragma unroll
                for (int m = 0; m < 4; ++m) { const int row = row0 + ai * HALF + m * 16; const float rs = rstd_of(ss, row);
#pragma unroll
                    for (int bj = 0; bj < 2; ++bj) { f32x4 v0 = acc[ai][bj][m][0] * rs, v1 = acc[ai][bj][m][1] * rs;
                        if (act) { v0 = v0 * sig4(v0); v1 = v1 * sig4(v1); }
                        *(u32x4*)(ZB + (size_t)row * ZP + colb + bj * HALF) = pack8(v0, v1); } asm volatile("" ::: "memory"); }
        }
    }
};
template <int MODE> struct EpiResid {
    static constexpr bool PERM = true, AFTER_DRAIN = false;
    const float* base; float* XF; bf16_t* XB; float* ss_out; const float* ss_in; const bf16_t* proj;
    __device__ __forceinline__ void operator()(const f32x4 (&acc)[2][2][4][2], const Unit& u, int wr, int wc, int fr, int fq) const {
        const int row0 = u.pm * BM + wr * 64 + fr, col0 = u.pn * BM + wc * 32 + 8 * fq;
#pragma unroll
        for (int ai = 0; ai < 2; ++ai)
#pragma unroll
            for (int m = 0; m < 4; ++m) { const int row = row0 + ai * HALF + m * 16; const size_t off = (size_t)row * 1024 + col0; float q = 0.f;
                float rs = 1.f; if (MODE == 1) rs = rstd_of(ss_in, row);
#pragma unroll
                for (int bj = 0; bj < 2; ++bj) { const f32x4 b0 = *(const f32x4*)(base + off + bj * HALF), b1 = *(const f32x4*)(base + off + bj * HALF + 4);
                    f32x4 v0, v1;
                    if (MODE == 1) { const u32x4 pw = *(const u32x4*)(proj + off + bj * HALF);
                        const f32x4 p0 = (f32x4){__uint_as_float(pw.x << 16), __uint_as_float(pw.x & 0xffff0000u), __uint_as_float(pw.y << 16), __uint_as_float(pw.y & 0xffff0000u)};
                        const f32x4 p1 = (f32x4){__uint_as_float(pw.z << 16), __uint_as_float(pw.z & 0xffff0000u), __uint_as_float(pw.w << 16), __uint_as_float(pw.w & 0xffff0000u)};
                        v0 = b0 + sig4(acc[ai][bj][m][0] * rs) * p0; v1 = b1 + sig4(acc[ai][bj][m][1] * rs) * p1; }
                    else { v0 = b0 + acc[ai][bj][m][0]; v1 = b1 + acc[ai][bj][m][1]; }
                    *(f32x4*)(XF + off + bj * HALF) = v0; *(f32x4*)(XF + off + bj * HALF + 4) = v1;
                    *(u32x4*)(XB + off + bj * HALF) = pack8(v0, v1);
                    q += (v0[0] * v0[0] + v0[1] * v0[1]) + (v0[2] * v0[2] + v0[3] * v0[3]) + (v1[0] * v1[0] + v1[1] * v1[1]) + (v1[2] * v1[2] + v1[3] * v1[3]); }
                q += __shfl_xor(q, 16); q += __shfl_xor(q, 32);
                if (fq == 0) ss_out[(size_t)row * SSP + u.pn * 4 + wc] = q; asm volatile("" ::: "memory"); }
    }
};
struct EpiFF1 {
    static constexpr bool PERM = true, AFTER_DRAIN = false;
    bf16_t* H; const float* ss;
    __device__ __forceinline__ void operator()(const f32x4 (&acc)[2][2][4][2], const Unit& u, int wr, int wc, int fr, int fq) const {
        const int row0 = u.pm * BM + wr * 64 + fr, col0 = u.pn * BM + wc * 32 + 8 * fq;
#pragma unroll
        for (int ai = 0; ai < 2; ++ai)
#pragma unroll
            for (int m = 0; m < 4; ++m) { const int row = row0 + ai * HALF + m * 16; const float rs = rstd_of(ss, row);
#pragma unroll
                for (int bj = 0; bj < 2; ++bj) { f32x4 v0 = acc[ai][bj][m][0] * rs, v1 = acc[ai][bj][m][1] * rs;
                    v0 = __builtin_elementwise_max(v0, (f32x4){0.f, 0.f, 0.f, 0.f}); v1 = __builtin_elementwise_max(v1, (f32x4){0.f, 0.f, 0.f, 0.f}); v0 = v0 * v0; v1 = v1 * v1;
                    *(u32x4*)(H + (size_t)row * 4096 + col0 + bj * HALF) = pack8(v0, v1); } asm volatile("" ::: "memory"); }
    }
};
struct EpiPlain {
    static constexpr bool PERM = true, AFTER_DRAIN = false;
    bf16_t* O;
    __device__ __forceinline__ void operator()(const f32x4 (&acc)[2][2][4][2], const Unit& u, int wr, int wc, int fr, int fq) const {
        const int row0 = u.pm * BM + wr * 64 + fr, col0 = u.pn * BM + wc * 32 + 8 * fq;
#pragma unroll
        for (int ai = 0; ai < 2; ++ai)
#pragma unroll
            for (int m = 0; m < 4; ++m) { const int row = row0 + ai * HALF + m * 16;
#pragma unroll
                for (int bj = 0; bj < 2; ++bj) *(u32x4*)(O + (size_t)row * 1024 + col0 + bj * HALF) = pack8(acc[ai][bj][m][0], acc[ai][bj][m][1]); }
    }
};

template <class Epi, class Sched, bool ALIGN_EPI = false, bool SP2 = false>
__device__ __forceinline__ void gemm_phase(PG8_LAS unsigned char* lds, const Gemm g, const Sched& S, const Epi& E, const int wave_id) {
    unsigned z_ = 0u; asm volatile("" : "+v"(z_)); const int tid_ = wave_id * 64 + (int)__builtin_amdgcn_mbcnt_hi(~0u, __builtin_amdgcn_mbcnt_lo(~0u, z_));
    const int tid = tid_, wid = wave_id, lane = tid & 63, wr = wid >> 2, wc = wid & 3, fr = lane & 15, fq = lane >> 4;
    const int K = g.K, nt = K / BK;
    unsigned voffA[2], voffB[2];
#pragma unroll
    for (int i = 0; i < 2; ++i) { int R, C; stage_rc(tid * 16 + i * 8192, R, C); const int Rb = Epi::PERM ? ((R & ~31) + perm32(R & 31)) : R;
        voffA[i] = (unsigned)(R * K + C) * 2u; voffB[i] = (unsigned)(Rb * K + C) * 2u; }
    const size_t kstep = (size_t)(BK * 2);
    const size_t hstep = (size_t)HALF * K * 2;
    const size_t tstep = 2 * hstep;
    const unsigned ldsw = (unsigned)wid * 1024u;
    const int aoff = lds_byte(wr * 64 + fr, fq * 8), boff = lds_byte(wc * 32 + fr, fq * 8);
#define PG8_SA(b, h) (((b) * 2 + (h)) * HTB)
#define PG8_SB(b, h) ((4 + (b) * 2 + (h)) * HTB)
#define PG8_STAGE(bufoff, gbase, voff) do { _Pragma("unroll") for (int _i = 0; _i < 2; ++_i) \
        __builtin_amdgcn_global_load_lds((const unsigned*)((const char*)(gbase) + (voff)[_i]), (PG8_LAS unsigned*)(lds + (bufoff) + ldsw + _i * 8192), 16, 0, 0); } while (0)
#define PG8_LDA(dst, b, h) do { _Pragma("unroll") for (int m = 0; m < 4; ++m) _Pragma("unroll") for (int k = 0; k < 2; ++k) dst[m][k] = *(const PG8_LAS bf16x8*)(lds + PG8_SA(b, h) + aoff + m * 2048 + k * 1024); } while (0)
#define PG8_LDB(dst, b, h) do { _Pragma("unroll") for (int n = 0; n < 2; ++n) _Pragma("unroll") for (int k = 0; k < 2; ++k) dst[n][k] = *(const PG8_LAS bf16x8*)(lds + PG8_SB(b, h) + boff + n * 2048 + k * 1024); } while (0)
#define PG8_MMA(ai, bj, At, Bt) do { __builtin_amdgcn_s_setprio(1); _Pragma("unroll") for (int m = 0; m < 4; ++m) _Pragma("unroll") for (int n = 0; n < 2; ++n) _Pragma("unroll") for (int k = 0; k < 2; ++k) \
        acc[ai][bj][m][n] = __builtin_amdgcn_mfma_f32_16x16x32_bf16(Bt[n][k], At[m][k], acc[ai][bj][m][n], 0, 0, 0); __builtin_amdgcn_s_setprio(0); } while (0)
#define PG8_WAIT_V(n) asm volatile("s_waitcnt vmcnt(" #n ")" ::: "memory")
#define PG8_WAIT_L(n) asm volatile("s_waitcnt lgkmcnt(" #n ")" ::: "memory")
#define PG8_BAR __builtin_amdgcn_s_barrier()
#define PG8_SCHED __builtin_amdgcn_sched_barrier(0)
    Unit cur, nxt; int ui = 0;
    if (!S.next(0, cur)) return;
    f32x4 acc[2][2][4][2];
#pragma unroll
    for (int a = 0; a < 2; ++a)
#pragma unroll
        for (int b = 0; b < 2; ++b)
#pragma unroll
            for (int m = 0; m < 4; ++m)
#pragma unroll
                for (int n = 0; n < 2; ++n) acc[a][b][m][n] = (f32x4){0.f, 0.f, 0.f, 0.f};
    bf16x8 At[4][2], B0[2][2], B1[2][2];
    const char* cA = (const char*)g.A + (size_t)cur.pm * tstep; const char* cB = (const char*)g.Bt + (size_t)cur.pn * tstep;
    S.a_ready(cur);
    if constexpr (SP2) {
        PG8_STAGE(PG8_SB(0, 0), cB, voffB); PG8_STAGE(PG8_SB(0, 1), cB + hstep, voffB); PG8_STAGE(PG8_SA(0, 0), cA, voffA); PG8_STAGE(PG8_SA(0, 1), cA + hstep, voffA);
        if (wr == 1) PG8_BAR;
        PG8_WAIT_V(2); PG8_BAR;
        PG8_STAGE(PG8_SB(1, 0), cB + kstep, voffB); PG8_STAGE(PG8_SA(1, 0), cA + kstep, voffA); PG8_STAGE(PG8_SB(1, 1), cB + hstep + kstep, voffB);
        PG8_WAIT_V(6); PG8_BAR;
    } else {
        PG8_STAGE(PG8_SB(0, 0), cB, voffB); PG8_STAGE(PG8_SA(0, 0), cA, voffA); PG8_STAGE(PG8_SB(0, 1), cB + hstep, voffB); PG8_STAGE(PG8_SA(0, 1), cA + hstep, voffA);
        if (wr == 1) PG8_BAR;
        PG8_WAIT_V(4); PG8_BAR;
        PG8_STAGE(PG8_SB(1, 0), cB + kstep, voffB); PG8_STAGE(PG8_SA(1, 0), cA + kstep, voffA); PG8_STAGE(PG8_SB(1, 1), cB + hstep + kstep, voffB);
        PG8_WAIT_V(6); PG8_BAR;
    }
    for (;;) {
        const bool has_next = S.next(ui + 1, nxt);
        const char* nA = has_next ? (const char*)g.A + (size_t)nxt.pm * tstep : cA; const char* nB = has_next ? (const char*)g.Bt + (size_t)nxt.pn * tstep : cB;
        for (int t = 0; t < nt; t += 2) {
            const bool last = (t == nt - 2);
            const char* a1 = cA + (size_t)(t + 1) * kstep;
            const char* a2 = last ? nA : cA + (size_t)(t + 2) * kstep; const char* b2 = last ? nB : cB + (size_t)(t + 2) * kstep;
            const char* a3 = a2 + kstep; const char* b3 = b2 + kstep;
            if (last && has_next) S.a_ready(nxt);
            if constexpr (SP2) {
            PG8_LDB(B0, 0, 0); PG8_LDB(B1, 0, 1); PG8_SCHED; PG8_LDA(At, 0, 0); PG8_STAGE(PG8_SA(1, 1), a1 + hstep, voffA);
            PG8_WAIT_V(8); PG8_WAIT_L(0); PG8_BAR; PG8_MMA(0, 0, At, B0); PG8_MMA(0, 1, At, B1); PG8_BAR; PG8_SCHED;
            PG8_LDA(At, 0, 1); PG8_STAGE(PG8_SB(0, 0), b2, voffB); PG8_STAGE(PG8_SB(0, 1), b2 + hstep, voffB); PG8_STAGE(PG8_SA(0, 0), a2, voffA);
            PG8_WAIT_V(8); PG8_WAIT_L(0); PG8_BAR; PG8_MMA(1, 0, At, B0); PG8_MMA(1, 1, At, B1); PG8_BAR; PG8_SCHED;
            PG8_LDB(B0, 1, 0); PG8_LDB(B1, 1, 1); PG8_SCHED; PG8_LDA(At, 1, 0); PG8_STAGE(PG8_SA(0, 1), a2 + hstep, voffA);
            PG8_WAIT_V(8); PG8_WAIT_L(0); PG8_BAR; PG8_MMA(0, 0, At, B0); PG8_MMA(0, 1, At, B1); PG8_BAR; PG8_SCHED;
            PG8_LDA(At, 1, 1); PG8_STAGE(PG8_SB(1, 0), b3, voffB); PG8_STAGE(PG8_SB(1, 1), b3 + hstep, voffB); PG8_STAGE(PG8_SA(1, 0), a3, voffA);
            PG8_WAIT_V(8); PG8_WAIT_L(0); PG8_BAR; PG8_MMA(1, 0, At, B0); PG8_MMA(1, 1, At, B1); PG8_BAR; PG8_SCHED;
            } else {
            PG8_LDB(B0, 0, 0); PG8_SCHED; PG8_LDA(At, 0, 0); PG8_STAGE(PG8_SA(1, 1), a1 + hstep, voffA);
            PG8_WAIT_L(8); PG8_BAR; PG8_WAIT_L(0); PG8_MMA(0, 0, At, B0); PG8_BAR; PG8_SCHED;
            PG8_LDB(B1, 0, 1); PG8_STAGE(PG8_SB(0, 0), b2, voffB);
            PG8_BAR; PG8_WAIT_L(0); PG8_MMA(0, 1, At, B1); PG8_BAR;
            PG8_LDA(At, 0, 1); PG8_STAGE(PG8_SA(0, 0), a2, voffA);
            PG8_BAR; PG8_WAIT_L(0); PG8_MMA(1, 0, At, B0); PG8_BAR; PG8_SCHED;
            PG8_STAGE(PG8_SB(0, 1), b2 + hstep, voffB);
            PG8_WAIT_V(6); PG8_BAR; PG8_MMA(1, 1, At, B1); PG8_BAR;
            PG8_LDB(B0, 1, 0); PG8_SCHED; PG8_LDA(At, 1, 0); PG8_STAGE(PG8_SA(0, 1), a2 + hstep, voffA);
            PG8_WAIT_L(8); PG8_BAR; PG8_WAIT_L(0); PG8_MMA(0, 0, At, B0); PG8_BAR; PG8_SCHED;
            PG8_LDB(B1, 1, 1); PG8_STAGE(PG8_SB(1, 0), b3, voffB);
            PG8_BAR; PG8_WAIT_L(0); PG8_MMA(0, 1, At, B1); PG8_BAR;
            PG8_LDA(At, 1, 1); PG8_STAGE(PG8_SA(1, 0), a3, voffA);
            PG8_BAR; PG8_WAIT_L(0); PG8_MMA(1, 0, At, B0); PG8_BAR; PG8_SCHED;
            PG8_STAGE(PG8_SB(1, 1), b3 + hstep, voffB);
            PG8_WAIT_V(6); PG8_BAR; PG8_MMA(1, 1, At, B1); PG8_BAR;
            }
        }
        if constexpr (ALIGN_EPI) { if (wr == 0) PG8_BAR; }
        if constexpr (!Epi::AFTER_DRAIN) { E(acc, cur, wr, wc, fr, fq); S.done(cur); }
        if (!has_next) break;
#pragma unroll
        for (int a = 0; a < 2; ++a)
#pragma unroll
            for (int b = 0; b < 2; ++b)
#pragma unroll
                for (int m = 0; m < 4; ++m)
#pragma unroll
                    for (int n = 0; n < 2; ++n) acc[a][b][m][n] = (f32x4){0.f, 0.f, 0.f, 0.f};
        cur = nxt; cA = nA; cB = nB; ++ui;
        if constexpr (ALIGN_EPI) { if (wr == 1) PG8_BAR; }
    }
    PG8_WAIT_V(0);
    if constexpr (!ALIGN_EPI) { if (wr == 0) PG8_BAR; }
    PG8_BAR;
    if constexpr (Epi::AFTER_DRAIN) { E.fused(acc, cur, wr, wc, fr, fq, lds, wid, lane); S.done(cur); }
#undef PG8_SA
#undef PG8_SB
#undef PG8_STAGE
#undef PG8_LDA
#undef PG8_LDB
#undef PG8_MMA
#undef PG8_WAIT_V
#undef PG8_WAIT_L
#undef PG8_BAR
#undef PG8_SCHED
}
}

constexpr int NWAVES = 8;
constexpr int NB = 8, SEQ = 8192, D = 1024, DEPTH = 2, CCH = 512, CONVW = 31, RH = 4, RD = 128, RW = 512, RC = 128, FF = 4096, PLE = 256, INC = 3072;
constexpr int M = NB * SEQ;
constexpr int ZP = 2560;
constexpr float LN_EPS = 1e-5f;
constexpr size_t MiB = 1u << 20;
constexpr size_t WS_CTL = 0, CTL_ZERO_BYTES = 1 * MiB;
constexpr size_t WS_W = 2 * MiB, W_LAYER = 27 * MiB;
constexpr size_t WO_IN = 0, WO_OUT = 6 * MiB, WO_FF1 = 8 * MiB, WO_FF2 = 16 * MiB, WO_GATE = 24 * MiB, WO_PROJ = 26 * MiB;
constexpr size_t WS_SS = 56 * MiB, SS_SITE = 4 * MiB;
constexpr size_t WS_ROPE = 84 * MiB;
constexpr size_t WS_XB = 100 * MiB;
constexpr size_t WS_PB = 228 * MiB;
constexpr size_t WS_PROJ = 292 * MiB;
constexpr size_t WS_ZB = 420 * MiB;
constexpr size_t WS_T = 740 * MiB;
constexpr size_t WS_MIX = 756 * MiB;
constexpr size_t WS_HID = 420 * MiB;
constexpr size_t WS_END = 932 * MiB;
constexpr size_t WS_U = WS_XB, WS_S = WS_PROJ;
constexpr int CW_TMO = 0, CW_BAR = 4096;
constexpr int LDS_BYTES = 163840, RING_OFF = 0, MISC_OFF = 163840 - 256;

#define GAS __attribute__((address_space(1)))
#define LAS __attribute__((address_space(3)))
typedef unsigned short bf16;
typedef unsigned v4u __attribute__((ext_vector_type(4)));
typedef float f32x4 __attribute__((ext_vector_type(4)));
typedef GAS unsigned gu32;
#define RLX_AGENT __ATOMIC_RELAXED, __HIP_MEMORY_SCOPE_AGENT
#define LDS_WAIT() asm volatile("s_waitcnt lgkmcnt(0)" ::: "memory")
__device__ __forceinline__ unsigned f2bf(float f) { unsigned u = __builtin_bit_cast(unsigned, f); return (u + 0x7fffu + ((u >> 16) & 1u)) >> 16; }
__device__ __forceinline__ unsigned pk2(float lo, float hi) { return f2bf(lo) | (f2bf(hi) << 16); }
__device__ __forceinline__ float bf2f(unsigned short b) { return __uint_as_float(((unsigned)b) << 16); }

__device__ __forceinline__ float wave_sum(float v) {
#pragma unroll
    for (int o = 1; o < 64; o <<= 1) v += __shfl_xor(v, o);
    return v;
}
#define XB_TMO      128
#define XB_XCNT(j)  (256  + 64 * (j))
#define XB_XSUB(j)  (1280 + 64 * (j))
#define XB_XGEN(j)  (2304 + 64 * (j))
#define XB_TOP      3328
#define XB_TOPGEN   3392
#define XCD_BAR_WORDS 3456
#define XB_SPIN_CAP (1u << 18)

__device__ __forceinline__ unsigned xb_ld(unsigned* p)              { return __hip_atomic_load(p, __ATOMIC_RELAXED, __HIP_MEMORY_SCOPE_AGENT); }
__device__ __forceinline__ unsigned xb_add(unsigned* p, unsigned v) { return __hip_atomic_fetch_add(p, v, __ATOMIC_RELAXED, __HIP_MEMORY_SCOPE_AGENT); }
__device__ __forceinline__ unsigned xb_xcc_id() { return (unsigned)__builtin_amdgcn_s_getreg((3 << 11) | 20) & 0xFu; }
#define XB_SPIN(cond, bar) do { unsigned _sp = 0; while (cond) { __builtin_amdgcn_s_sleep(1); \
    if ((++_sp & 255u) == 0u) { if (xb_ld(&(bar)[XB_TMO])) break; if (_sp > XB_SPIN_CAP) { atomicAdd(&(bar)[XB_TMO], 1u); break; } } } } while (0)

__device__ __forceinline__ int xb_fresh_lane() { unsigned z = 0u; asm volatile("" : "+v"(z)); return (int)__builtin_amdgcn_mbcnt_hi(~0u, __builtin_amdgcn_mbcnt_lo(~0u, z)); }
struct XcdBarrier {
    unsigned* bar; unsigned x; int wave;
    volatile LAS unsigned* st;
};

__device__ __forceinline__ XcdBarrier xcd_barrier_post(unsigned* bar, volatile LAS unsigned* st, int wave) {
    XcdBarrier b; b.bar = bar; b.x = xb_xcc_id(); b.st = st; b.wave = wave;
    if (wave == 0 && xb_fresh_lane() == 0) (void)xb_add(&bar[XB_XCNT(b.x)], 1u);
    return b;
}
__device__ __forceinline__ void xcd_barrier_complete(unsigned* bar, unsigned x, unsigned& nloc, unsigned& nx) {
    const unsigned G = gridDim.x * gridDim.y * gridDim.z;
    unsigned sum, cnt, mine, sp = 0u;
    for (;;) {
        sum = 0u; cnt = 0u; mine = 0u;
#pragma unroll
        for (unsigned j = 0; j < 16; ++j) { const unsigned c = xb_ld(&bar[XB_XCNT(j)]); sum += c; cnt += (c > 0u) ? 1u : 0u; mine = (j == x) ? c : mine; }
        if (sum == G) break;
        __builtin_amdgcn_s_sleep(1);
        if ((++sp & 255u) == 0u) { if (xb_ld(&bar[XB_TMO])) break; if (sp > XB_SPIN_CAP) { atomicAdd(&bar[XB_TMO], 1u); break; } }
    }
    nloc = mine > 0u ? mine : 1u; nx = cnt > 0u ? cnt : 1u;
}

__device__ __forceinline__ void xcd_barrier(const XcdBarrier& b) {
    asm volatile("s_waitcnt vmcnt(0)" ::: "memory");
    __syncthreads();
    if (b.wave == 0 && xb_fresh_lane() == 0) {
        unsigned* bar = b.bar;
        __builtin_amdgcn_s_waitcnt(0);
        unsigned nloc = b.st[0], nx = b.st[1];
        if (nloc == 0u) { xcd_barrier_complete(bar, b.x, nloc, nx); b.st[0] = nloc; b.st[1] = nx; }
        const unsigned old = xb_add(&bar[XB_XSUB(b.x)], 1u);
        const unsigned gen = old / nloc;
        if (old + 1u == (gen + 1u) * nloc) {
            __builtin_amdgcn_fence(__ATOMIC_RELEASE, "agent");
            asm volatile("s_waitcnt vmcnt(0)" ::: "memory");
            const unsigned og = xb_add(&bar[XB_TOP], 1u);
            const unsigned tg = og / nx;
            if (og + 1u == (tg + 1u) * nx) xb_add(&bar[XB_TOPGEN], 1u);
            else XB_SPIN(xb_ld(&bar[XB_TOPGEN]) == tg, bar);
            __builtin_amdgcn_fence(__ATOMIC_ACQUIRE, "agent");
            xb_add(&bar[XB_XGEN(b.x)], 1u);
            asm volatile("s_waitcnt vmcnt(0)" ::: "memory");
        } else {
            XB_SPIN(xb_ld(&bar[XB_XGEN(b.x)]) == gen, bar);
            __builtin_amdgcn_fence(__ATOMIC_ACQUIRE, "agent");
            asm volatile("s_waitcnt vmcnt(0)" ::: "memory");
        }
    }
    __syncthreads();
}

namespace mx {
typedef short s16x4 __attribute__((ext_vector_type(4)));
typedef short v4i16_t __attribute__((ext_vector_type(4)));
typedef short bf16x8 __attribute__((ext_vector_type(8)));
typedef float f32x2 __attribute__((ext_vector_type(2)));
typedef unsigned u32x2 __attribute__((ext_vector_type(2)));
constexpr int KI = 0, VI = 32768, QI = 65536, SI = 98304;

__device__ __forceinline__ unsigned off_b(unsigned row, unsigned ch) { return 256u * row + 16u * (ch ^ (((row & 3u) << 2) | ((row >> 2) & 3u))); }
__device__ __forceinline__ unsigned tr_addr(unsigned lane, unsigned c, unsigned ks, unsigned t) {
    const unsigned g = lane >> 4, q = (lane & 15u) >> 2, p = lane & 3u; return off_b(32u * ks + 8u * g + 4u * t + q, 2u * c + (p >> 1)) + 8u * (p & 1u);
}
__device__ __forceinline__ bf16x8 tr_frag(LAS const unsigned char* img, unsigned lane, unsigned c, unsigned ks) {
    const s16x4 lo = __builtin_bit_cast(s16x4, __builtin_amdgcn_ds_read_tr16_b64_v4i16((LAS v4i16_t*)(img + tr_addr(lane, c, ks, 0))));
    const s16x4 hi = __builtin_bit_cast(s16x4, __builtin_amdgcn_ds_read_tr16_b64_v4i16((LAS v4i16_t*)(img + tr_addr(lane, c, ks, 1))));
    return __builtin_shufflevector(lo, hi, 0, 1, 2, 3, 4, 5, 6, 7);
}
__device__ __forceinline__ bf16x8 row_frag(LAS const unsigned char* img, unsigned row, unsigned ch) { return *(LAS const bf16x8*)(img + off_b(row, ch)); }
__device__ __forceinline__ float gamma_log(int h) { return logf(1.0f - exp2f(-5.0f - (float)h)); }
__device__ __forceinline__ float to_sgpr(float v) { return __builtin_bit_cast(float, __builtin_amdgcn_readfirstlane(__builtin_bit_cast(int, v))); }
__device__ __forceinline__ int opaque_s(int v) { asm volatile("" : "+s"(v)); return v; }

template <bool SCALE> __device__ __forceinline__ void stage_tile(LAS unsigned char* img, const bf16* src, float rowscale, int tid) {
    const int row = tid >> 2, c0 = (tid & 3) * 4;
    const GAS v4u* g = (const GAS v4u*)(src + (size_t)row * ZP + c0 * 8);
    v4u v[4];
#pragma unroll
    for (int c = 0; c < 4; ++c) v[c] = g[c];
#pragma unroll
    for (int c = 0; c < 4; ++c) {
        v4u o = v[c];
        if (SCALE) {
            const unsigned w[4] = {o.x, o.y, o.z, o.w}; unsigned r[4];
#pragma unroll
            for (int i = 0; i < 4; ++i) r[i] = pg8::cvt_pk_bf16(__uint_as_float(w[i] << 16) * rowscale, __uint_as_float(w[i] & 0xffff0000u) * rowscale);
            o.x = r[0]; o.y = r[1]; o.z = r[2]; o.w = r[3];
        }
        *(LAS v4u*)(img + off_b(row, c0 + c)) = o;
    }
}
#define MX_MFMA(a, b, c) __builtin_amdgcn_mfma_f32_16x16x32_bf16((a), (b), (c), 0, 0, 0)

__device__ __forceinline__ void conv_phase(LAS unsigned char* L, const bf16* ZB, bf16* MIXB, const float* dw_w, const float* dw_b, const float* ln_g, const float* ln_b, int bx, int wave) {
    const int lane0 = xb_fresh_lane(), cp0 = (wave * 64 + lane0) & 255, half = wave >> 2;
    f32x2 w2[CONVW];
#pragma unroll
    for (int j = 0; j < CONVW; ++j) w2[j] = *(const GAS f32x2*)(dw_w + j * CCH + 2 * cp0);
    const f32x2 b2 = *(const GAS f32x2*)(dw_b + 2 * cp0);
    LAS float* CT = (LAS float*)L;
    for (int tile = 0; tile < 4; ++tile) {
        int lane = lane0; asm volatile("" : "+v"(lane));
        const int cp = (wave * 64 + lane) & 255;
        const int mt = bx * 256 + tile * 64, t0 = (mt % SEQ) + 32 * half;
        const bf16* src = ZB + ((long)(mt + 32 * half) - (CONVW - 1)) * ZP + 2 * cp;
        f32x2 acc[32];
#pragma unroll
        for (int t = 0; t < 32; ++t) acc[t] = b2;
#pragma unroll
        for (int r = 0; r < 32 + CONVW - 1; ++r) {
            unsigned u = 0u; if (t0 - (CONVW - 1) + r >= 0) u = *(const GAS unsigned*)(src + (long)r * ZP);
            const f32x2 h2 = {__uint_as_float(u << 16), __uint_as_float(u & 0xffff0000u)};
#pragma unroll
            for (int t = (r - (CONVW - 1) > 0 ? r - (CONVW - 1) : 0); t <= (r < 31 ? r : 31); ++t) acc[t] = w2[r - t] * h2 + acc[t];
        }
#pragma unroll
        for (int t = 0; t < 32; ++t) *(LAS f32x2*)(CT + (32 * half + t) * CCH + 2 * cp) = acc[t];
        __syncthreads();
        {
            const f32x4 g0 = *(const GAS f32x4*)(ln_g + 8 * lane), g1 = *(const GAS f32x4*)(ln_g + 8 * lane + 4), be0 = *(const GAS f32x4*)(ln_b + 8 * lane), be1 = *(const GAS f32x4*)(ln_b + 8 * lane + 4);
#pragma unroll 2
            for (int i = 0; i < 8; ++i) {
                const int tok = 8 * wave + i;
                f32x4 v0 = *(LAS f32x4*)(CT + tok * CCH + 8 * lane), v1 = *(LAS f32x4*)(CT + tok * CCH + 8 * lane + 4);
                const float mean = wave_sum((v0[0] + v0[1]) + (v0[2] + v0[3]) + (v1[0] + v1[1]) + (v1[2] + v1[3])) * (1.0f / CCH);
                v0 = v0 - mean; v1 = v1 - mean;
                const float rstd = rsqrtf(wave_sum((v0[0] * v0[0] + v0[1] * v0[1]) + (v0[2] * v0[2] + v0[3] * v0[3]) + (v1[0] * v1[0] + v1[1] * v1[1]) + (v1[2] * v1[2] + v1[3] * v1[3])) * (1.0f / CCH) + LN_EPS);
                v0 = v0 * rstd * g0 + be0; v1 = v1 * rstd * g1 + be1;
                v0 = v0 * pg8::sig4(v0); v1 = v1 * pg8::sig4(v1);
                *(GAS v4u*)(MIXB + (size_t)(mt + tok) * D + 8 * lane) = pg8::pack8(v0, v1);
            }
        }
        __syncthreads();
    }
}

__device__ __forceinline__ void state_mfma(f32x4 (&sacc)[8], LAS const unsigned char* Kimg, LAS const unsigned char* Vimg, int wave, int lane) {
#pragma unroll
    for (int kp = 0; kp < 4; ++kp) {
        const bf16x8 kf = tr_frag(Kimg, lane, wave, kp);
#pragma unroll
        for (int eb = 0; eb < 8; ++eb) { const bf16x8 vf = tr_frag(Vimg, lane, eb, kp); sacc[eb] = MX_MFMA(kf, vf, sacc[eb]); }
    }
}
__device__ __forceinline__ void ret_state_phase(LAS unsigned char* L, const bf16* ZB, float* Tf, int bx, int wave) {
    const int lane0 = xb_fresh_lane(), bh = bx >> 3, cg = bx & 7, b = bh >> 2, h = opaque_s(bh & 3);
    const float lg = to_sgpr(gamma_log(h)), kscale = expf(-(float)((wave * 64 + lane0) >> 2) * lg), g1 = to_sgpr(expf(lg)), g127 = to_sgpr(expf(127.0f * lg));
    f32x4 sacc[8];
#pragma unroll
    for (int eb = 0; eb < 8; ++eb) sacc[eb] = (f32x4){0.f, 0.f, 0.f, 0.f};
    for (int j = 0; j < 8; ++j) {
        int lane = lane0; asm volatile("" : "+v"(lane));
        const int tid = wave * 64 + lane;
        const size_t m0 = (size_t)b * SEQ + (size_t)(cg * 8 + j) * RC;
        stage_tile<true>(L + KI, ZB + m0 * ZP + 1024 + h * RD, kscale, tid);
        stage_tile<false>(L + VI, ZB + m0 * ZP + 1536 + h * RD, 1.0f, tid);
        __syncthreads();
#pragma unroll
        for (int eb = 0; eb < 8; ++eb) sacc[eb] = sacc[eb] * g1;
        state_mfma(sacc, L + KI, L + VI, wave, lane);
#pragma unroll
        for (int eb = 0; eb < 8; ++eb) sacc[eb] = sacc[eb] * g127;
        __syncthreads();
    }
    GAS f32x4* dst = (GAS f32x4*)Tf + (size_t)(bx * 8 + wave) * 8 * 64 + lane0;
#pragma unroll
    for (int eb = 0; eb < 8; ++eb) dst[eb * 64] = sacc[eb];
}
__device__ __forceinline__ void ret_out_phase(LAS unsigned char* L, const bf16* ZB, bf16* MIXB, const float* Tf, const float* gn_g, const float* gn_b, int bx, int wave) {
    const int lane0 = xb_fresh_lane(), bh = bx >> 3, cg = bx & 7, b = bh >> 2, h = opaque_s(bh & 3);
    const float lg = to_sgpr(gamma_log(h)), kscale = expf(-(float)((wave * 64 + lane0) >> 2) * lg), qscale = expf((float)((wave * 64 + lane0) >> 2) * lg), g1 = to_sgpr(expf(lg)), g127 = to_sgpr(expf(127.0f * lg)), cd8 = to_sgpr(expf(1024.0f * lg));
    f32x4 sacc[8];
#pragma unroll
    for (int eb = 0; eb < 8; ++eb) sacc[eb] = (f32x4){0.f, 0.f, 0.f, 0.f};
    { float coef = 1.0f;
      for (int g2 = cg - 1; g2 >= 0; --g2) { const GAS f32x4* src = (const GAS f32x4*)Tf + (size_t)((bh * 8 + g2) * 8 + wave) * 8 * 64 + lane0;
#pragma unroll
          for (int eb = 0; eb < 8; ++eb) sacc[eb] = sacc[eb] + src[eb * 64] * coef;
          coef *= cd8; } }
    for (int j = 0; j < 8; ++j) {
        int lane = lane0; asm volatile("" : "+v"(lane));
        const int tid = wave * 64 + lane, g = lane >> 4, li = lane & 15;
        const size_t m0 = (size_t)b * SEQ + (size_t)(cg * 8 + j) * RC;
        stage_tile<true>(L + KI, ZB + m0 * ZP + 1024 + h * RD, kscale, tid); __builtin_amdgcn_sched_barrier(0);
        stage_tile<false>(L + VI, ZB + m0 * ZP + 1536 + h * RD, 1.0f, tid); __builtin_amdgcn_sched_barrier(0);
        stage_tile<true>(L + QI, ZB + m0 * ZP + 512 + h * RD, qscale, tid); __builtin_amdgcn_sched_barrier(0);
#pragma unroll
        for (int eb = 0; eb < 8; ++eb) { const f32x4 sv = sacc[eb] * g1; u32x2 w; w.x = pg8::cvt_pk_bf16(sv[0], sv[1]); w.y = pg8::cvt_pk_bf16(sv[2], sv[3]);
            *(LAS u32x2*)(L + SI + off_b(16 * eb + li, 2 * wave + (g >> 1)) + 8 * (g & 1)) = w; }
        __syncthreads(); __builtin_amdgcn_sched_barrier(0);
        bf16x8 qf[4];
#pragma unroll
        for (int ks = 0; ks < 4; ++ks) qf[ks] = row_frag(L + QI, 16 * wave + li, 4 * ks + g);
        bf16x8 pf[4];
#pragma unroll
        for (int kp = 0; kp < 4; ++kp) {
            unsigned pw[4] = {0u, 0u, 0u, 0u};
            if (kp <= (wave >> 1)) {
#pragma unroll
                for (int t = 0; t < 2; ++t) {
                    f32x4 x = (f32x4){0.f, 0.f, 0.f, 0.f};
                    const unsigned krow = 32 * kp + 8 * (li >> 2) + 4 * t + (li & 3);
#pragma unroll
                    for (int ks = 0; ks < 4; ++ks) x = MX_MFMA(row_frag(L + KI, krow, 4 * ks + g), qf[ks], x);
                    { const int key0 = 32 * kp + 8 * g + 4 * t, ql = 16 * wave + li;
#pragma unroll
                        for (int r = 0; r < 4; ++r) x[r] = (key0 + r <= ql) ? x[r] : 0.f; }
                    pw[2 * t] = pg8::cvt_pk_bf16(x[0], x[1]); pw[2 * t + 1] = pg8::cvt_pk_bf16(x[2], x[3]);
                }
            }
            pf[kp] = __builtin_bit_cast(bf16x8, (v4u){pw[0], pw[1], pw[2], pw[3]}); __builtin_amdgcn_sched_barrier(0);
        }
        f32x4 o[8];
#pragma unroll
        for (int eb = 0; eb < 8; ++eb) o[eb] = (f32x4){0.f, 0.f, 0.f, 0.f};
#pragma unroll
        for (int eb = 0; eb < 8; ++eb) {
#pragma unroll
            for (int ks = 0; ks < 4; ++ks) o[eb] = MX_MFMA(row_frag(L + SI, 16 * eb + li, 4 * ks + g), qf[ks], o[eb]);
            if (eb & 1) __builtin_amdgcn_sched_barrier(0); }
#pragma unroll
        for (int eb = 0; eb < 8; ++eb) sacc[eb] = sacc[eb] * g1;
#pragma unroll
        for (int kp = 0; kp < 4; ++kp) {
            const bf16x8 kf = tr_frag(L + KI, lane, wave, kp);
#pragma unroll
            for (int eb = 0; eb < 8; ++eb) { const bf16x8 vf = tr_frag(L + VI, lane, eb, kp);
                o[eb] = MX_MFMA(vf, pf[kp], o[eb]);
                sacc[eb] = MX_MFMA(kf, vf, sacc[eb]); if (eb & 1) __builtin_amdgcn_sched_barrier(0); }
        }
#pragma unroll
        for (int eb = 0; eb < 8; ++eb) sacc[eb] = sacc[eb] * g127;
        float s1 = 0.f;
#pragma unroll
        for (int eb = 0; eb < 8; ++eb) s1 += (o[eb][0] + o[eb][1]) + (o[eb][2] + o[eb][3]);
        s1 += __shfl_xor(s1, 16); s1 += __shfl_xor(s1, 32);
        const float mean = s1 * (1.0f / RD); float s2 = 0.f;
#pragma unroll
        for (int eb = 0; eb < 8; ++eb) { o[eb] = o[eb] - mean; s2 += (o[eb][0] * o[eb][0] + o[eb][1] * o[eb][1]) + (o[eb][2] * o[eb][2] + o[eb][3] * o[eb][3]); }
        s2 += __shfl_xor(s2, 16); s2 += __shfl_xor(s2, 32);
        const float rstd = rsqrtf(s2 * (1.0f / RD) + LN_EPS); __builtin_amdgcn_sched_barrier(0);
        const size_t mrow = m0 + 16 * wave + li;
#pragma unroll
        for (int eb = 0; eb < 8; ++eb) { const int e0 = h * RD + 16 * eb + 4 * g;
            const f32x4 gg = *(const GAS f32x4*)(gn_g + e0), gb = *(const GAS f32x4*)(gn_b + e0);
            const u32x2 gw = *(const GAS u32x2*)(ZB + mrow * ZP + 2048 + e0);
            const f32x4 gt = (f32x4){__uint_as_float(gw.x << 16), __uint_as_float(gw.x & 0xffff0000u), __uint_as_float(gw.y << 16), __uint_as_float(gw.y & 0xffff0000u)};
            const f32x4 y = (o[eb] * rstd * gg + gb) * gt;
            u32x2 w; w.x = pg8::cvt_pk_bf16(y[0], y[1]); w.y = pg8::cvt_pk_bf16(y[2], y[3]);
            *(GAS u32x2*)(MIXB + mrow * D + CCH + e0) = w; if (eb & 1) __builtin_amdgcn_sched_barrier(0); }
        __syncthreads();
    }
}
#undef MX_MFMA
}

struct Args {
    const float* x; const float* p; const int* pos; const float* norm_mix_g; const float* w_in; const float* dw_w; const float* dw_b; const float* ln_g; const float* ln_b;
    const float* gn_g; const float* gn_b; const float* w_out; const float* norm_ffn_g; const float* w_ff1; const float* w_ff2; const float* norm_ple_g; const float* w_gate; const float* w_proj;
    const float* final_g; float* out; unsigned char* ws; int ph_lo, ph_hi, li, pad;
};
__device__ __forceinline__ int inmap(int s) {
    if (s < 512) return 256 * (s >> 7) + (s & 127);
    if (s < 1024) { const int ch = s - 512; return 256 * (ch >> 7) + 128 + (ch & 127); }
    if (s < 2048) { const int k = s >= 1536, r = s - (k ? 1536 : 1024), hq = r >> 7, dd = r & 127; return 256 * ((k ? 6 : 4) + (hq >> 1)) + 128 * (dd >> 6) + 64 * (hq & 1) + (dd & 63); }
    return s;
}
template <bool INMAP> __device__ __forceinline__ void tr_item(const float* W, int K, int N, const float* gain, bf16* WT, LAS float* scr, int item, int lane) {
    const int nblk = N / 32, kb = item / nblk, nb = item % nblk, k0 = 64 * kb, n0 = 32 * nb;
#pragma unroll 8
    for (int i = 0; i < 32; ++i) { const int kk = 2 * i + (lane >> 5); scr[kk * 33 + (lane & 31)] = W[(size_t)(k0 + kk) * N + n0 + (lane & 31)] * (gain ? gain[k0 + kk] : 1.0f); }
    LDS_WAIT(); asm volatile("" ::: "memory");
    const int c = lane & 7;
#pragma unroll
    for (int j = 0; j < 4; ++j) { const int n = (lane >> 3) + 8 * j; const LAS float* s = scr + (8 * c) * 33 + n;
        const int src = n0 + n; const int r = INMAP ? inmap(src) : src; const float cs = (INMAP && src >= 1536 && src < 2048) ? 0.088388347648318447f : 1.0f;
        v4u o; o.x = pk2(s[0 * 33] * cs, s[1 * 33] * cs); o.y = pk2(s[2 * 33] * cs, s[3 * 33] * cs); o.z = pk2(s[4 * 33] * cs, s[5 * 33] * cs); o.w = pk2(s[6 * 33] * cs, s[7 * 33] * cs);
        *(GAS v4u*)(WT + (size_t)r * K + k0 + 8 * c) = o; }
    LDS_WAIT(); asm volatile("" ::: "memory");
}

__global__ void __launch_bounds__(NWAVES * 64, 2) mk_fwd(Args a) {
    extern __shared__ __attribute__((aligned(16))) unsigned char lds[];
    LAS unsigned char* const L = (LAS unsigned char*)lds;
    volatile LAS unsigned* MISC = (volatile LAS unsigned*)(L + MISC_OFF);
    const int wave = __builtin_amdgcn_readfirstlane(threadIdx.x >> 6);
#define LANE_ID() xb_fresh_lane()
    const int G = gridDim.x, bx = blockIdx.x;
    unsigned char* ws = a.ws;
    gu32* ctl = (gu32*)(ws + WS_CTL);
    if (threadIdx.x < 64) MISC[threadIdx.x] = 0u;
    __syncthreads();
    XcdBarrier bar = xcd_barrier_post((unsigned*)(ctl + CW_BAR) + a.li * XCD_BAR_WORDS, MISC + 8, wave);
    const int lo = a.ph_lo, hi = a.ph_hi;
#define IN(k) (lo <= (k) && (k) < hi)
#define SEAM(k) do { if (IN(k) && IN((k) + 1)) xcd_barrier(bar); } while (0)
    const int gw = bx * NWAVES + wave, NGW = G * NWAVES;
    const size_t NGT = (size_t)G * NWAVES * 64;
    bf16* const XB = (bf16*)(ws + WS_XB); bf16* const ZB = (bf16*)(ws + WS_ZB); bf16* const MIXB = (bf16*)(ws + WS_MIX); bf16* const HID = (bf16*)(ws + WS_HID);
    bf16* const XBN = (bf16*)(ws + WS_MIX);
    float* const TF = (float*)(ws + WS_T);
    bf16* const PROJ = (bf16*)(ws + WS_PROJ); bf16* const PB = (bf16*)(ws + WS_PB); unsigned* const ROPE = (unsigned*)(ws + WS_ROPE);

    if (IN(0)) {
        const int lane = LANE_ID(); const size_t gt = (size_t)bx * (NWAVES * 64) + wave * 64 + lane;
        LAS float* scr = (LAS float*)(L + RING_OFF + wave * 16384);
        constexpr int I_IN = (D / 64) * (INC / 32), I_OUT = (D / 64) * (D / 32), I_F1 = (D / 64) * (FF / 32), I_F2 = (FF / 64) * (D / 32), I_G = I_OUT, I_P = (PLE / 64) * (D / 32);
        constexpr int I_LAYER = I_IN + I_OUT + I_F1 + I_F2 + I_G + I_P;
        for (int it = gw; it < DEPTH * I_LAYER; it += NGW) {
            const int l = it / I_LAYER; int r = it % I_LAYER; unsigned char* wl = ws + WS_W + (size_t)l * W_LAYER;
            if (r < I_IN) { tr_item<true>(a.w_in + (size_t)l * D * INC, D, INC, a.norm_mix_g + l * D, (bf16*)(wl + WO_IN), scr, r, lane); continue; } r -= I_IN;
            if (r < I_OUT) { tr_item<false>(a.w_out + (size_t)l * D * D, D, D, nullptr, (bf16*)(wl + WO_OUT), scr, r, lane); continue; } r -= I_OUT;
            if (r < I_F1) { tr_item<false>(a.w_ff1 + (size_t)l * D * FF, D, FF, a.norm_ffn_g + l * D, (bf16*)(wl + WO_FF1), scr, r, lane); continue; } r -= I_F1;
            if (r < I_F2) { tr_item<false>(a.w_ff2 + (size_t)l * FF * D, FF, D, nullptr, (bf16*)(wl + WO_FF2), scr, r, lane); continue; } r -= I_F2;
            if (r < I_G) { tr_item<false>(a.w_gate + (size_t)l * D * D, D, D, a.norm_ple_g + l * D, (bf16*)(wl + WO_GATE), scr, r, lane); continue; } r -= I_G;
            tr_item<false>(a.w_proj + (size_t)l * PLE * D, PLE, D, nullptr, (bf16*)(wl + WO_PROJ), scr, r, lane);
        }
        float* ss0 = (float*)(ws + WS_SS);
        for (int m = gw; m < M; m += NGW) {
            const GAS f32x4* xr = (const GAS f32x4*)(a.x + (size_t)m * D) + lane; f32x4 v[4]; float s = 0.f;
#pragma unroll
            for (int j = 0; j < 4; ++j) { v[j] = xr[64 * j]; s += (v[j].x * v[j].x + v[j].y * v[j].y) + (v[j].z * v[j].z + v[j].w * v[j].w); }
            s = wave_sum(s);
            GAS unsigned long long* o8 = (GAS unsigned long long*)(XB + (size_t)m * D) + lane;
#pragma unroll
            for (int j = 0; j < 4; ++j) o8[64 * j] = (unsigned long long)pk2(v[j].x, v[j].y) | ((unsigned long long)pk2(v[j].z, v[j].w) << 32);
            if (lane < 16) ss0[(size_t)m * 16 + lane] = lane == 0 ? s : 0.f;
        }
        for (size_t i = gt; i < (size_t)DEPTH * M * PLE / 8; i += NGT) {
            const f32x4 p0 = *(const GAS f32x4*)(a.p + i * 8), p1 = *(const GAS f32x4*)(a.p + i * 8 + 4);
            v4u o; o.x = pk2(p0.x, p0.y); o.y = pk2(p0.z, p0.w); o.z = pk2(p1.x, p1.y); o.w = pk2(p1.z, p1.w);
            *(GAS v4u*)(PB + i * 8) = o;
        }
        for (size_t i = gt; i < (size_t)M * 64; i += NGT) {
            const int d = (int)(i & 63); const size_t m = i >> 6;
            const float inv_freq = 1.0f / powf(10000.0f, (float)d * (2.0f / RD)), ang = (float)a.pos[m] * inv_freq;
            const pg8::f16x2 cs = {(_Float16)cosf(ang), (_Float16)sinf(ang)};
            ROPE[i] = __builtin_bit_cast(unsigned, cs);
        }
    }
    SEAM(0);
#pragma clang loop unroll(full)
    for (int l = 0; l < DEPTH; ++l) {
        const int pb = 1 + 8 * l;
        unsigned char* wl = ws + WS_W + (size_t)l * W_LAYER;
        float* const ss_a = (float*)(ws + WS_SS + (size_t)(3 * l + 0) * SS_SITE);
        float* const ss_b = (float*)(ws + WS_SS + (size_t)(3 * l + 1) * SS_SITE);
        float* const ss_c = (float*)(ws + WS_SS + (size_t)(3 * l + 2) * SS_SITE);
        float* const ss_d = (float*)(ws + WS_SS + (size_t)(3 * l + 3) * SS_SITE);
        if (IN(pb + 0)) {
            pg8::Gemm g{l == 0 ? XB : XBN, (const bf16*)(wl + WO_IN), M, INC, D}; pg8::StaticOrder S; S.init(M, INC, G, bx);
            pg8::EpiInProj E{ZB, ss_a, ROPE};
            pg8::gemm_phase<pg8::EpiInProj, pg8::StaticOrder, true, true>(L + RING_OFF, g, S, E, wave);
        }
        SEAM(pb + 0);
        if (IN(pb + 1)) {
            mx::conv_phase(L, ZB, MIXB, a.dw_w + l * CONVW * CCH, a.dw_b + l * CCH, a.ln_g + l * CCH, a.ln_b + l * CCH, bx, wave);
            mx::ret_state_phase(L, ZB, TF, bx, wave);
        }
        SEAM(pb + 1);
        if (IN(pb + 2)) mx::ret_out_phase(L, ZB, MIXB, TF, a.gn_g + l * RW, a.gn_b + l * RW, bx, wave);
        SEAM(pb + 2);
        if (IN(pb + 3)) {
            pg8::Gemm g{MIXB, (const bf16*)(wl + WO_OUT), M, D, D}; pg8::StaticOrder S; S.init(M, D, G, bx);
            pg8::EpiResid<0> E{l == 0 ? a.x : a.out, a.out, XB, ss_b, nullptr, nullptr};
            pg8::gemm_phase<pg8::EpiResid<0>, pg8::StaticOrder, true, true>(L + RING_OFF, g, S, E, wave);
        }
        SEAM(pb + 3);
        if (IN(pb + 4)) {
            pg8::Gemm g{XB, (const bf16*)(wl + WO_FF1), M, FF, D}; pg8::StaticOrder S; S.init(M, FF, G, bx);
            pg8::EpiFF1 E{HID, ss_b};
            pg8::gemm_phase<pg8::EpiFF1, pg8::StaticOrder, true, true>(L + RING_OFF, g, S, E, wave);
        }
        SEAM(pb + 4);
        if (IN(pb + 5)) {
            pg8::Gemm g{HID, (const bf16*)(wl + WO_FF2), M, D, FF}; pg8::StaticOrder S; S.init(M, D, G, bx);
            pg8::EpiResid<0> E{a.out, a.out, XB, ss_c, nullptr, nullptr};
            pg8::gemm_phase<pg8::EpiResid<0>, pg8::StaticOrder, true, true>(L + RING_OFF, g, S, E, wave);
        }
        SEAM(pb + 5);
        if (IN(pb + 6)) {
            pg8::Gemm g{PB + (size_t)l * M * PLE, (const bf16*)(wl + WO_PROJ), M, D, PLE}; pg8::StaticOrder S; S.init(M, D, G, bx);
            pg8::EpiPlain E{PROJ};
            pg8::gemm_phase<pg8::EpiPlain, pg8::StaticOrder, true, true>(L + RING_OFF, g, S, E, wave);
        }
        SEAM(pb + 6);
        if (IN(pb + 7)) {
            pg8::Gemm g{XB, (const bf16*)(wl + WO_GATE), M, D, D}; pg8::StaticOrder S; S.init(M, D, G, bx);
            pg8::EpiResid<1> E{a.out, a.out, XBN, ss_d, ss_c, PROJ};
            pg8::gemm_phase<pg8::EpiResid<1>, pg8::StaticOrder, true, true>(L + RING_OFF, g, S, E, wave);
        }
        SEAM(pb + 7);
    }
    if (IN(17)) {
        const int lane = LANE_ID();
        const float* ssf = (const float*)(ws + WS_SS + (size_t)6 * SS_SITE);
        for (int m = gw; m < M; m += NGW) {
            const float rs = pg8::rstd_of(ssf, m);
            GAS f32x4* xr = (GAS f32x4*)(a.out + (size_t)m * D) + lane; const GAS f32x4* gr = (const GAS f32x4*)a.final_g + lane;
#pragma unroll
            for (int j = 0; j < 4; ++j) { const f32x4 v = xr[64 * j], gg = gr[64 * j]; xr[64 * j] = v * rs * gg; }
        }
    }
#undef IN
#undef SEAM
}

extern "C" void kernel_launch(void* const* d_in, const int* in_sizes, int n_in, void* d_out, int out_size, void* d_ws, size_t ws_size, hipStream_t stream) {
    static int grid = 0;
    if (grid == 0) {
        if (n_in != 19 || out_size != M * D || ws_size < WS_END) { fprintf(stderr, "kernel_launch: unexpected problem (n_in %d, out %d, ws %zu < %zu); nothing launched\n", n_in, out_size, ws_size, (size_t)WS_END); grid = -1; return; }
        int dev = 0, cus = 0;
        if (hipGetDevice(&dev) != hipSuccess || hipDeviceGetAttribute(&cus, hipDeviceAttributeMultiprocessorCount, dev) != hipSuccess) { grid = -1; return; }
        if (hipFuncSetAttribute((const void*)mk_fwd, hipFuncAttributeMaxDynamicSharedMemorySize, LDS_BYTES) != hipSuccess) { fprintf(stderr, "kernel_launch: hipFuncSetAttribute failed\n"); grid = -1; return; }
        int per_cu = 0;
        if (hipOccupancyMaxActiveBlocksPerMultiprocessor(&per_cu, (const void*)mk_fwd, NWAVES * 64, LDS_BYTES) != hipSuccess || per_cu < 1) fprintf(stderr, "kernel_launch: occupancy query says %d\n", per_cu);
        (void)hipGetLastError();
        if (cus < 256) fprintf(stderr, "kernel_launch: %d CUs < 256: the grid cannot be resident\n", cus);
        grid = 256;
    }
    if (grid < 0) return;
    (void)hipMemsetAsync((char*)d_ws + WS_CTL, 0, CTL_ZERO_BYTES, stream);
    Args a{};
    a.x = (const float*)d_in[0]; a.p = (const float*)d_in[1]; a.pos = (const int*)d_in[2]; a.norm_mix_g = (const float*)d_in[3]; a.w_in = (const float*)d_in[4]; a.dw_w = (const float*)d_in[5];
    a.dw_b = (const float*)d_in[6]; a.ln_g = (const float*)d_in[7]; a.ln_b = (const float*)d_in[8]; a.gn_g = (const float*)d_in[9]; a.gn_b = (const float*)d_in[10]; a.w_out = (const float*)d_in[11];
    a.norm_ffn_g = (const float*)d_in[12]; a.w_ff1 = (const float*)d_in[13]; a.w_ff2 = (const float*)d_in[14]; a.norm_ple_g = (const float*)d_in[15]; a.w_gate = (const float*)d_in[16];
    a.w_proj = (const float*)d_in[17]; a.final_g = (const float*)d_in[18]; a.out = (float*)d_out; a.ws = (unsigned char*)d_ws;
    a.ph_lo = 0; a.ph_hi = 18; a.li = 0;
    hipLaunchKernelGGL(mk_fwd, dim3(grid), dim3(NWAVES * 64), LDS_BYTES, stream, a);
}
```

```cpp
#include <hip/hip_runtime.h>
#include <cstdio>
#include <cstdint>
#include <cstddef>
namespace pg8 {
#define PG8_LAS __attribute__((address_space(3)))
typedef unsigned short bf16_t;
typedef short bf16x8 __attribute__((ext_vector_type(8)));
typedef float f32x4 __attribute__((ext_vector_type(4)));
typedef unsigned u32x4 __attribute__((ext_vector_type(4)));
typedef unsigned u32x2 __attribute__((ext_vector_type(2)));
constexpr int BM = 256, BK = 64, HALF = 128, HTB = HALF * BK * 2  , STAGE_BYTES = 8 * HTB, NXCD = 8, WGM = 8;

__host__ __device__ __forceinline__ int lds_byte(int r, int c) { const int st = (r >> 4) * 2 + (c >> 5), rr = r & 15, cc = c & 31, ob = rr * 64 + cc * 2; return st * 1024 + (ob ^ (((ob >> 9) & 1) << 5)); }
__host__ __device__ __forceinline__ void stage_rc(int b, int& R, int& C) { const int st = b / 1024, sb = b % 1024, swz = sb ^ (((sb >> 9) & 1) << 5); R = (st >> 1) * 16 + swz / 64; C = (st & 1) * 32 + (swz % 64) / 2; }
__host__ __device__ __forceinline__ int perm32(int rho) { const int n = rho >> 4, i = rho & 15; return 8 * (i >> 2) + 4 * n + (i & 3); }

struct Unit { int pm, pn; };
struct Gemm { const bf16_t* A; const bf16_t* Bt; int M, N, K; };

struct StaticOrder {
    int nM, nN, nwg, G, c;
    __host__ __device__ void init(int M, int N, int G_, int c_) { nM = M / BM; nN = N / BM; nwg = nM * nN; G = G_; c = c_; }
    __host__ __device__ bool next(int i, Unit& u) const {
        const long L = (long)i * G + c; if (L >= nwg) return false;
        int wgid = (int)L; { const int q = nwg / NXCD, r = nwg % NXCD, xcd = wgid % NXCD, off = wgid / NXCD; wgid = (xcd < r ? xcd * (q + 1) : r * (q + 1) + (xcd - r) * q) + off; }
        const int nig = WGM * nN, gid = wgid / nig, fm = gid * WGM, gsz = (nM - fm) < WGM ? (nM - fm) : WGM;
        u.pm = fm + ((wgid % nig) % gsz); u.pn = (wgid % nig) / gsz; return true;
    }
    __device__ __forceinline__ void a_ready(const Unit&) const {}
    __device__ __forceinline__ void done(const Unit&) const {}
};

__device__ __forceinline__ unsigned cvt_pk_bf16(float lo, float hi) { unsigned r; asm volatile("v_cvt_pk_bf16_f32 %0, %1, %2" : "=v"(r) : "v"(lo), "v"(hi)); return r; }
__device__ __forceinline__ u32x4 pack8(const f32x4 a, const f32x4 b) { u32x4 w; w.x = cvt_pk_bf16(a[0], a[1]); w.y = cvt_pk_bf16(a[2], a[3]); w.z = cvt_pk_bf16(b[0], b[1]); w.w = cvt_pk_bf16(b[2], b[3]); return w; }
__device__ __forceinline__ float fast_sigmoid(float x) { return __builtin_amdgcn_rcpf(1.0f + __expf(-x)); }
__device__ __forceinline__ f32x4 sig4(const f32x4 v) { return (f32x4){fast_sigmoid(v[0]), fast_sigmoid(v[1]), fast_sigmoid(v[2]), fast_sigmoid(v[3])}; }
constexpr int SSP = 16;
constexpr float RMS_EPS_ = 1e-6f;
__device__ __forceinline__ float rstd_of(const float* ss, int row) {
    const f32x4* p = (const f32x4*)(ss + (size_t)row * SSP); const f32x4 a = p[0], b = p[1], c = p[2], d = p[3];
    const f32x4 s = (a + b) + (c + d); return rsqrtf(((s[0] + s[1]) + (s[2] + s[3])) * (1.0f / 1024.0f) + RMS_EPS_);
}
typedef _Float16 f16x2 __attribute__((ext_vector_type(2)));

struct EpiInProj {
    static constexpr bool PERM = true, AFTER_DRAIN = false;
    bf16_t* ZB; const float* ss; const unsigned* rope;
    static constexpr int ZP = 2560;
    __device__ __forceinline__ void operator()(const f32x4 (&acc)[2][2][4][2], const Unit& u, int wr, int wc, int fr, int fq) const {
        const int row0 = u.pm * BM + wr * 64 + fr, pn = u.pn, lc = wc * 32 + 8 * fq;
        if (pn < 4) {
#pragma unroll
            for (int ai = 0; ai < 2; ++ai)
#pragma unroll
                for (int m = 0; m < 4; ++m) { const int row = row0 + ai * HALF + m * 16; const float rs = rstd_of(ss, row);
                    const f32x4 h0 = (acc[ai][0][m][0] * rs) * sig4(acc[ai][1][m][0] * rs), h1 = (acc[ai][0][m][1] * rs) * sig4(acc[ai][1][m][1] * rs);
                    *(u32x4*)(ZB + (size_t)row * ZP + pn * 128 + lc) = pack8(h0, h1); asm volatile("" ::: "memory"); }
        } else if (pn < 8) {
            const int head = 2 * (pn & 1) + (wc >> 1), d0 = lc & 63, colb = (pn < 6 ? 512 : 1024) + head * 128 + d0;
#pragma unroll
            for (int ai = 0; ai < 2; ++ai)
#pragma unroll
                for (int m = 0; m < 4; ++m) { const int row = row0 + ai * HALF + m * 16; const float rs = rstd_of(ss, row);
                    const u32x4* rp = (const u32x4*)(rope + (size_t)row * 64 + d0); const u32x4 r0 = rp[0], r1 = rp[1];
                    f32x4 o1[2], o2[2];
                    const unsigned rv[8] = {r0.x, r0.y, r0.z, r0.w, r1.x, r1.y, r1.z, r1.w};
#pragma unroll
                    for (int n = 0; n < 2; ++n) {
#pragma unroll
                        for (int i = 0; i < 4; ++i) { const f16x2 cs = __builtin_bit_cast(f16x2, rv[4 * n + i]); const float c = (float)cs[0], s = (float)cs[1];
                            const float t1 = acc[ai][0][m][n][i] * rs, t2 = acc[ai][1][m][n][i] * rs; o1[n][i] = t1 * c - t2 * s; o2[n][i] = t2 * c + t1 * s; } }
                    bf16_t* zp = ZB + (size_t)row * ZP + colb; *(u32x4*)zp = pack8(o1[0], o1[1]); *(u32x4*)(zp + 64) = pack8(o2[0], o2[1]); asm volatile("" ::: "memory"); }
        } else {
            const int colb = (pn < 10 ? 1536 + (pn - 8) * 256 : 2048 + (pn - 10) * 256) + lc; const bool act = pn >= 10;
#pragma unroll
            for (int ai = 0; ai < 2; ++ai)
#pragma unroll
                for (int m = 0; m < 4; ++m) { const int row = row0 + ai * HALF + m * 16; const float rs = rstd_of(ss, row);
#pragma unroll
                    for (int bj = 0; bj < 2; ++bj) { f32x4 v0 = acc[ai][bj][m][0] * rs, v1 = acc[ai][bj][m][1] * rs;
                        if (act) { v0 = v0 * sig4(v0); v1 = v1 * sig4(v1); }
                        *(u32x4*)(ZB + (size_t)row * ZP + colb + bj * HALF) = pack8(v0, v1); } asm volatile("" ::: "memory"); }
        }
    }
};
template <int MODE> struct EpiResid {
    static constexpr bool PERM = true, AFTER_DRAIN = false;
    const float* base; float* XF; bf16_t* XB; float* ss_out; const float* ss_in; const bf16_t* proj;
    __device__ __forceinline__ void operator()(const f32x4 (&acc)[2][2][4][2], const Unit& u, int wr, int wc, int fr, int fq) const {
        const int row0 = u.pm * BM + wr * 64 + fr, col0 = u.pn * BM + wc * 32 + 8 * fq;
#pragma unroll
        for (int ai = 0; ai < 2; ++ai)
#pragma unroll
            for (int m = 0; m < 4; ++m) { const int row = row0 + ai * HALF + m * 16; const size_t off = (size_t)row * 1024 + col0; float q = 0.f;
                float rs = 1.f; if (MODE == 1) rs = rstd_of(ss_in, row);
#pragma unroll
                for (int bj = 0; bj < 2; ++bj) { const f32x4 b0 = *(const f32x4*)(base + off + bj * HALF), b1 = *(const f32x4*)(base + off + bj * HALF + 4);
                    f32x4 v0, v1;
                    if (MODE == 1) { const u32x4 pw = *(const u32x4*)(proj + off + bj * HALF);
                        const f32x4 p0 = (f32x4){__uint_as_float(pw.x << 16), __uint_as_float(pw.x & 0xffff0000u), __uint_as_float(pw.y << 16), __uint_as_float(pw.y & 0xffff0000u)};
                        const f32x4 p1 = (f32x4){__uint_as_float(pw.z << 16), __uint_as_float(pw.z & 0xffff0000u), __uint_as_float(pw.w << 16), __uint_as_float(pw.w & 0xffff0000u)};
                        v0 = b0 + sig4(acc[ai][bj][m][0] * rs) * p0; v1 = b1 + sig4(acc[ai][bj][m][1] * rs) * p1; }
                    else { v0 = b0 + acc[ai][bj][m][0]; v1 = b1 + acc[ai][bj][m][1]; }
                    *(f32x4*)(XF + off + bj * HALF) = v0; *(f32x4*)(XF + off + bj * HALF + 4) = v1;
                    *(u32x4*)(XB + off + bj * HALF) = pack8(v0, v1);
                    q += (v0[0] * v0[0] + v0[1] * v0[1]) + (v0[2] * v0[2] + v0[3] * v0[3]) + (v1[0] * v1[0] + v1[1] * v1[1]) + (v1[2] * v1[2] + v1[3] * v1[3]); }
                q += __shfl_xor(q, 16); q += __shfl_xor(q, 32);
                if (fq == 0) ss_out[(size_t)row * SSP + u.pn * 4 + wc] = q; asm volatile("" ::: "memory"); }
    }
};
struct EpiFF1 {
    static constexpr bool PERM = true, AFTER_DRAIN = false;
    bf16_t* H; const float* ss;
    __device__ __forceinline__ void operator()(const f32x4 (&acc)[2][2][4][2], const Unit& u, int wr, int wc, int fr, int fq) const {
        const int row0 = u.pm * BM + wr * 64 + fr, col0 = u.pn * BM + wc * 32 + 8 * fq;
#pragma unroll
        for (int ai = 0; ai < 2; ++ai)
#pragma unroll
            for (int m = 0; m < 4; ++m) { const int row = row0 + ai * HALF + m * 16; const float rs = rstd_of(ss, row);
#pragma unroll
                for (int bj = 0; bj < 2; ++bj) { f32x4 v0 = acc[ai][bj][m][0] * rs, v1 = acc[ai][bj][m][1] * rs;
                    v0 = __builtin_elementwise_max(v0, (f32x4){0.f, 0.f, 0.f, 0.f}); v1 = __builtin_elementwise_max(v1, (f32x4){0.f, 0.f, 0.f, 0.f}); v0 = v0 * v0; v1 = v1 * v1;
                    *(u32x4*)(H + (size_t)row * 4096 + col0 + bj * HALF) = pack8(v0, v1); } asm volatile("" ::: "memory"); }
    }
};
struct EpiPlain {
    static constexpr bool PERM = true, AFTER_DRAIN = false;
    bf16_t* O;
    __device__ __forceinline__ void operator()(const f32x4 (&acc)[2][2][4][2], const Unit& u, int wr, int wc, int fr, int fq) const {
        const int row0 = u.pm * BM + wr * 64 + fr, col0 = u.pn * BM + wc * 32 + 8 * fq;
#pragma unroll
        for (int ai = 0; ai < 2; ++ai)
#pragma unroll
            for (int m = 0; m < 4; ++m) { const int row = row0 + ai * HALF + m * 16;
#pragma unroll
                for (int bj = 0; bj < 2; ++bj) *(u32x4*)(O + (size_t)row * 1024 + col0 + bj * HALF) = pack8(acc[ai][bj][m][0], acc[ai][bj][m][1]); }
    }
};

template <class Epi, class Sched, bool ALIGN_EPI = false, bool SP2 = false>
__device__ __forceinline__ void gemm_phase(PG8_LAS unsigned char* lds, const Gemm g, const Sched& S, const Epi& E, const int wave_id) {
    unsigned z_ = 0u; asm volatile("" : "+v"(z_)); const int tid_ = wave_id * 64 + (int)__builtin_amdgcn_mbcnt_hi(~0u, __builtin_amdgcn_mbcnt_lo(~0u, z_));
    const int tid = tid_, wid = wave_id, lane = tid & 63, wr = wid >> 2, wc = wid & 3, fr = lane & 15, fq = lane >> 4;
    const int K = g.K, nt = K / BK;
    unsigned voffA[2], voffB[2];
#pragma unroll
    for (int i = 0; i < 2; ++i) { int R, C; stage_rc(tid * 16 + i * 8192, R, C); const int Rb = Epi::PERM ? ((R & ~31) + perm32(R & 31)) : R;
        voffA[i] = (unsigned)(R * K + C) * 2u; voffB[i] = (unsigned)(Rb * K + C) * 2u; }
    const size_t kstep = (size_t)(BK * 2);
    const size_t hstep = (size_t)HALF * K * 2;
    const size_t tstep = 2 * hstep;
    const unsigned ldsw = (unsigned)wid * 1024u;
    const int aoff = lds_byte(wr * 64 + fr, fq * 8), boff = lds_byte(wc * 32 + fr, fq * 8);
#define PG8_SA(b, h) (((b) * 2 + (h)) * HTB)
#define PG8_SB(b, h) ((4 + (b) * 2 + (h)) * HTB)
#define PG8_STAGE(bufoff, gbase, voff) do { _Pragma("unroll") for (int _i = 0; _i < 2; ++_i) \
        __builtin_amdgcn_global_load_lds((const unsigned*)((const char*)(gbase) + (voff)[_i]), (PG8_LAS unsigned*)(lds + (bufoff) + ldsw + _i * 8192), 16, 0, 0); } while (0)
#define PG8_LDA(dst, b, h) do { _Pragma("unroll") for (int m = 0; m < 4; ++m) _Pragma("unroll") for (int k = 0; k < 2; ++k) dst[m][k] = *(const PG8_LAS bf16x8*)(lds + PG8_SA(b, h) + aoff + m * 2048 + k * 1024); } while (0)
#define PG8_LDB(dst, b, h) do { _Pragma("unroll") for (int n = 0; n < 2; ++n) _Pragma("unroll") for (int k = 0; k < 2; ++k) dst[n][k] = *(const PG8_LAS bf16x8*)(lds + PG8_SB(b, h) + boff + n * 2048 + k * 1024); } while (0)
#define PG8_MMA(ai, bj, At, Bt) do { __builtin_amdgcn_s_setprio(1); _Pragma("unroll") for (int m = 0; m < 4; ++m) _Pragma("unroll") for (int n = 0; n < 2; ++n) _Pragma("unroll") for (int k = 0; k < 2; ++k) \
        acc[ai][bj][m][n] = __builtin_amdgcn_mfma_f32_16x16x32_bf16(Bt[n][k], At[m][k], acc[ai][bj][m][n], 0, 0, 0); __builtin_amdgcn_s_setprio(0); } while (0)
#define PG8_WAIT_V(n) asm volatile("s_waitcnt vmcnt(" #n ")" ::: "memory")
#define PG8_WAIT_L(n) asm volatile("s_waitcnt lgkmcnt(" #n ")" ::: "memory")
#define PG8_BAR __builtin_amdgcn_s_barrier()
#define PG8_SCHED __builtin_amdgcn_sched_barrier(0)
    Unit cur, nxt; int ui = 0;
    if (!S.next(0, cur)) return;
    f32x4 acc[2][2][4][2];
#pragma unroll
    for (int a = 0; a < 2; ++a)
#pragma unroll
        for (int b = 0; b < 2; ++b)
#pragma unroll
            for (int m = 0; m < 4; ++m)
#pragma unroll
                for (int n = 0; n < 2; ++n) acc[a][b][m][n] = (f32x4){0.f, 0.f, 0.f, 0.f};
    bf16x8 At[4][2], B0[2][2], B1[2][2];
    const char* cA = (const char*)g.A + (size_t)cur.pm * tstep; const char* cB = (const char*)g.Bt + (size_t)cur.pn * tstep;
    S.a_ready(cur);
    if constexpr (SP2) {
        PG8_STAGE(PG8_SB(0, 0), cB, voffB); PG8_STAGE(PG8_SB(0, 1), cB + hstep, voffB); PG8_STAGE(PG8_SA(0, 0), cA, voffA); PG8_STAGE(PG8_SA(0, 1), cA + hstep, voffA);
        if (wr == 1) PG8_BAR;
        PG8_WAIT_V(2); PG8_BAR;
        PG8_STAGE(PG8_SB(1, 0), cB + kstep, voffB); PG8_STAGE(PG8_SA(1, 0), cA + kstep, voffA); PG8_STAGE(PG8_SB(1, 1), cB + hstep + kstep, voffB);
        PG8_WAIT_V(6); PG8_BAR;
    } else {
        PG8_STAGE(PG8_SB(0, 0), cB, voffB); PG8_STAGE(PG8_SA(0, 0), cA, voffA); PG8_STAGE(PG8_SB(0, 1), cB + hstep, voffB); PG8_STAGE(PG8_SA(0, 1), cA + hstep, voffA);
        if (wr == 1) PG8_BAR;
        PG8_WAIT_V(4); PG8_BAR;
        PG8_STAGE(PG8_SB(1, 0), cB + kstep, voffB); PG8_STAGE(PG8_SA(1, 0), cA + kstep, voffA); PG8_STAGE(PG8_SB(1, 1), cB + hstep + kstep, voffB);
        PG8_WAIT_V(6); PG8_BAR;
    }
    for (;;) {
        const bool has_next = S.next(ui + 1, nxt);
        const char* nA = has_next ? (const char*)g.A + (size_t)nxt.pm * tstep : cA; const char* nB = has_next ? (const char*)g.Bt + (size_t)nxt.pn * tstep : cB;
        for (int t = 0; t < nt; t += 2) {
            const bool last = (t == nt - 2);
            const char* a1 = cA + (size_t)(t + 1) * kstep;
            const char* a2 = last ? nA : cA + (size_t)(t + 2) * kstep; const char* b2 = last ? nB : cB + (size_t)(t + 2) * kstep;
            const char* a3 = a2 + kstep; const char* b3 = b2 + kstep;
            if (last && has_next) S.a_ready(nxt);
            if constexpr (SP2) {
            PG8_LDB(B0, 0, 0); PG8_LDB(B1, 0, 1); PG8_SCHED; PG8_LDA(At, 0, 0); PG8_STAGE(PG8_SA(1, 1), a1 + hstep, voffA);
            PG8_WAIT_V(8); PG8_WAIT_L(0); PG8_BAR; PG8_MMA(0, 0, At, B0); PG8_MMA(0, 1, At, B1); PG8_BAR; PG8_SCHED;
            PG8_LDA(At, 0, 1); PG8_STAGE(PG8_SB(0, 0), b2, voffB); PG8_STAGE(PG8_SB(0, 1), b2 + hstep, voffB); PG8_STAGE(PG8_SA(0, 0), a2, voffA);
            PG8_WAIT_V(8); PG8_WAIT_L(0); PG8_BAR; PG8_MMA(1, 0, At, B0); PG8_MMA(1, 1, At, B1); PG8_BAR; PG8_SCHED;
            PG8_LDB(B0, 1, 0); PG8_LDB(B1, 1, 1); PG8_SCHED; PG8_LDA(At, 1, 0); PG8_STAGE(PG8_SA(0, 1), a2 + hstep, voffA);
            PG8_WAIT_V(8); PG8_WAIT_L(0); PG8_BAR; PG8_MMA(0, 0, At, B0); PG8_MMA(0, 1, At, B1); PG8_BAR; PG8_SCHED;
            PG8_LDA(At, 1, 1); PG8_STAGE(PG8_SB(1, 0), b3, voffB); PG8_STAGE(PG8_SB(1, 1), b3 + hstep, voffB); PG8_STAGE(PG8_SA(1, 0), a3, voffA);
            PG8_WAIT_V(8); PG8_WAIT_L(0); PG8_BAR; PG8_MMA(1, 0, At, B0); PG8_MMA(1, 1, At, B1); PG8_BAR; PG8_SCHED;
            } else {
            PG8_LDB(B0, 0, 0); PG8_SCHED; PG8_LDA(At, 0, 0); PG8_STAGE(PG8_SA(1, 1), a1 + hstep, voffA);
            PG8_WAIT_L(8); PG8_BAR; PG8_WAIT_L(0); PG8_MMA(0, 0, At, B0); PG8_BAR; PG8_SCHED;
            PG8_LDB(B1, 0, 1); PG8_STAGE(PG8_SB(0, 0), b2, voffB);
            PG8_BAR; PG8_WAIT_L(0); PG8_MMA(0, 1, At, B1); PG8_BAR;
            PG8_LDA(At, 0, 1); PG8_STAGE(PG8_SA(0, 0), a2, voffA);
            PG8_BAR; PG8_WAIT_L(0); PG8_MMA(1, 0, At, B0); PG8_BAR; PG8_SCHED;
            PG8_STAGE(PG8_SB(0, 1), b2 + hstep, voffB);
            PG8_WAIT_V(6); PG8_BAR; PG8_MMA(1, 1, At, B1); PG8_BAR;
            PG8_LDB(B0, 1, 0); PG8_SCHED; PG8_LDA(At, 1, 0); PG8_STAGE(PG8_SA(0, 1), a2 + hstep, voffA);
            PG8_WAIT_L(8); PG8_BAR; PG8_WAIT_L(0); PG8_MMA(0, 0, At, B0); PG8_BAR; PG8_SCHED;
            PG8_LDB(B1, 1, 1); PG8_STAGE(PG8_SB(1, 0), b3, voffB);
            PG8_BAR; PG8_WAIT_L(0); PG8_MMA(0, 1, At, B1); PG8_BAR;
            PG8_LDA(At, 1, 1); PG8_STAGE(PG8_SA(1, 0), a3, voffA);
            PG8_BAR; PG8_WAIT_L(0); PG8_MMA(1, 0, At, B0); PG8_BAR; PG8_SCHED;
            PG8_STAGE(PG8_SB(1, 1), b3 + hstep, voffB);
            PG8_WAIT_V(6); PG8_BAR; PG8_MMA(1, 1, At, B1); PG8_BAR;
            }
        }
        if constexpr (ALIGN_EPI) { if (wr == 0) PG8_BAR; }
        if constexpr (!Epi::AFTER_DRAIN) { E(acc, cur, wr, wc, fr, fq); S.done(cur); }
        if (!has_next) break;
#pragma unroll
        for (int a = 0; a < 2; ++a)
#pragma unroll
            for (int b = 0; b < 2; ++b)
#pragma unroll
                for (int m = 0; m < 4; ++m)
#pragma unroll
                    for (int n = 0; n < 2; ++n) acc[a][b][m][n] = (f32x4){0.f, 0.f, 0.f, 0.f};
        cur = nxt; cA = nA; cB = nB; ++ui;
        if constexpr (ALIGN_EPI) { if (wr == 1) PG8_BAR; }
    }
    PG8_WAIT_V(0);
    if constexpr (!ALIGN_EPI) { if (wr == 0) PG8_BAR; }
    PG8_BAR;
    if constexpr (Epi::AFTER_DRAIN) { E.fused(acc, cur, wr, wc, fr, fq, lds, wid, lane); S.done(cur); }
#undef PG8_SA
#undef PG8_SB
#undef PG8_STAGE
#undef PG8_LDA
#undef PG8_LDB
#undef PG8_MMA
#undef PG8_WAIT_V
#undef PG8_WAIT_L
#undef PG8_BAR
#undef PG8_SCHED
}
}

constexpr int NWAVES = 8;
constexpr int NB = 8, SEQ = 8192, D = 1024, DEPTH = 2, CCH = 512, CONVW = 31, RH = 4, RD = 128, RW = 512, RC = 128, FF = 4096, PLE = 256, INC = 3072;
constexpr int M = NB * SEQ;
constexpr int ZP = 2560;
constexpr float LN_EPS = 1e-5f;
constexpr size_t MiB = 1u << 20;
constexpr size_t WS_CTL = 0, CTL_ZERO_BYTES = 1 * MiB;
constexpr size_t WS_W = 2 * MiB, W_LAYER = 27 * MiB;
constexpr size_t WO_IN = 0, WO_OUT = 6 * MiB, WO_FF1 = 8 * MiB, WO_FF2 = 16 * MiB, WO_GATE = 24 * MiB, WO_PROJ = 26 * MiB;
constexpr size_t WS_SS = 56 * MiB, SS_SITE = 4 * MiB;
constexpr size_t WS_ROPE = 84 * MiB;
constexpr size_t WS_XB = 100 * MiB;
constexpr size_t WS_PB = 228 * MiB;
constexpr size_t WS_PROJ = 292 * MiB;
constexpr size_t WS_ZB = 420 * MiB;
constexpr size_t WS_T = 740 * MiB;
constexpr size_t WS_MIX = 756 * MiB;
constexpr size_t WS_HID = 420 * MiB;
constexpr size_t WS_END = 932 * MiB;
constexpr size_t WS_U = WS_XB, WS_S = WS_PROJ;
constexpr int CW_TMO = 0, CW_BAR = 4096;
constexpr int LDS_BYTES = 163840, RING_OFF = 0, MISC_OFF = 163840 - 256, ARGS_OFF = 163840 - 512;

#define GAS __attribute__((address_space(1)))
#define LAS __attribute__((address_space(3)))
typedef unsigned short bf16;
typedef unsigned v4u __attribute__((ext_vector_type(4)));
typedef float f32x4 __attribute__((ext_vector_type(4)));
typedef GAS unsigned gu32;
#define RLX_AGENT __ATOMIC_RELAXED, __HIP_MEMORY_SCOPE_AGENT
#define LDS_WAIT() asm volatile("s_waitcnt lgkmcnt(0)" ::: "memory")
__device__ __forceinline__ unsigned f2bf(float f) { unsigned u = __builtin_bit_cast(unsigned, f); return (u + 0x7fffu + ((u >> 16) & 1u)) >> 16; }
__device__ __forceinline__ unsigned pk2(float lo, float hi) { return f2bf(lo) | (f2bf(hi) << 16); }
__device__ __forceinline__ float bf2f(unsigned short b) { return __uint_as_float(((unsigned)b) << 16); }

__device__ __forceinline__ float wave_sum(float v) {
#pragma unroll
    for (int o = 1; o < 64; o <<= 1) v += __shfl_xor(v, o);
    return v;
}
#define XB_TMO      128
#define XB_XCNT(j)  (256  + 64 * (j))
#define XB_XSUB(j)  (1280 + 64 * (j))
#define XB_XGEN(j)  (2304 + 64 * (j))
#define XB_TOP      3328
#define XB_TOPGEN   3392
#define XCD_BAR_WORDS 3456
#define XB_SPIN_CAP (1u << 18)

__device__ __forceinline__ unsigned xb_ld(unsigned* p)              { return __hip_atomic_load(p, __ATOMIC_RELAXED, __HIP_MEMORY_SCOPE_AGENT); }
__device__ __forceinline__ unsigned xb_add(unsigned* p, unsigned v) { return __hip_atomic_fetch_add(p, v, __ATOMIC_RELAXED, __HIP_MEMORY_SCOPE_AGENT); }
__device__ __forceinline__ unsigned xb_xcc_id() { return (unsigned)__builtin_amdgcn_s_getreg((3 << 11) | 20) & 0xFu; }
#define XB_SPIN(cond, bar) do { unsigned _sp = 0; while (cond) { __builtin_amdgcn_s_sleep(1); \
    if ((++_sp & 255u) == 0u) { if (xb_ld(&(bar)[XB_TMO])) break; if (_sp > XB_SPIN_CAP) { atomicAdd(&(bar)[XB_TMO], 1u); break; } } } } while (0)

__device__ __forceinline__ int xb_fresh_lane() { unsigned z = 0u; asm volatile("" : "+v"(z)); return (int)__builtin_amdgcn_mbcnt_hi(~0u, __builtin_amdgcn_mbcnt_lo(~0u, z)); }
struct XcdBarrier {
    unsigned* bar; unsigned x; int wave;
    volatile LAS unsigned* st;
};

__device__ __forceinline__ XcdBarrier xcd_barrier_post(unsigned* bar, volatile LAS unsigned* st, int wave) {
    XcdBarrier b; b.bar = bar; b.x = xb_xcc_id(); b.st = st; b.wave = wave;
    if (wave == 0 && xb_fresh_lane() == 0) (void)xb_add(&bar[XB_XCNT(b.x)], 1u);
    return b;
}
__device__ __forceinline__ void xcd_barrier_complete(unsigned* bar, unsigned x, unsigned& nloc, unsigned& nx) {
    const unsigned G = gridDim.x * gridDim.y * gridDim.z;
    unsigned sum, cnt, mine, sp = 0u;
    for (;;) {
        sum = 0u; cnt = 0u; mine = 0u;
#pragma unroll
        for (unsigned j = 0; j < 16; ++j) { const unsigned c = xb_ld(&bar[XB_XCNT(j)]); sum += c; cnt += (c > 0u) ? 1u : 0u; mine = (j == x) ? c : mine; }
        if (sum == G) break;
        __builtin_amdgcn_s_sleep(1);
        if ((++sp & 255u) == 0u) { if (xb_ld(&bar[XB_TMO])) break; if (sp > XB_SPIN_CAP) { atomicAdd(&bar[XB_TMO], 1u); break; } }
    }
    nloc = mine > 0u ? mine : 1u; nx = cnt > 0u ? cnt : 1u;
}

__device__ __forceinline__ void xcd_barrier(const XcdBarrier& b) {
    asm volatile("s_waitcnt vmcnt(0)" ::: "memory");
    __syncthreads();
    if (b.wave == 0 && xb_fresh_lane() == 0) {
        unsigned* bar = b.bar;
        __builtin_amdgcn_s_waitcnt(0);
        unsigned nloc = b.st[0], nx = b.st[1];
        if (nloc == 0u) { xcd_barrier_complete(bar, b.x, nloc, nx); b.st[0] = nloc; b.st[1] = nx; }
        const unsigned old = xb_add(&bar[XB_XSUB(b.x)], 1u);
        const unsigned gen = old / nloc;
        if (old + 1u == (gen + 1u) * nloc) {
            __builtin_amdgcn_fence(__ATOMIC_RELEASE, "agent");
            asm volatile("s_waitcnt vmcnt(0)" ::: "memory");
            const unsigned og = xb_add(&bar[XB_TOP], 1u);
            const unsigned tg = og / nx;
            if (og + 1u == (tg + 1u) * nx) xb_add(&bar[XB_TOPGEN], 1u);
            else XB_SPIN(xb_ld(&bar[XB_TOPGEN]) == tg, bar);
            __builtin_amdgcn_fence(__ATOMIC_ACQUIRE, "agent");
            xb_add(&bar[XB_XGEN(b.x)], 1u);
            asm volatile("s_waitcnt vmcnt(0)" ::: "memory");
        } else {
            XB_SPIN(xb_ld(&bar[XB_XGEN(b.x)]) == gen, bar);
            __builtin_amdgcn_fence(__ATOMIC_ACQUIRE, "agent");
            asm volatile("s_waitcnt vmcnt(0)" ::: "memory");
        }
    }
    __syncthreads();
}

namespace mx {
typedef short s16x4 __attribute__((ext_vector_type(4)));
typedef short v4i16_t __attribute__((ext_vector_type(4)));
typedef short bf16x8 __attribute__((ext_vector_type(8)));
typedef float f32x2 __attribute__((ext_vector_type(2)));
typedef unsigned u32x2 __attribute__((ext_vector_type(2)));
constexpr int KI = 0, VI = 32768, QI = 65536, SI = 98304;

__device__ __forceinline__ unsigned off_b(unsigned row, unsigned ch) { return 256u * row + 16u * (ch ^ (((row & 3u) << 2) | ((row >> 2) & 3u))); }
__device__ __forceinline__ unsigned tr_addr(unsigned lane, unsigned c, unsigned ks, unsigned t) {
    const unsigned g = lane >> 4, q = (lane & 15u) >> 2, p = lane & 3u; return off_b(32u * ks + 8u * g + 4u * t + q, 2u * c + (p >> 1)) + 8u * (p & 1u);
}
__device__ __forceinline__ bf16x8 tr_frag(LAS const unsigned char* img, unsigned lane, unsigned c, unsigned ks) {
    const s16x4 lo = __builtin_bit_cast(s16x4, __builtin_amdgcn_ds_read_tr16_b64_v4i16((LAS v4i16_t*)(img + tr_addr(lane, c, ks, 0))));
    const s16x4 hi = __builtin_bit_cast(s16x4, __builtin_amdgcn_ds_read_tr16_b64_v4i16((LAS v4i16_t*)(img + tr_addr(lane, c, ks, 1))));
    return __builtin_shufflevector(lo, hi, 0, 1, 2, 3, 4, 5, 6, 7);
}
__device__ __forceinline__ bf16x8 row_frag(LAS const unsigned char* img, unsigned row, unsigned ch) { return *(LAS const bf16x8*)(img + off_b(row, ch)); }
__device__ __forceinline__ float gamma_log(int h) { return logf(1.0f - exp2f(-5.0f - (float)h)); }
__device__ __forceinline__ float to_sgpr(float v) { return __builtin_bit_cast(float, __builtin_amdgcn_readfirstlane(__builtin_bit_cast(int, v))); }
__device__ __forceinline__ int opaque_s(int v) { asm volatile("" : "+s"(v)); return v; }

template <bool SCALE> __device__ __forceinline__ void stage_tile(LAS unsigned char* img, const bf16* src, float rowscale, int tid) {
    const int row = tid >> 2, c0 = (tid & 3) * 4;
    const GAS v4u* g = (const GAS v4u*)(src + (size_t)row * ZP + c0 * 8);
    v4u v[4];
#pragma unroll
    for (int c = 0; c < 4; ++c) v[c] = g[c];
#pragma unroll
    for (int c = 0; c < 4; ++c) {
        v4u o = v[c];
        if (SCALE) {
            const unsigned w[4] = {o.x, o.y, o.z, o.w}; unsigned r[4];
#pragma unroll
            for (int i = 0; i < 4; ++i) r[i] = pg8::cvt_pk_bf16(__uint_as_float(w[i] << 16) * rowscale, __uint_as_float(w[i] & 0xffff0000u) * rowscale);
            o.x = r[0]; o.y = r[1]; o.z = r[2]; o.w = r[3];
        }
        *(LAS v4u*)(img + off_b(row, c0 + c)) = o;
    }
}
#define MX_MFMA(a, b, c) __builtin_amdgcn_mfma_f32_16x16x32_bf16((a), (b), (c), 0, 0, 0)

__device__ __forceinline__ void conv_phase(LAS unsigned char* L, const bf16* ZB, bf16* MIXB, const float* dw_w, const float* dw_b, const float* ln_g, const float* ln_b, int bx, int wave) {
    const int lane0 = xb_fresh_lane(), cp0 = (wave * 64 + lane0) & 255, half = wave >> 2;
    f32x2 w2[CONVW];
#pragma unroll
    for (int j = 0; j < CONVW; ++j) w2[j] = *(const GAS f32x2*)(dw_w + j * CCH + 2 * cp0);
    const f32x2 b2 = *(const GAS f32x2*)(dw_b + 2 * cp0);
    LAS float* CT = (LAS float*)L;
    for (int tile = 0; tile < 4; ++tile) {
        int lane = lane0; asm volatile("" : "+v"(lane));
        const int cp = (wave * 64 + lane) & 255;
        const int mt = bx * 256 + tile * 64, t0 = (mt % SEQ) + 32 * half;
        const bf16* src = ZB + ((long)(mt + 32 * half) - (CONVW - 1)) * ZP + 2 * cp;
        f32x2 acc[32];
#pragma unroll
        for (int t = 0; t < 32; ++t) acc[t] = b2;
#pragma unroll
        for (int r = 0; r < 32 + CONVW - 1; ++r) {
            unsigned u = 0u; if (t0 - (CONVW - 1) + r >= 0) u = *(const GAS unsigned*)(src + (long)r * ZP);
            const f32x2 h2 = {__uint_as_float(u << 16), __uint_as_float(u & 0xffff0000u)};
#pragma unroll
            for (int t = (r - (CONVW - 1) > 0 ? r - (CONVW - 1) : 0); t <= (r < 31 ? r : 31); ++t) acc[t] = w2[r - t] * h2 + acc[t];
        }
#pragma unroll
        for (int t = 0; t < 32; ++t) *(LAS f32x2*)(CT + (32 * half + t) * CCH + 2 * cp) = acc[t];
        __syncthreads();
        {
            const f32x4 g0 = *(const GAS f32x4*)(ln_g + 8 * lane), g1 = *(const GAS f32x4*)(ln_g + 8 * lane + 4), be0 = *(const GAS f32x4*)(ln_b + 8 * lane), be1 = *(const GAS f32x4*)(ln_b + 8 * lane + 4);
#pragma unroll 2
            for (int i = 0; i < 8; ++i) {
                const int tok = 8 * wave + i;
                f32x4 v0 = *(LAS f32x4*)(CT + tok * CCH + 8 * lane), v1 = *(LAS f32x4*)(CT + tok * CCH + 8 * lane + 4);
                const float mean = wave_sum((v0[0] + v0[1]) + (v0[2] + v0[3]) + (v1[0] + v1[1]) + (v1[2] + v1[3])) * (1.0f / CCH);
                v0 = v0 - mean; v1 = v1 - mean;
                const float rstd = rsqrtf(wave_sum((v0[0] * v0[0] + v0[1] * v0[1]) + (v0[2] * v0[2] + v0[3] * v0[3]) + (v1[0] * v1[0] + v1[1] * v1[1]) + (v1[2] * v1[2] + v1[3] * v1[3])) * (1.0f / CCH) + LN_EPS);
                v0 = v0 * rstd * g0 + be0; v1 = v1 * rstd * g1 + be1;
                v0 = v0 * pg8::sig4(v0); v1 = v1 * pg8::sig4(v1);
                *(GAS v4u*)(MIXB + (size_t)(mt + tok) * D + 8 * lane) = pg8::pack8(v0, v1);
            }
        }
        __syncthreads();
    }
}

__device__ __forceinline__ void state_mfma(f32x4 (&sacc)[8], LAS const unsigned char* Kimg, LAS const unsigned char* Vimg, int wave, int lane) {
#pragma unroll
    for (int kp = 0; kp < 4; ++kp) {
        const bf16x8 kf = tr_frag(Kimg, lane, wave, kp);
#pragma unroll
        for (int eb = 0; eb < 8; ++eb) { const bf16x8 vf = tr_frag(Vimg, lane, eb, kp); sacc[eb] = MX_MFMA(kf, vf, sacc[eb]); }
    }
}
__device__ __forceinline__ void ret_state_phase(LAS unsigned char* L, const bf16* ZB, float* Tf, int bx, int wave) {
    const int lane0 = xb_fresh_lane(), bh = bx >> 3, cg = bx & 7, b = bh >> 2, h = opaque_s(bh & 3);
    const float lg = to_sgpr(gamma_log(h)), kscale = expf(-(float)((wave * 64 + lane0) >> 2) * lg), g1 = to_sgpr(expf(lg)), g127 = to_sgpr(expf(127.0f * lg));
    f32x4 sacc[8];
#pragma unroll
    for (int eb = 0; eb < 8; ++eb) sacc[eb] = (f32x4){0.f, 0.f, 0.f, 0.f};
    for (int j = 0; j < 8; ++j) {
        int lane = lane0; asm volatile("" : "+v"(lane));
        const int tid = wave * 64 + lane;
        const size_t m0 = (size_t)b * SEQ + (size_t)(cg * 8 + j) * RC;
        stage_tile<true>(L + KI, ZB + m0 * ZP + 1024 + h * RD, kscale, tid);
        stage_tile<false>(L + VI, ZB + m0 * ZP + 1536 + h * RD, 1.0f, tid);
        __syncthreads();
#pragma unroll
        for (int eb = 0; eb < 8; ++eb) sacc[eb] = sacc[eb] * g1;
        state_mfma(sacc, L + KI, L + VI, wave, lane);
#pragma unroll
        for (int eb = 0; eb < 8; ++eb) sacc[eb] = sacc[eb] * g127;
        __syncthreads();
    }
    GAS f32x4* dst = (GAS f32x4*)Tf + (size_t)(bx * 8 + wave) * 8 * 64 + lane0;
#pragma unroll
    for (int eb = 0; eb < 8; ++eb) dst[eb * 64] = sacc[eb];
}
__device__ __forceinline__ void ret_out_phase(LAS unsigned char* L, const bf16* ZB, bf16* MIXB, const float* Tf, const float* gn_g, const float* gn_b, int bx, int wave) {
    const int lane0 = xb_fresh_lane(), bh = bx >> 3, cg = bx & 7, b = bh >> 2, h = opaque_s(bh & 3);
    const float lg = to_sgpr(gamma_log(h)), kscale = expf(-(float)((wave * 64 + lane0) >> 2) * lg), qscale = expf((float)((wave * 64 + lane0) >> 2) * lg), g1 = to_sgpr(expf(lg)), g127 = to_sgpr(expf(127.0f * lg)), cd8 = to_sgpr(expf(1024.0f * lg));
    f32x4 sacc[8];
#pragma unroll
    for (int eb = 0; eb < 8; ++eb) sacc[eb] = (f32x4){0.f, 0.f, 0.f, 0.f};
    { float coef = 1.0f;
      for (int g2 = cg - 1; g2 >= 0; --g2) { const GAS f32x4* src = (const GAS f32x4*)Tf + (size_t)((bh * 8 + g2) * 8 + wave) * 8 * 64 + lane0;
#pragma unroll
          for (int eb = 0; eb < 8; ++eb) sacc[eb] = sacc[eb] + src[eb * 64] * coef;
          coef *= cd8; } }
    for (int j = 0; j < 8; ++j) {
        int lane = lane0; asm volatile("" : "+v"(lane));
        const int tid = wave * 64 + lane, g = lane >> 4, li = lane & 15;
        const size_t m0 = (size_t)b * SEQ + (size_t)(cg * 8 + j) * RC;
        stage_tile<true>(L + KI, ZB + m0 * ZP + 1024 + h * RD, kscale, tid); __builtin_amdgcn_sched_barrier(0);
        stage_tile<false>(L + VI, ZB + m0 * ZP + 1536 + h * RD, 1.0f, tid); __builtin_amdgcn_sched_barrier(0);
        stage_tile<true>(L + QI, ZB + m0 * ZP + 512 + h * RD, qscale, tid); __builtin_amdgcn_sched_barrier(0);
#pragma unroll
        for (int eb = 0; eb < 8; ++eb) { const f32x4 sv = sacc[eb] * g1; u32x2 w; w.x = pg8::cvt_pk_bf16(sv[0], sv[1]); w.y = pg8::cvt_pk_bf16(sv[2], sv[3]);
            *(LAS u32x2*)(L + SI + off_b(16 * eb + li, 2 * wave + (g >> 1)) + 8 * (g & 1)) = w; }
        __syncthreads(); __builtin_amdgcn_sched_barrier(0);
        bf16x8 qf[4];
#pragma unroll
        for (int ks = 0; ks < 4; ++ks) qf[ks] = row_frag(L + QI, 16 * wave + li, 4 * ks + g);
        bf16x8 pf[4];
#pragma unroll
        for (int kp = 0; kp < 4; ++kp) {
            unsigned pw[4] = {0u, 0u, 0u, 0u};
            if (kp <= (wave >> 1)) {
#pragma unroll
                for (int t = 0; t < 2; ++t) {
                    f32x4 x = (f32x4){0.f, 0.f, 0.f, 0.f};
                    const unsigned krow = 32 * kp + 8 * (li >> 2) + 4 * t + (li & 3);
#pragma unroll
                    for (int ks = 0; ks < 4; ++ks) x = MX_MFMA(row_frag(L + KI, krow, 4 * ks + g), qf[ks], x);
                    { const int key0 = 32 * kp + 8 * g + 4 * t, ql = 16 * wave + li;
#pragma unroll
                        for (int r = 0; r < 4; ++r) x[r] = (key0 + r <= ql) ? x[r] : 0.f; }
                    pw[2 * t] = pg8::cvt_pk_bf16(x[0], x[1]); pw[2 * t + 1] = pg8::cvt_pk_bf16(x[2], x[3]);
                }
            }
            pf[kp] = __builtin_bit_cast(bf16x8, (v4u){pw[0], pw[1], pw[2], pw[3]}); __builtin_amdgcn_sched_barrier(0);
        }
        f32x4 o[8];
#pragma unroll
        for (int eb = 0; eb < 8; ++eb) o[eb] = (f32x4){0.f, 0.f, 0.f, 0.f};
#pragma unroll
        for (int eb = 0; eb < 8; ++eb) {
#pragma unroll
            for (int ks = 0; ks < 4; ++ks) o[eb] = MX_MFMA(row_frag(L + SI, 16 * eb + li, 4 * ks + g), qf[ks], o[eb]);
            if (eb & 1) __builtin_amdgcn_sched_barrier(0); }
#pragma unroll
        for (int eb = 0; eb < 8; ++eb) sacc[eb] = sacc[eb] * g1;
#pragma unroll
        for (int kp = 0; kp < 4; ++kp) {
            const bf16x8 kf = tr_frag(L + KI, lane, wave, kp);
#pragma unroll
            for (int eb = 0; eb < 8; ++eb) { const bf16x8 vf = tr_frag(L + VI, lane, eb, kp);
                o[eb] = MX_MFMA(vf, pf[kp], o[eb]);
                sacc[eb] = MX_MFMA(kf, vf, sacc[eb]); if (eb & 1) __builtin_amdgcn_sched_barrier(0); }
        }
#pragma unroll
        for (int eb = 0; eb < 8; ++eb) sacc[eb] = sacc[eb] * g127;
        float s1 = 0.f;
#pragma unroll
        for (int eb = 0; eb < 8; ++eb) s1 += (o[eb][0] + o[eb][1]) + (o[eb][2] + o[eb][3]);
        s1 += __shfl_xor(s1, 16); s1 += __shfl_xor(s1, 32);
        const float mean = s1 * (1.0f / RD); float s2 = 0.f;
#pragma unroll
        for (int eb = 0; eb < 8; ++eb) { o[eb] = o[eb] - mean; s2 += (o[eb][0] * o[eb][0] + o[eb][1] * o[eb][1]) + (o[eb][2] * o[eb][2] + o[eb][3] * o[eb][3]); }
        s2 += __shfl_xor(s2, 16); s2 += __shfl_xor(s2, 32);
        const float rstd = rsqrtf(s2 * (1.0f / RD) + LN_EPS); __builtin_amdgcn_sched_barrier(0);
        const size_t mrow = m0 + 16 * wave + li;
#pragma unroll
        for (int eb = 0; eb < 8; ++eb) { const int e0 = h * RD + 16 * eb + 4 * g;
            const f32x4 gg = *(const GAS f32x4*)(gn_g + e0), gb = *(const GAS f32x4*)(gn_b + e0);
            const u32x2 gw = *(const GAS u32x2*)(ZB + mrow * ZP + 2048 + e0);
            const f32x4 gt = (f32x4){__uint_as_float(gw.x << 16), __uint_as_float(gw.x & 0xffff0000u), __uint_as_float(gw.y << 16), __uint_as_float(gw.y & 0xffff0000u)};
            const f32x4 y = (o[eb] * rstd * gg + gb) * gt;
            u32x2 w; w.x = pg8::cvt_pk_bf16(y[0], y[1]); w.y = pg8::cvt_pk_bf16(y[2], y[3]);
            *(GAS u32x2*)(MIXB + mrow * D + CCH + e0) = w; if (eb & 1) __builtin_amdgcn_sched_barrier(0); }
        __syncthreads();
    }
}
#undef MX_MFMA
}

struct Args {
    const float* x; const float* p; const int* pos; const float* norm_mix_g; const float* w_in; const float* dw_w; const float* dw_b; const float* ln_g; const float* ln_b;
    const float* gn_g; const float* gn_b; const float* w_out; const float* norm_ffn_g; const float* w_ff1; const float* w_ff2; const float* norm_ple_g; const float* w_gate; const float* w_proj;
    const float* final_g; float* out; unsigned char* ws; int ph_lo, ph_hi, li, pad;
};
__device__ __forceinline__ int inmap(int s) {
    if (s < 512) return 256 * (s >> 7) + (s & 127);
    if (s < 1024) { const int ch = s - 512; return 256 * (ch >> 7) + 128 + (ch & 127); }
    if (s < 2048) { const int k = s >= 1536, r = s - (k ? 1536 : 1024), hq = r >> 7, dd = r & 127; return 256 * ((k ? 6 : 4) + (hq >> 1)) + 128 * (dd >> 6) + 64 * (hq & 1) + (dd & 63); }
    return s;
}
template <bool INMAP> __device__ __forceinline__ void tr_item(const float* W, int K, int N, const float* gain, bf16* WT, LAS float* scr, int item, int lane) {
    const int nblk = N / 32, kb = item / nblk, nb = item % nblk, k0 = 64 * kb, n0 = 32 * nb;
#pragma unroll 8
    for (int i = 0; i < 32; ++i) { const int kk = 2 * i + (lane >> 5); scr[kk * 33 + (lane & 31)] = W[(size_t)(k0 + kk) * N + n0 + (lane & 31)] * (gain ? gain[k0 + kk] : 1.0f); }
    LDS_WAIT(); asm volatile("" ::: "memory");
    const int c = lane & 7;
#pragma unroll
    for (int j = 0; j < 4; ++j) { const int n = (lane >> 3) + 8 * j; const LAS float* s = scr + (8 * c) * 33 + n;
        const int src = n0 + n; const int r = INMAP ? inmap(src) : src; const float cs = (INMAP && src >= 1536 && src < 2048) ? 0.088388347648318447f : 1.0f;
        v4u o; o.x = pk2(s[0 * 33] * cs, s[1 * 33] * cs); o.y = pk2(s[2 * 33] * cs, s[3 * 33] * cs); o.z = pk2(s[4 * 33] * cs, s[5 * 33] * cs); o.w = pk2(s[6 * 33] * cs, s[7 * 33] * cs);
        *(GAS v4u*)(WT + (size_t)r * K + k0 + 8 * c) = o; }
    LDS_WAIT(); asm volatile("" ::: "memory");
}

__device__ __forceinline__ const void* lds_ptr(LAS unsigned char* p) {
    const unsigned lo = __builtin_amdgcn_readfirstlane(((volatile LAS unsigned*)p)[0]), hi = __builtin_amdgcn_readfirstlane(((volatile LAS unsigned*)p)[1]);
    return (const void*)(((unsigned long long)hi << 32) | lo);
}
#ifndef PROBE_DUP
#define PROBE_DUP (-1)
#endif
#define DUPN(k) ((PROBE_DUP == (k)) ? 2 : 1)
__global__ void __launch_bounds__(NWAVES * 64, 2) mk_fwd(Args a) {
    extern __shared__ __attribute__((aligned(16))) unsigned char lds[];
    LAS unsigned char* const L = (LAS unsigned char*)lds;
    volatile LAS unsigned* MISC = (volatile LAS unsigned*)(L + MISC_OFF);
    const int wave = __builtin_amdgcn_readfirstlane(threadIdx.x >> 6);
#define LANE_ID() xb_fresh_lane()
    const int G = gridDim.x, bx = blockIdx.x;
    unsigned char* ws = a.ws;
    gu32* ctl = (gu32*)(ws + WS_CTL);
    if (threadIdx.x < 64) MISC[threadIdx.x] = 0u;
    if (threadIdx.x < sizeof(Args) / 4) ((volatile LAS unsigned*)(L + ARGS_OFF))[threadIdx.x] = ((const unsigned*)&a)[threadIdx.x];
    __syncthreads();
#define ARGP(field) ((decltype(a.field))lds_ptr(L + ARGS_OFF + offsetof(Args, field)))
    XcdBarrier bar = xcd_barrier_post((unsigned*)(ctl + CW_BAR) + a.li * XCD_BAR_WORDS, MISC + 8, wave);
    const int lo = a.ph_lo, hi = a.ph_hi;
#define IN(k) (lo <= (k) && (k) < hi)
#define SEAM(k) do { if (IN(k) && IN((k) + 1)) xcd_barrier(bar); } while (0)
    const int gw = bx * NWAVES + wave, NGW = G * NWAVES;
    const size_t NGT = (size_t)G * NWAVES * 64;
    bf16* const XB = (bf16*)(ws + WS_XB); bf16* const ZB = (bf16*)(ws + WS_ZB); bf16* const MIXB = (bf16*)(ws + WS_MIX); bf16* const HID = (bf16*)(ws + WS_HID);
    bf16* const XBN = (bf16*)(ws + WS_MIX);
    float* const TF = (float*)(ws + WS_T);
    bf16* const PROJ = (bf16*)(ws + WS_PROJ); bf16* const PB = (bf16*)(ws + WS_PB); unsigned* const ROPE = (unsigned*)(ws + WS_ROPE);

    if (IN(0))
#pragma clang loop unroll(full)
    for (int rep = 0; rep < DUPN(0); ++rep) {
        const int lane = LANE_ID(); const size_t gt = (size_t)bx * (NWAVES * 64) + wave * 64 + lane;
        LAS float* scr = (LAS float*)(L + RING_OFF + wave * 16384);
        constexpr int I_IN = (D / 64) * (INC / 32), I_OUT = (D / 64) * (D / 32), I_F1 = (D / 64) * (FF / 32), I_F2 = (FF / 64) * (D / 32), I_G = I_OUT, I_P = (PLE / 64) * (D / 32);
        constexpr int I_LAYER = I_IN + I_OUT + I_F1 + I_F2 + I_G + I_P;
        for (int it = gw; it < DEPTH * I_LAYER; it += NGW) {
            const int l = it / I_LAYER; int r = it % I_LAYER; unsigned char* wl = ws + WS_W + (size_t)l * W_LAYER;
            if (r < I_IN) { tr_item<true>(a.w_in + (size_t)l * D * INC, D, INC, a.norm_mix_g + l * D, (bf16*)(wl + WO_IN), scr, r, lane); continue; } r -= I_IN;
            if (r < I_OUT) { tr_item<false>(a.w_out + (size_t)l * D * D, D, D, nullptr, (bf16*)(wl + WO_OUT), scr, r, lane); continue; } r -= I_OUT;
            if (r < I_F1) { tr_item<false>(a.w_ff1 + (size_t)l * D * FF, D, FF, a.norm_ffn_g + l * D, (bf16*)(wl + WO_FF1), scr, r, lane); continue; } r -= I_F1;
            if (r < I_F2) { tr_item<false>(a.w_ff2 + (size_t)l * FF * D, FF, D, nullptr, (bf16*)(wl + WO_FF2), scr, r, lane); continue; } r -= I_F2;
            if (r < I_G) { tr_item<false>(a.w_gate + (size_t)l * D * D, D, D, a.norm_ple_g + l * D, (bf16*)(wl + WO_GATE), scr, r, lane); continue; } r -= I_G;
            tr_item<false>(a.w_proj + (size_t)l * PLE * D, PLE, D, nullptr, (bf16*)(wl + WO_PROJ), scr, r, lane);
        }
        float* ss0 = (float*)(ws + WS_SS);
        for (int m = gw; m < M; m += NGW) {
            const GAS f32x4* xr = (const GAS f32x4*)(a.x + (size_t)m * D) + lane; f32x4 v[4]; float s = 0.f;
#pragma unroll
            for (int j = 0; j < 4; ++j) { v[j] = xr[64 * j]; s += (v[j].x * v[j].x + v[j].y * v[j].y) + (v[j].z * v[j].z + v[j].w * v[j].w); }
            s = wave_sum(s);
            GAS unsigned long long* o8 = (GAS unsigned long long*)(XB + (size_t)m * D) + lane;
#pragma unroll
            for (int j = 0; j < 4; ++j) o8[64 * j] = (unsigned long long)pk2(v[j].x, v[j].y) | ((unsigned long long)pk2(v[j].z, v[j].w) << 32);
            if (lane < 16) ss0[(size_t)m * 16 + lane] = lane == 0 ? s : 0.f;
        }
        for (size_t i = gt; i < (size_t)DEPTH * M * PLE / 8; i += NGT) {
            const f32x4 p0 = *(const GAS f32x4*)(a.p + i * 8), p1 = *(const GAS f32x4*)(a.p + i * 8 + 4);
            v4u o; o.x = pk2(p0.x, p0.y); o.y = pk2(p0.z, p0.w); o.z = pk2(p1.x, p1.y); o.w = pk2(p1.z, p1.w);
            *(GAS v4u*)(PB + i * 8) = o;
        }
        for (size_t i = gt; i < (size_t)M * 64; i += NGT) {
            const int d = (int)(i & 63); const size_t m = i >> 6;
            const float inv_freq = 1.0f / powf(10000.0f, (float)d * (2.0f / RD)), ang = (float)a.pos[m] * inv_freq;
            const pg8::f16x2 cs = {(_Float16)cosf(ang), (_Float16)sinf(ang)};
            ROPE[i] = __builtin_bit_cast(unsigned, cs);
        }
    }
    SEAM(0);
#pragma clang loop unroll(full)
    for (int l = 0; l < DEPTH; ++l) {
        const int pb = 1 + 8 * l;
        unsigned char* wl = ws + WS_W + (size_t)l * W_LAYER;
        float* const ss_a = (float*)(ws + WS_SS + (size_t)(3 * l + 0) * SS_SITE);
        float* const ss_b = (float*)(ws + WS_SS + (size_t)(3 * l + 1) * SS_SITE);
        float* const ss_c = (float*)(ws + WS_SS + (size_t)(3 * l + 2) * SS_SITE);
        float* const ss_d = (float*)(ws + WS_SS + (size_t)(3 * l + 3) * SS_SITE);
        if (IN(pb + 0))
#pragma clang loop unroll(full)
        for (int rep = 0; rep < DUPN(pb + 0); ++rep) {
            pg8::Gemm g{l == 0 ? XB : XBN, (const bf16*)(wl + WO_IN), M, INC, D}; pg8::StaticOrder S; S.init(M, INC, G, bx);
            pg8::EpiInProj E{ZB, ss_a, ROPE};
            pg8::gemm_phase<pg8::EpiInProj, pg8::StaticOrder, true, true>(L + RING_OFF, g, S, E, wave);
        }
        SEAM(pb + 0);
        if (IN(pb + 1))
#pragma clang loop unroll(full)
        for (int rep = 0; rep < DUPN(pb + 1); ++rep) {
            mx::conv_phase(L, ZB, MIXB, ARGP(dw_w) + l * CONVW * CCH, ARGP(dw_b) + l * CCH, ARGP(ln_g) + l * CCH, ARGP(ln_b) + l * CCH, bx, wave);
            mx::ret_state_phase(L, ZB, TF, bx, wave);
        }
        SEAM(pb + 1);
        if (IN(pb + 2))
#pragma clang loop unroll(full)
        for (int rep = 0; rep < DUPN(pb + 2); ++rep) mx::ret_out_phase(L, ZB, MIXB, TF, ARGP(gn_g) + l * RW, ARGP(gn_b) + l * RW, bx, wave);
        SEAM(pb + 2);
        if (IN(pb + 3))
#pragma clang loop unroll(full)
        for (int rep = 0; rep < (l == 0 ? DUPN(pb + 3) : 1); ++rep) {
            pg8::Gemm g{MIXB, (const bf16*)(wl + WO_OUT), M, D, D}; pg8::StaticOrder S; S.init(M, D, G, bx);
            pg8::EpiResid<0> E{l == 0 ? ARGP(x) : a.out, a.out, XB, ss_b, nullptr, nullptr};
            pg8::gemm_phase<pg8::EpiResid<0>, pg8::StaticOrder, true, true>(L + RING_OFF, g, S, E, wave);
        }
        SEAM(pb + 3);
        if (IN(pb + 4))
#pragma clang loop unroll(full)
        for (int rep = 0; rep < DUPN(pb + 4); ++rep) {
            pg8::Gemm g{XB, (const bf16*)(wl + WO_FF1), M, FF, D}; pg8::StaticOrder S; S.init(M, FF, G, bx);
            pg8::EpiFF1 E{HID, ss_b};
            pg8::gemm_phase<pg8::EpiFF1, pg8::StaticOrder, true, true>(L + RING_OFF, g, S, E, wave);
        }
        SEAM(pb + 4);
        if (IN(pb + 5)) {
            pg8::Gemm g{HID, (const bf16*)(wl + WO_FF2), M, D, FF}; pg8::StaticOrder S; S.init(M, D, G, bx);
            pg8::EpiResid<0> E{a.out, a.out, XB, ss_c, nullptr, nullptr};
            pg8::gemm_phase<pg8::EpiResid<0>, pg8::StaticOrder, true, true>(L + RING_OFF, g, S, E, wave);
        }
        SEAM(pb + 5);
        if (IN(pb + 6))
#pragma clang loop unroll(full)
        for (int rep = 0; rep < DUPN(pb + 6); ++rep) {
            pg8::Gemm g{PB + (size_t)l * M * PLE, (const bf16*)(wl + WO_PROJ), M, D, PLE}; pg8::StaticOrder S; S.init(M, D, G, bx);
            pg8::EpiPlain E{PROJ};
            pg8::gemm_phase<pg8::EpiPlain, pg8::StaticOrder, true, true>(L + RING_OFF, g, S, E, wave);
        }
        SEAM(pb + 6);
        if (IN(pb + 7)) {
            pg8::Gemm g{XB, (const bf16*)(wl + WO_GATE), M, D, D}; pg8::StaticOrder S; S.init(M, D, G, bx);
            pg8::EpiResid<1> E{a.out, a.out, XBN, ss_d, ss_c, PROJ};
            pg8::gemm_phase<pg8::EpiResid<1>, pg8::StaticOrder, true, true>(L + RING_OFF, g, S, E, wave);
        }
        SEAM(pb + 7);
    }
    if (IN(17)) {
        const int lane = LANE_ID();
        const float* ssf = (const float*)(ws + WS_SS + (size_t)6 * SS_SITE);
        for (int m = gw; m < M; m += NGW) {
            const float rs = pg8::rstd_of(ssf, m);
            GAS f32x4* xr = (GAS f32x4*)(a.out + (size_t)m * D) + lane; const GAS f32x4* gr = (const GAS f32x4*)ARGP(final_g) + lane;
#pragma unroll
            for (int j = 0; j < 4; ++j) { const f32x4 v = xr[64 * j], gg = gr[64 * j]; xr[64 * j] = v * rs * gg; }
        }
    }
#undef IN
#undef SEAM
}

extern "C" void kernel_launch(void* const* d_in, const int* in_sizes, int n_in, void* d_out, int out_size, void* d_ws, size_t ws_size, hipStream_t stream) {
    static int grid = 0;
    if (grid == 0) {
        if (n_in != 19 || out_size != M * D || ws_size < WS_END) { fprintf(stderr, "kernel_launch: unexpected problem (n_in %d, out %d, ws %zu < %zu); nothing launched\n", n_in, out_size, ws_size, (size_t)WS_END); grid = -1; return; }
        int dev = 0, cus = 0;
        if (hipGetDevice(&dev) != hipSuccess || hipDeviceGetAttribute(&cus, hipDeviceAttributeMultiprocessorCount, dev) != hipSuccess) { grid = -1; return; }
        if (hipFuncSetAttribute((const void*)mk_fwd, hipFuncAttributeMaxDynamicSharedMemorySize, LDS_BYTES) != hipSuccess) { fprintf(stderr, "kernel_launch: hipFuncSetAttribute failed\n"); grid = -1; return; }
        int per_cu = 0;
        if (hipOccupancyMaxActiveBlocksPerMultiprocessor(&per_cu, (const void*)mk_fwd, NWAVES * 64, LDS_BYTES) != hipSuccess || per_cu < 1) fprintf(stderr, "kernel_launch: occupancy query says %d\n", per_cu);
        (void)hipGetLastError();
        if (cus < 256) fprintf(stderr, "kernel_launch: %d CUs < 256: the grid cannot be resident\n", cus);
        grid = 256;
    }
    if (grid < 0) return;
    (void)hipMemsetAsync((char*)d_ws + WS_CTL, 0, CTL_ZERO_BYTES, stream);
    Args a{};
    a.x = (const float*)d_in[0]; a.p = (const float*)d_in[1]; a.pos = (const int*)d_in[2]; a.norm_mix_g = (const float*)d_in[3]; a.w_in = (const float*)d_in[4]; a.dw_w = (const float*)d_in[5];
    a.dw_b = (const float*)d_in[6]; a.ln_g = (const float*)d_in[7]; a.ln_b = (const float*)d_in[8]; a.gn_g = (const float*)d_in[9]; a.gn_b = (const float*)d_in[10]; a.w_out = (const float*)d_in[11];
    a.norm_ffn_g = (const float*)d_in[12]; a.w_ff1 = (const float*)d_in[13]; a.w_ff2 = (const float*)d_in[14]; a.norm_ple_g = (const float*)d_in[15]; a.w_gate = (const float*)d_in[16];
    a.w_proj = (const float*)d_in[17]; a.final_g = (const float*)d_in[18]; a.out = (float*)d_out; a.ws = (unsigned char*)d_ws;
    a.ph_lo = 0; a.ph_hi = 18; a.li = 0;
    hipLaunchKernelGGL(mk_fwd, dim3(grid), dim3(NWAVES * 64), LDS_BYTES, stream, a);
}
```

```cpp
#include <hip/hip_runtime.h>
#include <cstdio>
#include <cstdint>
#include <cstddef>
namespace pg8 {
#define PG8_LAS __attribute__((address_space(3)))
typedef unsigned short bf16_t;
typedef short bf16x8 __attribute__((ext_vector_type(8)));
typedef float f32x4 __attribute__((ext_vector_type(4)));
typedef unsigned u32x4 __attribute__((ext_vector_type(4)));
typedef unsigned u32x2 __attribute__((ext_vector_type(2)));
constexpr int BM = 256, BK = 64, HALF = 128, HTB = HALF * BK * 2  , STAGE_BYTES = 8 * HTB, NXCD = 8, WGM = 8;

__host__ __device__ __forceinline__ int lds_byte(int r, int c) { const int st = (r >> 4) * 2 + (c >> 5), rr = r & 15, cc = c & 31, ob = rr * 64 + cc * 2; return st * 1024 + (ob ^ (((ob >> 9) & 1) << 5)); }
__host__ __device__ __forceinline__ void stage_rc(int b, int& R, int& C) { const int st = b / 1024, sb = b % 1024, swz = sb ^ (((sb >> 9) & 1) << 5); R = (st >> 1) * 16 + swz / 64; C = (st & 1) * 32 + (swz % 64) / 2; }
__host__ __device__ __forceinline__ int perm32(int rho) { const int n = rho >> 4, i = rho & 15; return 8 * (i >> 2) + 4 * n + (i & 3); }

struct Unit { int pm, pn; };
struct Gemm { const bf16_t* A; const bf16_t* Bt; int M, N, K; };

struct StaticOrder {
    int nM, nN, nwg, G, c;
    __host__ __device__ void init(int M, int N, int G_, int c_) { nM = M / BM; nN = N / BM; nwg = nM * nN; G = G_; c = c_; }
    __host__ __device__ bool next(int i, Unit& u) const {
        const long L = (long)i * G + c; if (L >= nwg) return false;
        int wgid = (int)L; { const int q = nwg / NXCD, r = nwg % NXCD, xcd = wgid % NXCD, off = wgid / NXCD; wgid = (xcd < r ? xcd * (q + 1) : r * (q + 1) + (xcd - r) * q) + off; }
        const int nig = WGM * nN, gid = wgid / nig, fm = gid * WGM, gsz = (nM - fm) < WGM ? (nM - fm) : WGM;
        u.pm = fm + ((wgid % nig) % gsz); u.pn = (wgid % nig) / gsz; return true;
    }
    __device__ __forceinline__ void a_ready(const Unit&) const {}
    __device__ __forceinline__ void done(const Unit&) const {}
};

__device__ __forceinline__ unsigned cvt_pk_bf16(float lo, float hi) { unsigned r; asm volatile("v_cvt_pk_bf16_f32 %0, %1, %2" : "=v"(r) : "v"(lo), "v"(hi)); return r; }
__device__ __forceinline__ u32x4 pack8(const f32x4 a, const f32x4 b) { u32x4 w; w.x = cvt_pk_bf16(a[0], a[1]); w.y = cvt_pk_bf16(a[2], a[3]); w.z = cvt_pk_bf16(b[0], b[1]); w.w = cvt_pk_bf16(b[2], b[3]); return w; }
__device__ __forceinline__ float fast_sigmoid(float x) { return __builtin_amdgcn_rcpf(1.0f + __builtin_amdgcn_exp2f(x * -1.4426950408889634f)); }
__device__ __forceinline__ f32x4 sig4(const f32x4 v) { return (f32x4){fast_sigmoid(v[0]), fast_sigmoid(v[1]), fast_sigmoid(v[2]), fast_sigmoid(v[3])}; }
constexpr int SSP = 16;
constexpr float RMS_EPS_ = 1e-6f;
__device__ __forceinline__ float rstd_of(const float* ss, int row) {
    const f32x4* p = (const f32x4*)(ss + (size_t)row * SSP); const f32x4 a = p[0], b = p[1], c = p[2], d = p[3];
    const f32x4 s = (a + b) + (c + d); return rsqrtf(((s[0] + s[1]) + (s[2] + s[3])) * (1.0f / 1024.0f) + RMS_EPS_);
}
typedef _Float16 f16x2 __attribute__((ext_vector_type(2)));

struct EpiInProj {
    static constexpr bool PERM = true, AFTER_DRAIN = false;
    bf16_t* ZB; const float* ss; const unsigned* rope;
    static constexpr int ZP = 2560;
    __device__ __forceinline__ void operator()(const f32x4 (&acc)[2][2][4][2], const Unit& u, int wr, int wc, int fr, int fq) const {
        const int row0 = u.pm * BM + wr * 64 + fr, pn = u.pn, lc = wc * 32 + 8 * fq;
        if (pn < 4) {
#pragma unroll
            for (int ai = 0; ai < 2; ++ai)
#pragma unroll
                for (int m = 0; m < 4; ++m) { const int row = row0 + ai * HALF + m * 16; const float rs = rstd_of(ss, row);
                    const f32x4 h0 = (acc[ai][0][m][0] * rs) * sig4(acc[ai][1][m][0] * rs), h1 = (acc[ai][0][m][1] * rs) * sig4(acc[ai][1][m][1] * rs);
                    *(u32x4*)(ZB + (size_t)row * ZP + pn * 128 + lc) = pack8(h0, h1); asm volatile("" ::: "memory"); }
        } else if (pn < 8) {
            const int head = 2 * (pn & 1) + (wc >> 1), d0 = lc & 63, colb = (pn < 6 ? 512 : 1024) + head * 128 + d0;
#pragma unroll
            for (int ai = 0; ai < 2; ++ai)
#pragma unroll
                for (int m = 0; m < 4; ++m) { const int row = row0 + ai * HALF + m * 16; const float rs = rstd_of(ss, row);
                    const u32x4* rp = (const u32x4*)(rope + (size_t)row * 64 + d0); const u32x4 r0 = rp[0], r1 = rp[1];
                    f32x4 o1[2], o2[2];
                    const unsigned rv[8] = {r0.x, r0.y, r0.z, r0.w, r1.x, r1.y, r1.z, r1.w};
#pragma unroll
                    for (int n = 0; n < 2; ++n) {
#pragma unroll
                        for (int i = 0; i < 4; ++i) { const f16x2 cs = __builtin_bit_cast(f16x2, rv[4 * n + i]); const float c = (float)cs[0], s = (float)cs[1];
                            const float t1 = acc[ai][0][m][n][i] * rs, t2 = acc[ai][1][m][n][i] * rs; o1[n][i] = t1 * c - t2 * s; o2[n][i] = t2 * c + t1 * s; } }
                    bf16_t* zp = ZB + (size_t)row * ZP + colb; *(u32x4*)zp = pack8(o1[0], o1[1]); *(u32x4*)(zp + 64) = pack8(o2[0], o2[1]); asm volatile("" ::: "memory"); }
        } else {
            const int colb = (pn < 10 ? 1536 + (pn - 8) * 256 : 2048 + (pn - 10) * 256) + lc; const bool act = pn >= 10;
#pragma unroll
            for (int ai = 0; ai < 2; ++ai)
#pragma unroll
                for (int m = 0; m < 4; ++m) { const int row = row0 + ai * HALF + m * 16; const float rs = rstd_of(ss, row);
#pragma unroll
                    for (int bj = 0; bj < 2; ++bj) { f32x4 v0 = acc[ai][bj][m][0] * rs, v1 = acc[ai][bj][m][1] * rs;
                        if (act) { v0 = v0 * sig4(v0); v1 = v1 * sig4(v1); }
                        *(u32x4*)(ZB + (size_t)row * ZP + colb + bj * HALF) = pack8(v0, v1); } asm volatile("" ::: "memory"); }
        }
    }
};
__device__ __forceinline__ void unpack8(const u32x4 w, f32x4& a, f32x4& b) {
    a = (f32x4){__uint_as_float(w.x << 16), __uint_as_float(w.x & 0xffff0000u), __uint_as_float(w.y << 16), __uint_as_float(w.y & 0xffff0000u)};
    b = (f32x4){__uint_as_float(w.z << 16), __uint_as_float(w.z & 0xffff0000u), __uint_as_float(w.w << 16), __uint_as_float(w.w & 0xffff0000u)};
}
template <int MODE> struct EpiResid {
    static constexpr bool PERM = true, AFTER_DRAIN = false;
    const bf16_t* XI; bf16_t* XO; float* ss_out; const float* ss_in; const bf16_t* proj;
    __device__ __forceinline__ void operator()(const f32x4 (&acc)[2][2][4][2], const Unit& u, int wr, int wc, int fr, int fq) const {
        const int row0 = u.pm * BM + wr * 64 + fr, col0 = u.pn * BM + wc * 32 + 8 * fq;
#pragma unroll
        for (int ai = 0; ai < 2; ++ai)
#pragma unroll
            for (int m = 0; m < 4; ++m) { const int row = row0 + ai * HALF + m * 16; const size_t off = (size_t)row * 1024 + col0; float q = 0.f;
                float rs = 1.f; if (MODE == 1) rs = rstd_of(ss_in, row);
#pragma unroll
                for (int bj = 0; bj < 2; ++bj) { f32x4 b0, b1; unpack8(*(const u32x4*)(XI + off + bj * HALF), b0, b1);
                    f32x4 v0, v1;
                    if (MODE == 1) { f32x4 p0, p1; unpack8(*(const u32x4*)(proj + off + bj * HALF), p0, p1);
                        v0 = b0 + sig4(acc[ai][bj][m][0] * rs) * p0; v1 = b1 + sig4(acc[ai][bj][m][1] * rs) * p1; }
                    else { v0 = b0 + acc[ai][bj][m][0]; v1 = b1 + acc[ai][bj][m][1]; }
                    *(u32x4*)(XO + off + bj * HALF) = pack8(v0, v1);
                    q += (v0[0] * v0[0] + v0[1] * v0[1]) + (v0[2] * v0[2] + v0[3] * v0[3]) + (v1[0] * v1[0] + v1[1] * v1[1]) + (v1[2] * v1[2] + v1[3] * v1[3]); }
                q += __shfl_xor(q, 16); q += __shfl_xor(q, 32);
                if (fq == 0) ss_out[(size_t)row * SSP + u.pn * 4 + wc] = q; asm volatile("" ::: "memory"); }
    }
};
struct EpiFF1 {
    static constexpr bool PERM = true, AFTER_DRAIN = false;
    bf16_t* H; const float* ss;
    __device__ __forceinline__ void operator()(const f32x4 (&acc)[2][2][4][2], const Unit& u, int wr, int wc, int fr, int fq) const {
        const int row0 = u.pm * BM + wr * 64 + fr, col0 = u.pn * BM + wc * 32 + 8 * fq;
#pragma unroll
        for (int ai = 0; ai < 2; ++ai)
#pragma unroll
            for (int m = 0; m < 4; ++m) { const int row = row0 + ai * HALF + m * 16; const float rs = rstd_of(ss, row);
#pragma unroll
                for (int bj = 0; bj < 2; ++bj) { f32x4 v0 = acc[ai][bj][m][0] * rs, v1 = acc[ai][bj][m][1] * rs;
                    v0 = __builtin_elementwise_max(v0, (f32x4){0.f, 0.f, 0.f, 0.f}); v1 = __builtin_elementwise_max(v1, (f32x4){0.f, 0.f, 0.f, 0.f}); v0 = v0 * v0; v1 = v1 * v1;
                    *(u32x4*)(H + (size_t)row * 4096 + col0 + bj * HALF) = pack8(v0, v1); } asm volatile("" ::: "memory"); }
    }
};
struct EpiPlain {
    static constexpr bool PERM = true, AFTER_DRAIN = false;
    bf16_t* O;
    __device__ __forceinline__ void operator()(const f32x4 (&acc)[2][2][4][2], const Unit& u, int wr, int wc, int fr, int fq) const {
        const int row0 = u.pm * BM + wr * 64 + fr, col0 = u.pn * BM + wc * 32 + 8 * fq;
#pragma unroll
        for (int ai = 0; ai < 2; ++ai)
#pragma unroll
            for (int m = 0; m < 4; ++m) { const int row = row0 + ai * HALF + m * 16;
#pragma unroll
                for (int bj = 0; bj < 2; ++bj) *(u32x4*)(O + (size_t)row * 1024 + col0 + bj * HALF) = pack8(acc[ai][bj][m][0], acc[ai][bj][m][1]); }
    }
};

template <class Epi, class Sched, bool ALIGN_EPI = false, bool SP2 = false>
__device__ __forceinline__ void gemm_phase(PG8_LAS unsigned char* lds, const Gemm g, const Sched& S, const Epi& E, const int wave_id) {
    unsigned z_ = 0u; asm volatile("" : "+v"(z_)); const int tid_ = wave_id * 64 + (int)__builtin_amdgcn_mbcnt_hi(~0u, __builtin_amdgcn_mbcnt_lo(~0u, z_));
    const int tid = tid_, wid = wave_id, lane = tid & 63, wr = wid >> 2, wc = wid & 3, fr = lane & 15, fq = lane >> 4;
    const int K = g.K, nt = K / BK;
    unsigned voffA[2], voffB[2];
#pragma unroll
    for (int i = 0; i < 2; ++i) { int R, C; stage_rc(tid * 16 + i * 8192, R, C); const int Rb = Epi::PERM ? ((R & ~31) + perm32(R & 31)) : R;
        voffA[i] = (unsigned)(R * K + C) * 2u; voffB[i] = (unsigned)(Rb * K + C) * 2u; }
    const size_t kstep = (size_t)(BK * 2);
    const size_t hstep = (size_t)HALF * K * 2;
    const size_t tstep = 2 * hstep;
    const unsigned ldsw = (unsigned)wid * 1024u;
    const int aoff = lds_byte(wr * 64 + fr, fq * 8), boff = lds_byte(wc * 32 + fr, fq * 8);
#define PG8_SA(b, h) (((b) * 2 + (h)) * HTB)
#define PG8_SB(b, h) ((4 + (b) * 2 + (h)) * HTB)
#define PG8_STAGE(bufoff, gbase, voff) do { _Pragma("unroll") for (int _i = 0; _i < 2; ++_i) \
        __builtin_amdgcn_global_load_lds((const unsigned*)((const char*)(gbase) + (voff)[_i]), (PG8_LAS unsigned*)(lds + (bufoff) + ldsw + _i * 8192), 16, 0, 0); } while (0)
#define PG8_LDA(dst, b, h) do { _Pragma("unroll") for (int m = 0; m < 4; ++m) _Pragma("unroll") for (int k = 0; k < 2; ++k) dst[m][k] = *(const PG8_LAS bf16x8*)(lds + PG8_SA(b, h) + aoff + m * 2048 + k * 1024); } while (0)
#define PG8_LDB(dst, b, h) do { _Pragma("unroll") for (int n = 0; n < 2; ++n) _Pragma("unroll") for (int k = 0; k < 2; ++k) dst[n][k] = *(const PG8_LAS bf16x8*)(lds + PG8_SB(b, h) + boff + n * 2048 + k * 1024); } while (0)
#define PG8_MMA(ai, bj, At, Bt) do { __builtin_amdgcn_s_setprio(1); _Pragma("unroll") for (int m = 0; m < 4; ++m) _Pragma("unroll") for (int n = 0; n < 2; ++n) _Pragma("unroll") for (int k = 0; k < 2; ++k) \
        acc[ai][bj][m][n] = __builtin_amdgcn_mfma_f32_16x16x32_bf16(Bt[n][k], At[m][k], acc[ai][bj][m][n], 0, 0, 0); __builtin_amdgcn_s_setprio(0); } while (0)
#define PG8_WAIT_V(n) asm volatile("s_waitcnt vmcnt(" #n ")" ::: "memory")
#define PG8_WAIT_L(n) asm volatile("s_waitcnt lgkmcnt(" #n ")" ::: "memory")
#define PG8_BAR __builtin_amdgcn_s_barrier()
#define PG8_SCHED __builtin_amdgcn_sched_barrier(0)
    Unit cur, nxt; int ui = 0;
    if (!S.next(0, cur)) return;
    f32x4 acc[2][2][4][2];
#pragma unroll
    for (int a = 0; a < 2; ++a)
#pragma unroll
        for (int b = 0; b < 2; ++b)
#pragma unroll
            for (int m = 0; m < 4; ++m)
#pragma unroll
                for (int n = 0; n < 2; ++n) acc[a][b][m][n] = (f32x4){0.f, 0.f, 0.f, 0.f};
    bf16x8 At[4][2], B0[2][2], B1[2][2];
    const char* cA = (const char*)g.A + (size_t)cur.pm * tstep; const char* cB = (const char*)g.Bt + (size_t)cur.pn * tstep;
    S.a_ready(cur);
    if constexpr (SP2) {
        PG8_STAGE(PG8_SB(0, 0), cB, voffB); PG8_STAGE(PG8_SB(0, 1), cB + hstep, voffB); PG8_STAGE(PG8_SA(0, 0), cA, voffA); PG8_STAGE(PG8_SA(0, 1), cA + hstep, voffA);
        if (wr == 1) PG8_BAR;
        PG8_WAIT_V(2); PG8_BAR;
        PG8_STAGE(PG8_SB(1, 0), cB + kstep, voffB); PG8_STAGE(PG8_SA(1, 0), cA + kstep, voffA); PG8_STAGE(PG8_SB(1, 1), cB + hstep + kstep, voffB);
        PG8_WAIT_V(6); PG8_BAR;
    } else {
        PG8_STAGE(PG8_SB(0, 0), cB, voffB); PG8_STAGE(PG8_SA(0, 0), cA, voffA); PG8_STAGE(PG8_SB(0, 1), cB + hstep, voffB); PG8_STAGE(PG8_SA(0, 1), cA + hstep, voffA);
        if (wr == 1) PG8_BAR;
        PG8_WAIT_V(4); PG8_BAR;
        PG8_STAGE(PG8_SB(1, 0), cB + kstep, voffB); PG8_STAGE(PG8_SA(1, 0), cA + kstep, voffA); PG8_STAGE(PG8_SB(1, 1), cB + hstep + kstep, voffB);
        PG8_WAIT_V(6); PG8_BAR;
    }
    for (;;) {
        const bool has_next = S.next(ui + 1, nxt);
        const char* nA = has_next ? (const char*)g.A + (size_t)nxt.pm * tstep : cA; const char* nB = has_next ? (const char*)g.Bt + (size_t)nxt.pn * tstep : cB;
        for (int t = 0; t < nt; t += 2) {
            const bool last = (t == nt - 2);
            const char* a1 = cA + (size_t)(t + 1) * kstep;
            const char* a2 = last ? nA : cA + (size_t)(t + 2) * kstep; const char* b2 = last ? nB : cB + (size_t)(t + 2) * kstep;
            const char* a3 = a2 + kstep; const char* b3 = b2 + kstep;
            if (last && has_next) S.a_ready(nxt);
            if constexpr (SP2) {
            PG8_LDB(B0, 0, 0); PG8_LDB(B1, 0, 1); PG8_SCHED; PG8_LDA(At, 0, 0); PG8_STAGE(PG8_SA(1, 1), a1 + hstep, voffA);
            PG8_WAIT_V(8); PG8_WAIT_L(0); PG8_BAR; PG8_MMA(0, 0, At, B0); PG8_MMA(0, 1, At, B1); PG8_BAR; PG8_SCHED;
            PG8_LDA(At, 0, 1); PG8_STAGE(PG8_SB(0, 0), b2, voffB); PG8_STAGE(PG8_SB(0, 1), b2 + hstep, voffB); PG8_STAGE(PG8_SA(0, 0), a2, voffA);
            PG8_WAIT_V(8); PG8_WAIT_L(0); PG8_BAR; PG8_MMA(1, 0, At, B0); PG8_MMA(1, 1, At, B1); PG8_BAR; PG8_SCHED;
            PG8_LDB(B0, 1, 0); PG8_LDB(B1, 1, 1); PG8_SCHED; PG8_LDA(At, 1, 0); PG8_STAGE(PG8_SA(0, 1), a2 + hstep, voffA);
            PG8_WAIT_V(8); PG8_WAIT_L(0); PG8_BAR; PG8_MMA(0, 0, At, B0); PG8_MMA(0, 1, At, B1); PG8_BAR; PG8_SCHED;
            PG8_LDA(At, 1, 1); PG8_STAGE(PG8_SB(1, 0), b3, voffB); PG8_STAGE(PG8_SB(1, 1), b3 + hstep, voffB); PG8_STAGE(PG8_SA(1, 0), a3, voffA);
            PG8_WAIT_V(8); PG8_WAIT_L(0); PG8_BAR; PG8_MMA(1, 0, At, B0); PG8_MMA(1, 1, At, B1); PG8_BAR; PG8_SCHED;
            } else {
            PG8_LDB(B0, 0, 0); PG8_SCHED; PG8_LDA(At, 0, 0); PG8_STAGE(PG8_SA(1, 1), a1 + hstep, voffA);
            PG8_WAIT_L(8); PG8_BAR; PG8_WAIT_L(0); PG8_MMA(0, 0, At, B0); PG8_BAR; PG8_SCHED;
            PG8_LDB(B1, 0, 1); PG8_STAGE(PG8_SB(0, 0), b2, voffB);
            PG8_BAR; PG8_WAIT_L(0); PG8_MMA(0, 1, At, B1); PG8_BAR;
            PG8_LDA(At, 0, 1); PG8_STAGE(PG8_SA(0, 0), a2, voffA);
            PG8_BAR; PG8_WAIT_L(0); PG8_MMA(1, 0, At, B0); PG8_BAR; PG8_SCHED;
            PG8_STAGE(PG8_SB(0, 1), b2 + hstep, voffB);
            PG8_WAIT_V(6); PG8_BAR; PG8_MMA(1, 1, At, B1); PG8_BAR;
            PG8_LDB(B0, 1, 0); PG8_SCHED; PG8_LDA(At, 1, 0); PG8_STAGE(PG8_SA(0, 1), a2 + hstep, voffA);
            PG8_WAIT_L(8); PG8_BAR; PG8_WAIT_L(0); PG8_MMA(0, 0, At, B0); PG8_BAR; PG8_SCHED;
            PG8_LDB(B1, 1, 1); PG8_STAGE(PG8_SB(1, 0), b3, voffB);
            PG8_BAR; PG8_WAIT_L(0); PG8_MMA(0, 1, At, B1); PG8_BAR;
            PG8_LDA(At, 1, 1); PG8_STAGE(PG8_SA(1, 0), a3, voffA);
            PG8_BAR; PG8_WAIT_L(0); PG8_MMA(1, 0, At, B0); PG8_BAR; PG8_SCHED;
            PG8_STAGE(PG8_SB(1, 1), b3 + hstep, voffB);
            PG8_WAIT_V(6); PG8_BAR; PG8_MMA(1, 1, At, B1); PG8_BAR;
            }
        }
        if constexpr (ALIGN_EPI) { if (wr == 0) PG8_BAR; }
        if constexpr (!Epi::AFTER_DRAIN) { E(acc, cur, wr, wc, fr, fq); S.done(cur); }
        if (!has_next) break;
#pragma unroll
        for (int a = 0; a < 2; ++a)
#pragma unroll
            for (int b = 0; b < 2; ++b)
#pragma unroll
                for (int m = 0; m < 4; ++m)
#pragma unroll
                    for (int n = 0; n < 2; ++n) acc[a][b][m][n] = (f32x4){0.f, 0.f, 0.f, 0.f};
        cur = nxt; cA = nA; cB = nB; ++ui;
        if constexpr (ALIGN_EPI) { if (wr == 1) PG8_BAR; }
    }
    PG8_WAIT_V(0);
    if constexpr (!ALIGN_EPI) { if (wr == 0) PG8_BAR; }
    PG8_BAR;
    if constexpr (Epi::AFTER_DRAIN) { E.fused(acc, cur, wr, wc, fr, fq, lds, wid, lane); S.done(cur); }
#undef PG8_SA
#undef PG8_SB
#undef PG8_STAGE
#undef PG8_LDA
#undef PG8_LDB
#undef PG8_MMA
#undef PG8_WAIT_V
#undef PG8_WAIT_L
#undef PG8_BAR
#undef PG8_SCHED
}
}

constexpr int NWAVES = 8;
constexpr int NB = 8, SEQ = 8192, D = 1024, DEPTH = 2, CCH = 512, CONVW = 31, RH = 4, RD = 128, RW = 512, RC = 128, FF = 4096, PLE = 256, INC = 3072;
constexpr int M = NB * SEQ;
constexpr int ZP = 2560;
constexpr float LN_EPS = 1e-5f;
constexpr size_t MiB = 1u << 20;
constexpr size_t WS_CTL = 0, CTL_ZERO_BYTES = 1 * MiB;
constexpr size_t WS_W = 2 * MiB, W_LAYER = 27 * MiB;
constexpr size_t WO_IN = 0, WO_OUT = 6 * MiB, WO_FF1 = 8 * MiB, WO_FF2 = 16 * MiB, WO_GATE = 24 * MiB, WO_PROJ = 26 * MiB;
constexpr size_t WS_SS = 56 * MiB, SS_SITE = 4 * MiB;
constexpr size_t WS_ROPE = 84 * MiB;
constexpr size_t WS_XB = 100 * MiB;
constexpr size_t WS_PB = 228 * MiB;
constexpr size_t WS_PROJ = 292 * MiB;
constexpr size_t WS_ZB = 420 * MiB;
constexpr size_t WS_T = 740 * MiB;
constexpr size_t WS_MIX = 756 * MiB;
constexpr size_t WS_HID = 420 * MiB;
constexpr size_t WS_END = 932 * MiB;
constexpr size_t WS_U = WS_XB, WS_S = WS_PROJ;
constexpr int CW_TMO = 0, CW_BAR = 4096;
constexpr int LDS_BYTES = 163840, RING_OFF = 0, MISC_OFF = 163840 - 256, ARGS_OFF = 163840 - 512;

#define GAS __attribute__((address_space(1)))
#define LAS __attribute__((address_space(3)))
typedef unsigned short bf16;
typedef unsigned v4u __attribute__((ext_vector_type(4)));
typedef float f32x4 __attribute__((ext_vector_type(4)));
typedef GAS unsigned gu32;
#define RLX_AGENT __ATOMIC_RELAXED, __HIP_MEMORY_SCOPE_AGENT
#define LDS_WAIT() asm volatile("s_waitcnt lgkmcnt(0)" ::: "memory")
__device__ __forceinline__ unsigned f2bf(float f) { unsigned u = __builtin_bit_cast(unsigned, f); return (u + 0x7fffu + ((u >> 16) & 1u)) >> 16; }
__device__ __forceinline__ unsigned pk2(float lo, float hi) { return f2bf(lo) | (f2bf(hi) << 16); }
__device__ __forceinline__ float bf2f(unsigned short b) { return __uint_as_float(((unsigned)b) << 16); }

__device__ __forceinline__ float wave_sum(float v) {
#pragma unroll
    for (int o = 1; o < 64; o <<= 1) v += __shfl_xor(v, o);
    return v;
}
#define XB_TMO      128
#define XB_XCNT(j)  (256  + 64 * (j))
#define XB_XSUB(j)  (1280 + 64 * (j))
#define XB_XGEN(j)  (2304 + 64 * (j))
#define XB_TOP      3328
#define XB_TOPGEN   3392
#define XCD_BAR_WORDS 3456
#define XB_SPIN_CAP (1u << 18)

__device__ __forceinline__ unsigned xb_ld(unsigned* p)              { return __hip_atomic_load(p, __ATOMIC_RELAXED, __HIP_MEMORY_SCOPE_AGENT); }
__device__ __forceinline__ unsigned xb_add(unsigned* p, unsigned v) { return __hip_atomic_fetch_add(p, v, __ATOMIC_RELAXED, __HIP_MEMORY_SCOPE_AGENT); }
__device__ __forceinline__ unsigned xb_xcc_id() { return (unsigned)__builtin_amdgcn_s_getreg((3 << 11) | 20) & 0xFu; }
#define XB_SPIN(cond, bar) do { unsigned _sp = 0; while (cond) { __builtin_amdgcn_s_sleep(1); \
    if ((++_sp & 255u) == 0u) { if (xb_ld(&(bar)[XB_TMO])) break; if (_sp > XB_SPIN_CAP) { atomicAdd(&(bar)[XB_TMO], 1u); break; } } } } while (0)

__device__ __forceinline__ int xb_fresh_lane() { unsigned z = 0u; asm volatile("" : "+v"(z)); return (int)__builtin_amdgcn_mbcnt_hi(~0u, __builtin_amdgcn_mbcnt_lo(~0u, z)); }
struct XcdBarrier {
    unsigned* bar; unsigned x; int wave;
    volatile LAS unsigned* st;
};

__device__ __forceinline__ XcdBarrier xcd_barrier_post(unsigned* bar, volatile LAS unsigned* st, int wave) {
    XcdBarrier b; b.bar = bar; b.x = xb_xcc_id(); b.st = st; b.wave = wave;
    if (wave == 0 && xb_fresh_lane() == 0) (void)xb_add(&bar[XB_XCNT(b.x)], 1u);
    return b;
}
__device__ __forceinline__ void xcd_barrier_complete(unsigned* bar, unsigned x, unsigned& nloc, unsigned& nx) {
    const unsigned G = gridDim.x * gridDim.y * gridDim.z;
    unsigned sum, cnt, mine, sp = 0u;
    for (;;) {
        sum = 0u; cnt = 0u; mine = 0u;
#pragma unroll
        for (unsigned j = 0; j < 16; ++j) { const unsigned c = xb_ld(&bar[XB_XCNT(j)]); sum += c; cnt += (c > 0u) ? 1u : 0u; mine = (j == x) ? c : mine; }
        if (sum == G) break;
        __builtin_amdgcn_s_sleep(1);
        if ((++sp & 255u) == 0u) { if (xb_ld(&bar[XB_TMO])) break; if (sp > XB_SPIN_CAP) { atomicAdd(&bar[XB_TMO], 1u); break; } }
    }
    nloc = mine > 0u ? mine : 1u; nx = cnt > 0u ? cnt : 1u;
}

__device__ __forceinline__ void xcd_barrier(const XcdBarrier& b) {
    asm volatile("s_waitcnt vmcnt(0)" ::: "memory");
    __syncthreads();
    if (b.wave == 0 && xb_fresh_lane() == 0) {
        unsigned* bar = b.bar;
        __builtin_amdgcn_s_waitcnt(0);
        unsigned nloc = b.st[0], nx = b.st[1];
        if (nloc == 0u) { xcd_barrier_complete(bar, b.x, nloc, nx); b.st[0] = nloc; b.st[1] = nx; }
        const unsigned old = xb_add(&bar[XB_XSUB(b.x)], 1u);
        const unsigned gen = old / nloc;
        if (old + 1u == (gen + 1u) * nloc) {
            __builtin_amdgcn_fence(__ATOMIC_RELEASE, "agent");
            asm volatile("s_waitcnt vmcnt(0)" ::: "memory");
            const unsigned og = xb_add(&bar[XB_TOP], 1u);
            const unsigned tg = og / nx;
            if (og + 1u == (tg + 1u) * nx) xb_add(&bar[XB_TOPGEN], 1u);
            else XB_SPIN(xb_ld(&bar[XB_TOPGEN]) == tg, bar);
            __builtin_amdgcn_fence(__ATOMIC_ACQUIRE, "agent");
            xb_add(&bar[XB_XGEN(b.x)], 1u);
            asm volatile("s_waitcnt vmcnt(0)" ::: "memory");
        } else {
            XB_SPIN(xb_ld(&bar[XB_XGEN(b.x)]) == gen, bar);
            __builtin_amdgcn_fence(__ATOMIC_ACQUIRE, "agent");
            asm volatile("s_waitcnt vmcnt(0)" ::: "memory");
        }
    }
    __syncthreads();
}

namespace mx {
typedef short s16x4 __attribute__((ext_vector_type(4)));
typedef short v4i16_t __attribute__((ext_vector_type(4)));
typedef short bf16x8 __attribute__((ext_vector_type(8)));
typedef float f32x2 __attribute__((ext_vector_type(2)));
typedef unsigned u32x2 __attribute__((ext_vector_type(2)));
constexpr int KI = 0, VI = 32768, QI = 65536, SI = 98304;

__device__ __forceinline__ unsigned off_b(unsigned row, unsigned ch) { return 256u * row + 16u * (ch ^ (((row & 3u) << 2) | ((row >> 2) & 3u))); }
__device__ __forceinline__ unsigned tr_addr(unsigned lane, unsigned c, unsigned ks, unsigned t) {
    const unsigned g = lane >> 4, q = (lane & 15u) >> 2, p = lane & 3u; return off_b(32u * ks + 8u * g + 4u * t + q, 2u * c + (p >> 1)) + 8u * (p & 1u);
}
__device__ __forceinline__ bf16x8 tr_frag(LAS const unsigned char* img, unsigned lane, unsigned c, unsigned ks) {
    const s16x4 lo = __builtin_bit_cast(s16x4, __builtin_amdgcn_ds_read_tr16_b64_v4i16((LAS v4i16_t*)(img + tr_addr(lane, c, ks, 0))));
    const s16x4 hi = __builtin_bit_cast(s16x4, __builtin_amdgcn_ds_read_tr16_b64_v4i16((LAS v4i16_t*)(img + tr_addr(lane, c, ks, 1))));
    return __builtin_shufflevector(lo, hi, 0, 1, 2, 3, 4, 5, 6, 7);
}
__device__ __forceinline__ bf16x8 row_frag(LAS const unsigned char* img, unsigned row, unsigned ch) { return *(LAS const bf16x8*)(img + off_b(row, ch)); }
__device__ __forceinline__ float gamma_log(int h) { return logf(1.0f - exp2f(-5.0f - (float)h)); }
__device__ __forceinline__ float to_sgpr(float v) { return __builtin_bit_cast(float, __builtin_amdgcn_readfirstlane(__builtin_bit_cast(int, v))); }
__device__ __forceinline__ int opaque_s(int v) { asm volatile("" : "+s"(v)); return v; }

template <bool SCALE> __device__ __forceinline__ void stage_tile(LAS unsigned char* img, const bf16* src, float rowscale, int tid) {
    const int row = tid >> 2, c0 = (tid & 3) * 4;
    const GAS v4u* g = (const GAS v4u*)(src + (size_t)row * ZP + c0 * 8);
    v4u v[4];
#pragma unroll
    for (int c = 0; c < 4; ++c) v[c] = g[c];
#pragma unroll
    for (int c = 0; c < 4; ++c) {
        v4u o = v[c];
        if (SCALE) {
            const unsigned w[4] = {o.x, o.y, o.z, o.w}; unsigned r[4];
#pragma unroll
            for (int i = 0; i < 4; ++i) r[i] = pg8::cvt_pk_bf16(__uint_as_float(w[i] << 16) * rowscale, __uint_as_float(w[i] & 0xffff0000u) * rowscale);
            o.x = r[0]; o.y = r[1]; o.z = r[2]; o.w = r[3];
        }
        *(LAS v4u*)(img + off_b(row, c0 + c)) = o;
    }
}
#define MX_MFMA(a, b, c) __builtin_amdgcn_mfma_f32_16x16x32_bf16((a), (b), (c), 0, 0, 0)

__device__ __forceinline__ void conv_phase(LAS unsigned char* L, const bf16* ZB, bf16* MIXB, const float* dw_w, const float* dw_b, const float* ln_g, const float* ln_b, int bx, int wave) {
    const int lane0 = xb_fresh_lane(), cp0 = (wave * 64 + lane0) & 255, half = wave >> 2;
    f32x2 w2[CONVW];
#pragma unroll
    for (int j = 0; j < CONVW; ++j) w2[j] = *(const GAS f32x2*)(dw_w + j * CCH + 2 * cp0);
    const f32x2 b2 = *(const GAS f32x2*)(dw_b + 2 * cp0);
    LAS float* CT = (LAS float*)L;
    for (int tile = 0; tile < 4; ++tile) {
        int lane = lane0; asm volatile("" : "+v"(lane));
        const int cp = (wave * 64 + lane) & 255;
        const int mt = bx * 256 + tile * 64, t0 = (mt % SEQ) + 32 * half;
        const bf16* src = ZB + ((long)(mt + 32 * half) - (CONVW - 1)) * ZP + 2 * cp;
        f32x2 acc[32];
#pragma unroll
        for (int t = 0; t < 32; ++t) acc[t] = b2;
#pragma unroll
        for (int r = 0; r < 32 + CONVW - 1; ++r) {
            unsigned u = 0u; if (t0 - (CONVW - 1) + r >= 0) u = *(const GAS unsigned*)(src + (long)r * ZP);
            const f32x2 h2 = {__uint_as_float(u << 16), __uint_as_float(u & 0xffff0000u)};
#pragma unroll
            for (int t = (r - (CONVW - 1) > 0 ? r - (CONVW - 1) : 0); t <= (r < 31 ? r : 31); ++t) acc[t] = w2[r - t] * h2 + acc[t];
        }
#pragma unroll
        for (int t = 0; t < 32; ++t) *(LAS f32x2*)(CT + (32 * half + t) * CCH + 2 * cp) = acc[t];
        __syncthreads();
        {
            const f32x4 g0 = *(const GAS f32x4*)(ln_g + 8 * lane), g1 = *(const GAS f32x4*)(ln_g + 8 * lane + 4), be0 = *(const GAS f32x4*)(ln_b + 8 * lane), be1 = *(const GAS f32x4*)(ln_b + 8 * lane + 4);
#pragma unroll 2
            for (int i = 0; i < 8; ++i) {
                const int tok = 8 * wave + i;
                f32x4 v0 = *(LAS f32x4*)(CT + tok * CCH + 8 * lane), v1 = *(LAS f32x4*)(CT + tok * CCH + 8 * lane + 4);
                const float mean = wave_sum((v0[0] + v0[1]) + (v0[2] + v0[3]) + (v1[0] + v1[1]) + (v1[2] + v1[3])) * (1.0f / CCH);
                v0 = v0 - mean; v1 = v1 - mean;
                const float rstd = rsqrtf(wave_sum((v0[0] * v0[0] + v0[1] * v0[1]) + (v0[2] * v0[2] + v0[3] * v0[3]) + (v1[0] * v1[0] + v1[1] * v1[1]) + (v1[2] * v1[2] + v1[3] * v1[3])) * (1.0f / CCH) + LN_EPS);
                v0 = v0 * rstd * g0 + be0; v1 = v1 * rstd * g1 + be1;
                v0 = v0 * pg8::sig4(v0); v1 = v1 * pg8::sig4(v1);
                *(GAS v4u*)(MIXB + (size_t)(mt + tok) * D + 8 * lane) = pg8::pack8(v0, v1);
            }
        }
        __syncthreads();
    }
}

__device__ __forceinline__ void state_mfma(f32x4 (&sacc)[8], LAS const unsigned char* Kimg, LAS const unsigned char* Vimg, int wave, int lane) {
#pragma unroll
    for (int kp = 0; kp < 4; ++kp) {
        const bf16x8 kf = tr_frag(Kimg, lane, wave, kp);
#pragma unroll
        for (int eb = 0; eb < 8; ++eb) { const bf16x8 vf = tr_frag(Vimg, lane, eb, kp); sacc[eb] = MX_MFMA(kf, vf, sacc[eb]); }
    }
}
__device__ __forceinline__ void ret_state_phase(LAS unsigned char* L, const bf16* ZB, float* Tf, int bx, int wave) {
    const int lane0 = xb_fresh_lane(), bh = bx >> 3, cg = bx & 7, b = bh >> 2, h = opaque_s(bh & 3);
    const float lg = to_sgpr(gamma_log(h)), kscale = expf(-(float)((wave * 64 + lane0) >> 2) * lg), g1 = to_sgpr(expf(lg)), g127 = to_sgpr(expf(127.0f * lg));
    f32x4 sacc[8];
#pragma unroll
    for (int eb = 0; eb < 8; ++eb) sacc[eb] = (f32x4){0.f, 0.f, 0.f, 0.f};
    for (int j = 0; j < 8; ++j) {
        int lane = lane0; asm volatile("" : "+v"(lane));
        const int tid = wave * 64 + lane;
        const size_t m0 = (size_t)b * SEQ + (size_t)(cg * 8 + j) * RC;
        stage_tile<true>(L + KI, ZB + m0 * ZP + 1024 + h * RD, kscale, tid);
        stage_tile<false>(L + VI, ZB + m0 * ZP + 1536 + h * RD, 1.0f, tid);
        __syncthreads();
#pragma unroll
        for (int eb = 0; eb < 8; ++eb) sacc[eb] = sacc[eb] * g1;
        state_mfma(sacc, L + KI, L + VI, wave, lane);
#pragma unroll
        for (int eb = 0; eb < 8; ++eb) sacc[eb] = sacc[eb] * g127;
        __syncthreads();
    }
    GAS f32x4* dst = (GAS f32x4*)Tf + (size_t)(bx * 8 + wave) * 8 * 64 + lane0;
#pragma unroll
    for (int eb = 0; eb < 8; ++eb) dst[eb * 64] = sacc[eb];
}
__device__ __forceinline__ void ret_out_phase(LAS unsigned char* L, const bf16* ZB, bf16* MIXB, const float* Tf, const float* gn_g, const float* gn_b, int bx, int wave) {
    const int lane0 = xb_fresh_lane(), bh = bx >> 3, cg = bx & 7, b = bh >> 2, h = opaque_s(bh & 3);
    const float lg = to_sgpr(gamma_log(h)), kscale = expf(-(float)((wave * 64 + lane0) >> 2) * lg), qscale = expf((float)((wave * 64 + lane0) >> 2) * lg), g1 = to_sgpr(expf(lg)), g127 = to_sgpr(expf(127.0f * lg)), cd8 = to_sgpr(expf(1024.0f * lg));
    f32x4 sacc[8];
#pragma unroll
    for (int eb = 0; eb < 8; ++eb) sacc[eb] = (f32x4){0.f, 0.f, 0.f, 0.f};
    { float coef = 1.0f;
      for (int g2 = cg - 1; g2 >= 0; --g2) { const GAS f32x4* src = (const GAS f32x4*)Tf + (size_t)((bh * 8 + g2) * 8 + wave) * 8 * 64 + lane0;
#pragma unroll
          for (int eb = 0; eb < 8; ++eb) sacc[eb] = sacc[eb] + src[eb * 64] * coef;
          coef *= cd8; } }
    for (int j = 0; j < 8; ++j) {
        int lane = lane0; asm volatile("" : "+v"(lane));
        const int tid = wave * 64 + lane, g = lane >> 4, li = lane & 15;
        const size_t m0 = (size_t)b * SEQ + (size_t)(cg * 8 + j) * RC;
        stage_tile<true>(L + KI, ZB + m0 * ZP + 1024 + h * RD, kscale, tid); __builtin_amdgcn_sched_barrier(0);
        stage_tile<false>(L + VI, ZB + m0 * ZP + 1536 + h * RD, 1.0f, tid); __builtin_amdgcn_sched_barrier(0);
        stage_tile<true>(L + QI, ZB + m0 * ZP + 512 + h * RD, qscale, tid); __builtin_amdgcn_sched_barrier(0);
#pragma unroll
        for (int eb = 0; eb < 8; ++eb) { const f32x4 sv = sacc[eb] * g1; u32x2 w; w.x = pg8::cvt_pk_bf16(sv[0], sv[1]); w.y = pg8::cvt_pk_bf16(sv[2], sv[3]);
            *(LAS u32x2*)(L + SI + off_b(16 * eb + li, 2 * wave + (g >> 1)) + 8 * (g & 1)) = w; }
        __syncthreads(); __builtin_amdgcn_sched_barrier(0);
        bf16x8 qf[4];
#pragma unroll
        for (int ks = 0; ks < 4; ++ks) qf[ks] = row_frag(L + QI, 16 * wave + li, 4 * ks + g);
        bf16x8 pf[4];
#pragma unroll
        for (int kp = 0; kp < 4; ++kp) {
            unsigned pw[4] = {0u, 0u, 0u, 0u};
            if (kp <= (wave >> 1)) {
#pragma unroll
                for (int t = 0; t < 2; ++t) {
                    f32x4 x = (f32x4){0.f, 0.f, 0.f, 0.f};
                    const unsigned krow = 32 * kp + 8 * (li >> 2) + 4 * t + (li & 3);
#pragma unroll
                    for (int ks = 0; ks < 4; ++ks) x = MX_MFMA(row_frag(L + KI, krow, 4 * ks + g), qf[ks], x);
                    { const int key0 = 32 * kp + 8 * g + 4 * t, ql = 16 * wave + li;
#pragma unroll
                        for (int r = 0; r < 4; ++r) x[r] = (key0 + r <= ql) ? x[r] : 0.f; }
                    pw[2 * t] = pg8::cvt_pk_bf16(x[0], x[1]); pw[2 * t + 1] = pg8::cvt_pk_bf16(x[2], x[3]);
                }
            }
            pf[kp] = __builtin_bit_cast(bf16x8, (v4u){pw[0], pw[1], pw[2], pw[3]}); __builtin_amdgcn_sched_barrier(0);
        }
        f32x4 o[8];
#pragma unroll
        for (int eb = 0; eb < 8; ++eb) o[eb] = (f32x4){0.f, 0.f, 0.f, 0.f};
#pragma unroll
        for (int eb = 0; eb < 8; ++eb) {
#pragma unroll
            for (int ks = 0; ks < 4; ++ks) o[eb] = MX_MFMA(row_frag(L + SI, 16 * eb + li, 4 * ks + g), qf[ks], o[eb]);
            if (eb & 1) __builtin_amdgcn_sched_barrier(0); }
#pragma unroll
        for (int eb = 0; eb < 8; ++eb) sacc[eb] = sacc[eb] * g1;
#pragma unroll
        for (int kp = 0; kp < 4; ++kp) {
            const bf16x8 kf = tr_frag(L + KI, lane, wave, kp);
#pragma unroll
            for (int eb = 0; eb < 8; ++eb) { const bf16x8 vf = tr_frag(L + VI, lane, eb, kp);
                o[eb] = MX_MFMA(vf, pf[kp], o[eb]);
                sacc[eb] = MX_MFMA(kf, vf, sacc[eb]); if (eb & 1) __builtin_amdgcn_sched_barrier(0); }
        }
#pragma unroll
        for (int eb = 0; eb < 8; ++eb) sacc[eb] = sacc[eb] * g127;
        float s1 = 0.f;
#pragma unroll
        for (int eb = 0; eb < 8; ++eb) s1 += (o[eb][0] + o[eb][1]) + (o[eb][2] + o[eb][3]);
        s1 += __shfl_xor(s1, 16); s1 += __shfl_xor(s1, 32);
        const float mean = s1 * (1.0f / RD); float s2 = 0.f;
#pragma unroll
        for (int eb = 0; eb < 8; ++eb) { o[eb] = o[eb] - mean; s2 += (o[eb][0] * o[eb][0] + o[eb][1] * o[eb][1]) + (o[eb][2] * o[eb][2] + o[eb][3] * o[eb][3]); }
        s2 += __shfl_xor(s2, 16); s2 += __shfl_xor(s2, 32);
        const float rstd = rsqrtf(s2 * (1.0f / RD) + LN_EPS); __builtin_amdgcn_sched_barrier(0);
        const size_t mrow = m0 + 16 * wave + li;
#pragma unroll
        for (int eb = 0; eb < 8; ++eb) { const int e0 = h * RD + 16 * eb + 4 * g;
            const f32x4 gg = *(const GAS f32x4*)(gn_g + e0), gb = *(const GAS f32x4*)(gn_b + e0);
            const u32x2 gw = *(const GAS u32x2*)(ZB + mrow * ZP + 2048 + e0);
            const f32x4 gt = (f32x4){__uint_as_float(gw.x << 16), __uint_as_float(gw.x & 0xffff0000u), __uint_as_float(gw.y << 16), __uint_as_float(gw.y & 0xffff0000u)};
            const f32x4 y = (o[eb] * rstd * gg + gb) * gt;
            u32x2 w; w.x = pg8::cvt_pk_bf16(y[0], y[1]); w.y = pg8::cvt_pk_bf16(y[2], y[3]);
            *(GAS u32x2*)(MIXB + mrow * D + CCH + e0) = w; if (eb & 1) __builtin_amdgcn_sched_barrier(0); }
        __syncthreads();
    }
}
#undef MX_MFMA
}

struct Args {
    const float* x; const float* p; const int* pos; const float* norm_mix_g; const float* w_in; const float* dw_w; const float* dw_b; const float* ln_g; const float* ln_b;
    const float* gn_g; const float* gn_b; const float* w_out; const float* norm_ffn_g; const float* w_ff1; const float* w_ff2; const float* norm_ple_g; const float* w_gate; const float* w_proj;
    const float* final_g; float* out; unsigned char* ws; int ph_lo, ph_hi, li, pad;
};
__device__ __forceinline__ int inmap(int s) {
    if (s < 512) return 256 * (s >> 7) + (s & 127);
    if (s < 1024) { const int ch = s - 512; return 256 * (ch >> 7) + 128 + (ch & 127); }
    if (s < 2048) { const int k = s >= 1536, r = s - (k ? 1536 : 1024), hq = r >> 7, dd = r & 127; return 256 * ((k ? 6 : 4) + (hq >> 1)) + 128 * (dd >> 6) + 64 * (hq & 1) + (dd & 63); }
    return s;
}
template <bool INMAP> __device__ __forceinline__ void tr_item(const float* W, int K, int N, const float* gain, bf16* WT, LAS float* scr, int item, int lane) {
    const int nblk = N / 32, kb = item / nblk, nb = item % nblk, k0 = 64 * kb, n0 = 32 * nb;
#pragma unroll 8
    for (int i = 0; i < 32; ++i) { const int kk = 2 * i + (lane >> 5); scr[kk * 33 + (lane & 31)] = W[(size_t)(k0 + kk) * N + n0 + (lane & 31)] * (gain ? gain[k0 + kk] : 1.0f); }
    LDS_WAIT(); asm volatile("" ::: "memory");
    const int c = lane & 7;
#pragma unroll
    for (int j = 0; j < 4; ++j) { const int n = (lane >> 3) + 8 * j; const LAS float* s = scr + (8 * c) * 33 + n;
        const int src = n0 + n; const int r = INMAP ? inmap(src) : src; const float cs = (INMAP && src >= 1536 && src < 2048) ? 0.088388347648318447f : 1.0f;
        v4u o; o.x = pk2(s[0 * 33] * cs, s[1 * 33] * cs); o.y = pk2(s[2 * 33] * cs, s[3 * 33] * cs); o.z = pk2(s[4 * 33] * cs, s[5 * 33] * cs); o.w = pk2(s[6 * 33] * cs, s[7 * 33] * cs);
        *(GAS v4u*)(WT + (size_t)r * K + k0 + 8 * c) = o; }
    LDS_WAIT(); asm volatile("" ::: "memory");
}

__device__ __forceinline__ const void* lds_ptr(LAS unsigned char* p) {
    const unsigned lo = __builtin_amdgcn_readfirstlane(((volatile LAS unsigned*)p)[0]), hi = __builtin_amdgcn_readfirstlane(((volatile LAS unsigned*)p)[1]);
    return (const void*)(((unsigned long long)hi << 32) | lo);
}
#ifndef PROBE_DUP
#define PROBE_DUP (-1)
#endif
#define DUPN(k) ((PROBE_DUP == (k)) ? 2 : 1)
__global__ void __launch_bounds__(NWAVES * 64, 2) mk_fwd(Args a) {
    extern __shared__ __attribute__((aligned(16))) unsigned char lds[];
    LAS unsigned char* const L = (LAS unsigned char*)lds;
    volatile LAS unsigned* MISC = (volatile LAS unsigned*)(L + MISC_OFF);
    const int wave = __builtin_amdgcn_readfirstlane(threadIdx.x >> 6);
#define LANE_ID() xb_fresh_lane()
    const int G = gridDim.x, bx = blockIdx.x;
    unsigned char* ws = a.ws;
    gu32* ctl = (gu32*)(ws + WS_CTL);
    if (threadIdx.x < 64) MISC[threadIdx.x] = 0u;
    if (threadIdx.x < sizeof(Args) / 4) ((volatile LAS unsigned*)(L + ARGS_OFF))[threadIdx.x] = ((const unsigned*)&a)[threadIdx.x];
    __syncthreads();
#define ARGP(field) ((decltype(a.field))lds_ptr(L + ARGS_OFF + offsetof(Args, field)))
    XcdBarrier bar = xcd_barrier_post((unsigned*)(ctl + CW_BAR) + a.li * XCD_BAR_WORDS, MISC + 8, wave);
    const int lo = a.ph_lo, hi = a.ph_hi;
#define IN(k) (lo <= (k) && (k) < hi)
#define SEAM(k) do { if (IN(k) && IN((k) + 1)) xcd_barrier(bar); } while (0)
    const int gw = bx * NWAVES + wave, NGW = G * NWAVES;
    const size_t NGT = (size_t)G * NWAVES * 64;
    bf16* const XB = (bf16*)(ws + WS_XB); bf16* const ZB = (bf16*)(ws + WS_ZB); bf16* const MIXB = (bf16*)(ws + WS_MIX); bf16* const HID = (bf16*)(ws + WS_HID);
    bf16* const XO = (bf16*)a.out;
    float* const TF = (float*)(ws + WS_T);
    bf16* const PROJ = (bf16*)(ws + WS_PROJ); bf16* const PB = (bf16*)(ws + WS_PB); unsigned* const ROPE = (unsigned*)(ws + WS_ROPE);

    if (IN(0))
#pragma clang loop unroll(full)
    for (int rep = 0; rep < DUPN(0); ++rep) {
        const int lane = LANE_ID(); const size_t gt = (size_t)bx * (NWAVES * 64) + wave * 64 + lane;
        LAS float* scr = (LAS float*)(L + RING_OFF + wave * 16384);
        constexpr int I_IN = (D / 64) * (INC / 32), I_OUT = (D / 64) * (D / 32), I_F1 = (D / 64) * (FF / 32), I_F2 = (FF / 64) * (D / 32), I_G = I_OUT, I_P = (PLE / 64) * (D / 32);
        constexpr int I_LAYER = I_IN + I_OUT + I_F1 + I_F2 + I_G + I_P;
        for (int it = gw; it < DEPTH * I_LAYER; it += NGW) {
            const int l = it / I_LAYER; int r = it % I_LAYER; unsigned char* wl = ws + WS_W + (size_t)l * W_LAYER;
            if (r < I_IN) { tr_item<true>(a.w_in + (size_t)l * D * INC, D, INC, a.norm_mix_g + l * D, (bf16*)(wl + WO_IN), scr, r, lane); continue; } r -= I_IN;
            if (r < I_OUT) { tr_item<false>(a.w_out + (size_t)l * D * D, D, D, nullptr, (bf16*)(wl + WO_OUT), scr, r, lane); continue; } r -= I_OUT;
            if (r < I_F1) { tr_item<false>(a.w_ff1 + (size_t)l * D * FF, D, FF, a.norm_ffn_g + l * D, (bf16*)(wl + WO_FF1), scr, r, lane); continue; } r -= I_F1;
            if (r < I_F2) { tr_item<false>(a.w_ff2 + (size_t)l * FF * D, FF, D, nullptr, (bf16*)(wl + WO_FF2), scr, r, lane); continue; } r -= I_F2;
            if (r < I_G) { tr_item<false>(a.w_gate + (size_t)l * D * D, D, D, a.norm_ple_g + l * D, (bf16*)(wl + WO_GATE), scr, r, lane); continue; } r -= I_G;
            tr_item<false>(a.w_proj + (size_t)l * PLE * D, PLE, D, nullptr, (bf16*)(wl + WO_PROJ), scr, r, lane);
        }
        float* ss0 = (float*)(ws + WS_SS);
        for (int m = gw; m < M; m += NGW) {
            const GAS f32x4* xr = (const GAS f32x4*)(a.x + (size_t)m * D) + lane; f32x4 v[4]; float s = 0.f;
#pragma unroll
            for (int j = 0; j < 4; ++j) { v[j] = xr[64 * j]; s += (v[j].x * v[j].x + v[j].y * v[j].y) + (v[j].z * v[j].z + v[j].w * v[j].w); }
            s = wave_sum(s);
            GAS unsigned long long* o8 = (GAS unsigned long long*)(XB + (size_t)m * D) + lane;
#pragma unroll
            for (int j = 0; j < 4; ++j) o8[64 * j] = (unsigned long long)pk2(v[j].x, v[j].y) | ((unsigned long long)pk2(v[j].z, v[j].w) << 32);
            if (lane < 16) ss0[(size_t)m * 16 + lane] = lane == 0 ? s : 0.f;
        }
        for (size_t i = gt; i < (size_t)DEPTH * M * PLE / 8; i += NGT) {
            const f32x4 p0 = *(const GAS f32x4*)(a.p + i * 8), p1 = *(const GAS f32x4*)(a.p + i * 8 + 4);
            v4u o; o.x = pk2(p0.x, p0.y); o.y = pk2(p0.z, p0.w); o.z = pk2(p1.x, p1.y); o.w = pk2(p1.z, p1.w);
            *(GAS v4u*)(PB + i * 8) = o;
        }
        for (size_t i = gt; i < (size_t)M * 64; i += NGT) {
            const int d = (int)(i & 63); const size_t m = i >> 6;
            const float inv_freq = 1.0f / powf(10000.0f, (float)d * (2.0f / RD)), ang = (float)a.pos[m] * inv_freq;
            const pg8::f16x2 cs = {(_Float16)cosf(ang), (_Float16)sinf(ang)};
            ROPE[i] = __builtin_bit_cast(unsigned, cs);
        }
    }
    SEAM(0);
#pragma clang loop unroll(full)
    for (int l = 0; l < DEPTH; ++l) {
        const int pb = 1 + 8 * l;
        bf16* const XC = (l & 1) ? XO : XB; bf16* const XN = (l & 1) ? XB : XO;
        unsigned char* wl = ws + WS_W + (size_t)l * W_LAYER;
        float* const ss_a = (float*)(ws + WS_SS + (size_t)(3 * l + 0) * SS_SITE);
        float* const ss_b = (float*)(ws + WS_SS + (size_t)(3 * l + 1) * SS_SITE);
        float* const ss_c = (float*)(ws + WS_SS + (size_t)(3 * l + 2) * SS_SITE);
        float* const ss_d = (float*)(ws + WS_SS + (size_t)(3 * l + 3) * SS_SITE);
        if (IN(pb + 0))
#pragma clang loop unroll(full)
        for (int rep = 0; rep < DUPN(pb + 0); ++rep) {
            pg8::Gemm g{XC, (const bf16*)(wl + WO_IN), M, INC, D}; pg8::StaticOrder S; S.init(M, INC, G, bx);
            pg8::EpiInProj E{ZB, ss_a, ROPE};
            pg8::gemm_phase<pg8::EpiInProj, pg8::StaticOrder, true, true>(L + RING_OFF, g, S, E, wave);
        }
        SEAM(pb + 0);
        if (IN(pb + 1))
#pragma clang loop unroll(full)
        for (int rep = 0; rep < DUPN(pb + 1); ++rep) {
            mx::conv_phase(L, ZB, MIXB, ARGP(dw_w) + l * CONVW * CCH, ARGP(dw_b) + l * CCH, ARGP(ln_g) + l * CCH, ARGP(ln_b) + l * CCH, bx, wave);
            mx::ret_state_phase(L, ZB, TF, bx, wave);
        }
        SEAM(pb + 1);
        if (IN(pb + 2))
#pragma clang loop unroll(full)
        for (int rep = 0; rep < DUPN(pb + 2); ++rep) mx::ret_out_phase(L, ZB, MIXB, TF, ARGP(gn_g) + l * RW, ARGP(gn_b) + l * RW, bx, wave);
        SEAM(pb + 2);
        if (IN(pb + 3))
#pragma clang loop unroll(full)
        for (int rep = 0; rep < 1; ++rep) {
            pg8::Gemm g{MIXB, (const bf16*)(wl + WO_OUT), M, D, D}; pg8::StaticOrder S; S.init(M, D, G, bx);
            pg8::EpiResid<0> E{XC, XC, ss_b, nullptr, nullptr};
            pg8::gemm_phase<pg8::EpiResid<0>, pg8::StaticOrder, true, true>(L + RING_OFF, g, S, E, wave);
        }
        SEAM(pb + 3);
        if (IN(pb + 4))
#pragma clang loop unroll(full)
        for (int rep = 0; rep < DUPN(pb + 4); ++rep) {
            pg8::Gemm g{XC, (const bf16*)(wl + WO_FF1), M, FF, D}; pg8::StaticOrder S; S.init(M, FF, G, bx);
            pg8::EpiFF1 E{HID, ss_b};
            pg8::gemm_phase<pg8::EpiFF1, pg8::StaticOrder, true, true>(L + RING_OFF, g, S, E, wave);
        }
        SEAM(pb + 4);
        if (IN(pb + 5)) {
            pg8::Gemm g{HID, (const bf16*)(wl + WO_FF2), M, D, FF}; pg8::StaticOrder S; S.init(M, D, G, bx);
            pg8::EpiResid<0> E{XC, XC, ss_c, nullptr, nullptr};
            pg8::gemm_phase<pg8::EpiResid<0>, pg8::StaticOrder, true, true>(L + RING_OFF, g, S, E, wave);
        }
        SEAM(pb + 5);
        if (IN(pb + 6))
#pragma clang loop unroll(full)
        for (int rep = 0; rep < DUPN(pb + 6); ++rep) {
            pg8::Gemm g{PB + (size_t)l * M * PLE, (const bf16*)(wl + WO_PROJ), M, D, PLE}; pg8::StaticOrder S; S.init(M, D, G, bx);
            pg8::EpiPlain E{PROJ};
            pg8::gemm_phase<pg8::EpiPlain, pg8::StaticOrder, true, true>(L + RING_OFF, g, S, E, wave);
        }
        SEAM(pb + 6);
        if (IN(pb + 7)) {
            pg8::Gemm g{XC, (const bf16*)(wl + WO_GATE), M, D, D}; pg8::StaticOrder S; S.init(M, D, G, bx);
            pg8::EpiResid<1> E{XC, XN, ss_d, ss_c, PROJ};
            pg8::gemm_phase<pg8::EpiResid<1>, pg8::StaticOrder, true, true>(L + RING_OFF, g, S, E, wave);
        }
        SEAM(pb + 7);
    }
    if (IN(17)) {
        const int lane = LANE_ID();
        const float* ssf = (const float*)(ws + WS_SS + (size_t)6 * SS_SITE);
        const bf16* XF = (DEPTH & 1) ? XO : XB;
        const GAS f32x4* gr = (const GAS f32x4*)ARGP(final_g) + 2 * lane; const f32x4 g0 = gr[0], g1 = gr[1], g2 = gr[128], g3 = gr[129];
        for (int m = gw; m < M; m += NGW) {
            const float rs = pg8::rstd_of(ssf, m);
            const GAS v4u* xr = (const GAS v4u*)(XF + (size_t)m * D) + lane; GAS f32x4* orow = (GAS f32x4*)(a.out + (size_t)m * D) + 2 * lane;
            f32x4 a0, a1, b0, b1; pg8::unpack8(xr[0], a0, a1); pg8::unpack8(xr[64], b0, b1);
            orow[0] = a0 * rs * g0; orow[1] = a1 * rs * g1; orow[128] = b0 * rs * g2; orow[129] = b1 * rs * g3;
        }
    }
#undef IN
#undef SEAM
}

extern "C" void kernel_launch(void* const* d_in, const int* in_sizes, int n_in, void* d_out, int out_size, void* d_ws, size_t ws_size, hipStream_t stream) {
    static int grid = 0;
    if (grid == 0) {
        if (n_in != 19 || out_size != M * D || ws_size < WS_END) { fprintf(stderr, "kernel_launch: unexpected problem (n_in %d, out %d, ws %zu < %zu); nothing launched\n", n_in, out_size, ws_size, (size_t)WS_END); grid = -1; return; }
        int dev = 0, cus = 0;
        if (hipGetDevice(&dev) != hipSuccess || hipDeviceGetAttribute(&cus, hipDeviceAttributeMultiprocessorCount, dev) != hipSuccess) { grid = -1; return; }
        if (hipFuncSetAttribute((const void*)mk_fwd, hipFuncAttributeMaxDynamicSharedMemorySize, LDS_BYTES) != hipSuccess) { fprintf(stderr, "kernel_launch: hipFuncSetAttribute failed\n"); grid = -1; return; }
        int per_cu = 0;
        if (hipOccupancyMaxActiveBlocksPerMultiprocessor(&per_cu, (const void*)mk_fwd, NWAVES * 64, LDS_BYTES) != hipSuccess || per_cu < 1) fprintf(stderr, "kernel_launch: occupancy query says %d\n", per_cu);
        (void)hipGetLastError();
        if (cus < 256) fprintf(stderr, "kernel_launch: %d CUs < 256: the grid cannot be resident\n", cus);
        grid = 256;
    }
    if (grid < 0) return;
    (void)hipMemsetAsync((char*)d_ws + WS_CTL, 0, CTL_ZERO_BYTES, stream);
    Args a{};
    a.x = (const float*)d_in[0]; a.p = (const float*)d_in[1]; a.pos = (const int*)d_in[2]; a.norm_mix_g = (const float*)d_in[3]; a.w_in = (const float*)d_in[4]; a.dw_w = (const float*)d_in[5];
    a.dw_b = (const float*)d_in[6]; a.ln_g = (const float*)d_in[7]; a.ln_b = (const float*)d_in[8]; a.gn_g = (const float*)d_in[9]; a.gn_b = (const float*)d_in[10]; a.w_out = (const float*)d_in[11];
    a.norm_ffn_g = (const float*)d_in[12]; a.w_ff1 = (const float*)d_in[13]; a.w_ff2 = (const float*)d_in[14]; a.norm_ple_g = (const float*)d_in[15]; a.w_gate = (const float*)d_in[16];
    a.w_proj = (const float*)d_in[17]; a.final_g = (const float*)d_in[18]; a.out = (float*)d_out; a.ws = (unsigned char*)d_ws;
    a.ph_lo = 0; a.ph_hi = 18; a.li = 0;
    hipLaunchKernelGGL(mk_fwd, dim3(grid), dim3(NWAVES * 64), LDS_BYTES, stream, a);
}
```

```cpp
#include <hip/hip_runtime.h>
#include <cstdio>
#include <cstdint>
#include <cstddef>
namespace pg8 {
#define PG8_LAS __attribute__((address_space(3)))
typedef unsigned short bf16_t;
typedef short bf16x8 __attribute__((ext_vector_type(8)));
typedef float f32x4 __attribute__((ext_vector_type(4)));
typedef unsigned u32x4 __attribute__((ext_vector_type(4)));
typedef unsigned u32x2 __attribute__((ext_vector_type(2)));
constexpr int BM = 256, BK = 64, HALF = 128, HTB = HALF * BK * 2  , STAGE_BYTES = 8 * HTB, NXCD = 8, WGM = 8;

__host__ __device__ __forceinline__ int lds_byte(int r, int c) { const int st = (r >> 4) * 2 + (c >> 5), rr = r & 15, cc = c & 31, ob = rr * 64 + cc * 2; return st * 1024 + (ob ^ (((ob >> 9) & 1) << 5)); }
__host__ __device__ __forceinline__ void stage_rc(int b, int& R, int& C) { const int st = b / 1024, sb = b % 1024, swz = sb ^ (((sb >> 9) & 1) << 5); R = (st >> 1) * 16 + swz / 64; C = (st & 1) * 32 + (swz % 64) / 2; }
__host__ __device__ __forceinline__ int perm32(int rho) { const int n = rho >> 4, i = rho & 15; return 8 * (i >> 2) + 4 * n + (i & 3); }

struct Unit { int pm, pn; };
struct Gemm { const bf16_t* A; const bf16_t* Bt; int M, N, K; };

struct StaticOrder {
    int nM, nN, nwg, G, c;
    __host__ __device__ void init(int M, int N, int G_, int c_) { nM = M / BM; nN = N / BM; nwg = nM * nN; G = G_; c = c_; }
    __host__ __device__ bool next(int i, Unit& u) const {
        const long L = (long)i * G + c; if (L >= nwg) return false;
        int wgid = (int)L; { const int q = nwg / NXCD, r = nwg % NXCD, xcd = wgid % NXCD, off = wgid / NXCD; wgid = (xcd < r ? xcd * (q + 1) : r * (q + 1) + (xcd - r) * q) + off; }
        const int nig = WGM * nN, gid = wgid / nig, fm = gid * WGM, gsz = (nM - fm) < WGM ? (nM - fm) : WGM;
        u.pm = fm + ((wgid % nig) % gsz); u.pn = (wgid % nig) / gsz; return true;
    }
    __device__ __forceinline__ void a_ready(const Unit&) const {}
    __device__ __forceinline__ void done(const Unit&) const {}
};

__device__ __forceinline__ unsigned cvt_pk_bf16(float lo, float hi) { unsigned r; asm volatile("v_cvt_pk_bf16_f32 %0, %1, %2" : "=v"(r) : "v"(lo), "v"(hi)); return r; }
__device__ __forceinline__ u32x4 pack8(const f32x4 a, const f32x4 b) { u32x4 w; w.x = cvt_pk_bf16(a[0], a[1]); w.y = cvt_pk_bf16(a[2], a[3]); w.z = cvt_pk_bf16(b[0], b[1]); w.w = cvt_pk_bf16(b[2], b[3]); return w; }
__device__ __forceinline__ float fast_sigmoid(float x) { return __builtin_amdgcn_rcpf(1.0f + __builtin_amdgcn_exp2f(x * -1.4426950408889634f)); }
__device__ __forceinline__ f32x4 sig4(const f32x4 v) { return (f32x4){fast_sigmoid(v[0]), fast_sigmoid(v[1]), fast_sigmoid(v[2]), fast_sigmoid(v[3])}; }
constexpr int SSP = 16;
constexpr float RMS_EPS_ = 1e-6f;
__device__ __forceinline__ float rstd_of(const float* ss, int row) {
    const f32x4* p = (const f32x4*)(ss + (size_t)row * SSP); const f32x4 a = p[0], b = p[1], c = p[2], d = p[3];
    const f32x4 s = (a + b) + (c + d); return rsqrtf(((s[0] + s[1]) + (s[2] + s[3])) * (1.0f / 1024.0f) + RMS_EPS_);
}
typedef _Float16 f16x2 __attribute__((ext_vector_type(2)));

struct EpiInProj {
    static constexpr bool PERM = true, AFTER_DRAIN = false;
    bf16_t* ZB; const float* ss; const unsigned* rope;
    static constexpr int ZP = 2560;
    __device__ __forceinline__ void operator()(const f32x4 (&acc)[2][2][4][2], const Unit& u, int wr, int wc, int fr, int fq) const {
        const int row0 = u.pm * BM + wr * 64 + fr, pn = u.pn, lc = wc * 32 + 8 * fq;
        if (pn < 4) {
#pragma unroll
            for (int ai = 0; ai < 2; ++ai)
#pragma unroll
                for (int m = 0; m < 4; ++m) { const int row = row0 + ai * HALF + m * 16; const float rs = rstd_of(ss, row);
                    const f32x4 h0 = (acc[ai][0][m][0] * rs) * sig4(acc[ai][1][m][0] * rs), h1 = (acc[ai][0][m][1] * rs) * sig4(acc[ai][1][m][1] * rs);
                    *(u32x4*)(ZB + (size_t)row * ZP + pn * 128 + lc) = pack8(h0, h1); asm volatile("" ::: "memory"); }
        } else if (pn < 8) {
            const int head = 2 * (pn & 1) + (wc >> 1), d0 = lc & 63, colb = (pn < 6 ? 512 : 1024) + head * 128 + d0;
#pragma unroll
            for (int ai = 0; ai < 2; ++ai)
#pragma unroll
                for (int m = 0; m < 4; ++m) { const int row = row0 + ai * HALF + m * 16; const float rs = rstd_of(ss, row);
                    const u32x4* rp = (const u32x4*)(rope + (size_t)row * 64 + d0); const u32x4 r0 = rp[0], r1 = rp[1];
                    f32x4 o1[2], o2[2];
                    const unsigned rv[8] = {r0.x, r0.y, r0.z, r0.w, r1.x, r1.y, r1.z, r1.w};
#pragma unroll
                    for (int n = 0; n < 2; ++n) {
#pragma unroll
                        for (int i = 0; i < 4; ++i) { const f16x2 cs = __builtin_bit_cast(f16x2, rv[4 * n + i]); const float c = (float)cs[0], s = (float)cs[1];
                            const float t1 = acc[ai][0][m][n][i] * rs, t2 = acc[ai][1][m][n][i] * rs; o1[n][i] = t1 * c - t2 * s; o2[n][i] = t2 * c + t1 * s; } }
                    bf16_t* zp = ZB + (size_t)row * ZP + colb; *(u32x4*)zp = pack8(o1[0], o1[1]); *(u32x4*)(zp + 64) = pack8(o2[0], o2[1]); asm volatile("" ::: "memory"); }
        } else {
            const int colb = 1536 + (pn - 8) * 256 + lc;
#pragma unroll
            for (int ai = 0; ai < 2; ++ai)
#pragma unroll
                for (int m = 0; m < 4; ++m) { const int row = row0 + ai * HALF + m * 16; const float rs = rstd_of(ss, row);
#pragma unroll
                    for (int bj = 0; bj < 2; ++bj) { f32x4 v0 = acc[ai][bj][m][0] * rs, v1 = acc[ai][bj][m][1] * rs;
                        *(u32x4*)(ZB + (size_t)row * ZP + colb + bj * HALF) = pack8(v0, v1); } asm volatile("" ::: "memory"); }
        }
    }
};
__device__ __forceinline__ void unpack8(const u32x4 w, f32x4& a, f32x4& b) {
    a = (f32x4){__uint_as_float(w.x << 16), __uint_as_float(w.x & 0xffff0000u), __uint_as_float(w.y << 16), __uint_as_float(w.y & 0xffff0000u)};
    b = (f32x4){__uint_as_float(w.z << 16), __uint_as_float(w.z & 0xffff0000u), __uint_as_float(w.w << 16), __uint_as_float(w.w & 0xffff0000u)};
}
template <int MODE> struct EpiResid {
    static constexpr bool PERM = true, AFTER_DRAIN = false;
    const bf16_t* XI; bf16_t* XO; float* ss_out; const float* ss_in; const bf16_t* proj;
    __device__ __forceinline__ void operator()(const f32x4 (&acc)[2][2][4][2], const Unit& u, int wr, int wc, int fr, int fq) const {
        const int row0 = u.pm * BM + wr * 64 + fr, col0 = u.pn * BM + wc * 32 + 8 * fq;
#pragma unroll
        for (int ai = 0; ai < 2; ++ai)
#pragma unroll
            for (int m = 0; m < 4; ++m) { const int row = row0 + ai * HALF + m * 16; const size_t off = (size_t)row * 1024 + col0; float q = 0.f;
                float rs = 1.f; if (MODE == 1) rs = rstd_of(ss_in, row);
#pragma unroll
                for (int bj = 0; bj < 2; ++bj) { f32x4 b0, b1; unpack8(*(const u32x4*)(XI + off + bj * HALF), b0, b1);
                    f32x4 v0, v1;
                    if (MODE == 1) { f32x4 p0, p1; unpack8(*(const u32x4*)(proj + off + bj * HALF), p0, p1);
                        v0 = b0 + sig4(acc[ai][bj][m][0] * rs) * p0; v1 = b1 + sig4(acc[ai][bj][m][1] * rs) * p1; }
                    else { v0 = b0 + acc[ai][bj][m][0]; v1 = b1 + acc[ai][bj][m][1]; }
                    *(u32x4*)(XO + off + bj * HALF) = pack8(v0, v1);
                    q += (v0[0] * v0[0] + v0[1] * v0[1]) + (v0[2] * v0[2] + v0[3] * v0[3]) + (v1[0] * v1[0] + v1[1] * v1[1]) + (v1[2] * v1[2] + v1[3] * v1[3]); }
                q += __shfl_xor(q, 16); q += __shfl_xor(q, 32);
                if (fq == 0) ss_out[(size_t)row * SSP + u.pn * 4 + wc] = q; asm volatile("" ::: "memory"); }
    }
};
struct EpiFF1 {
    static constexpr bool PERM = true, AFTER_DRAIN = false;
    bf16_t* H; const float* ss;
    __device__ __forceinline__ void operator()(const f32x4 (&acc)[2][2][4][2], const Unit& u, int wr, int wc, int fr, int fq) const {
        const int row0 = u.pm * BM + wr * 64 + fr, col0 = u.pn * BM + wc * 32 + 8 * fq;
#pragma unroll
        for (int ai = 0; ai < 2; ++ai)
#pragma unroll
            for (int m = 0; m < 4; ++m) { const int row = row0 + ai * HALF + m * 16; const float rs = rstd_of(ss, row);
#pragma unroll
                for (int bj = 0; bj < 2; ++bj) { f32x4 v0 = acc[ai][bj][m][0] * rs, v1 = acc[ai][bj][m][1] * rs;
                    v0 = __builtin_elementwise_max(v0, (f32x4){0.f, 0.f, 0.f, 0.f}); v1 = __builtin_elementwise_max(v1, (f32x4){0.f, 0.f, 0.f, 0.f}); v0 = v0 * v0; v1 = v1 * v1;
                    *(u32x4*)(H + (size_t)row * 4096 + col0 + bj * HALF) = pack8(v0, v1); } asm volatile("" ::: "memory"); }
    }
};
struct EpiPlain {
    static constexpr bool PERM = true, AFTER_DRAIN = false;
    bf16_t* O;
    __device__ __forceinline__ void operator()(const f32x4 (&acc)[2][2][4][2], const Unit& u, int wr, int wc, int fr, int fq) const {
        const int row0 = u.pm * BM + wr * 64 + fr, col0 = u.pn * BM + wc * 32 + 8 * fq;
#pragma unroll
        for (int ai = 0; ai < 2; ++ai)
#pragma unroll
            for (int m = 0; m < 4; ++m) { const int row = row0 + ai * HALF + m * 16;
#pragma unroll
                for (int bj = 0; bj < 2; ++bj) *(u32x4*)(O + (size_t)row * 1024 + col0 + bj * HALF) = pack8(acc[ai][bj][m][0], acc[ai][bj][m][1]); }
    }
};

template <class Epi, class Sched, bool ALIGN_EPI = false, bool SP2 = false>
__device__ __forceinline__ void gemm_phase(PG8_LAS unsigned char* lds, const Gemm g, const Sched& S, const Epi& E, const int wave_id) {
    unsigned z_ = 0u; asm volatile("" : "+v"(z_)); const int tid_ = wave_id * 64 + (int)__builtin_amdgcn_mbcnt_hi(~0u, __builtin_amdgcn_mbcnt_lo(~0u, z_));
    const int tid = tid_, wid = wave_id, lane = tid & 63, wr = wid >> 2, wc = wid & 3, fr = lane & 15, fq = lane >> 4;
    const int K = g.K, nt = K / BK;
    unsigned voffA[2], voffB[2];
#pragma unroll
    for (int i = 0; i < 2; ++i) { int R, C; stage_rc(tid * 16 + i * 8192, R, C); const int Rb = Epi::PERM ? ((R & ~31) + perm32(R & 31)) : R;
        voffA[i] = (unsigned)(R * K + C) * 2u; voffB[i] = (unsigned)(Rb * K + C) * 2u; }
    const size_t kstep = (size_t)(BK * 2);
    const size_t hstep = (size_t)HALF * K * 2;
    const size_t tstep = 2 * hstep;
    const unsigned ldsw = (unsigned)wid * 1024u;
    const int aoff = lds_byte(wr * 64 + fr, fq * 8), boff = lds_byte(wc * 32 + fr, fq * 8);
#define PG8_SA(b, h) (((b) * 2 + (h)) * HTB)
#define PG8_SB(b, h) ((4 + (b) * 2 + (h)) * HTB)
#define PG8_STAGE(bufoff, gbase, voff) do { _Pragma("unroll") for (int _i = 0; _i < 2; ++_i) \
        __builtin_amdgcn_global_load_lds((const unsigned*)((const char*)(gbase) + (voff)[_i]), (PG8_LAS unsigned*)(lds + (bufoff) + ldsw + _i * 8192), 16, 0, 0); } while (0)
#define PG8_LDA(dst, b, h) do { _Pragma("unroll") for (int m = 0; m < 4; ++m) _Pragma("unroll") for (int k = 0; k < 2; ++k) dst[m][k] = *(const PG8_LAS bf16x8*)(lds + PG8_SA(b, h) + aoff + m * 2048 + k * 1024); } while (0)
#define PG8_LDB(dst, b, h) do { _Pragma("unroll") for (int n = 0; n < 2; ++n) _Pragma("unroll") for (int k = 0; k < 2; ++k) dst[n][k] = *(const PG8_LAS bf16x8*)(lds + PG8_SB(b, h) + boff + n * 2048 + k * 1024); } while (0)
#define PG8_MMA(ai, bj, At, Bt) do { __builtin_amdgcn_s_setprio(1); _Pragma("unroll") for (int m = 0; m < 4; ++m) _Pragma("unroll") for (int n = 0; n < 2; ++n) _Pragma("unroll") for (int k = 0; k < 2; ++k) \
        acc[ai][bj][m][n] = __builtin_amdgcn_mfma_f32_16x16x32_bf16(Bt[n][k], At[m][k], acc[ai][bj][m][n], 0, 0, 0); __builtin_amdgcn_s_setprio(0); } while (0)
#define PG8_WAIT_V(n) asm volatile("s_waitcnt vmcnt(" #n ")" ::: "memory")
#define PG8_WAIT_L(n) asm volatile("s_waitcnt lgkmcnt(" #n ")" ::: "memory")
#define PG8_BAR __builtin_amdgcn_s_barrier()
#define PG8_SCHED __builtin_amdgcn_sched_barrier(0)
    Unit cur, nxt; int ui = 0;
    if (!S.next(0, cur)) return;
    f32x4 acc[2][2][4][2];
#pragma unroll
    for (int a = 0; a < 2; ++a)
#pragma unroll
        for (int b = 0; b < 2; ++b)
#pragma unroll
            for (int m = 0; m < 4; ++m)
#pragma unroll
                for (int n = 0; n < 2; ++n) acc[a][b][m][n] = (f32x4){0.f, 0.f, 0.f, 0.f};
    bf16x8 At[4][2], B0[2][2], B1[2][2];
    const char* cA = (const char*)g.A + (size_t)cur.pm * tstep; const char* cB = (const char*)g.Bt + (size_t)cur.pn * tstep;
    S.a_ready(cur);
    if constexpr (SP2) {
        PG8_STAGE(PG8_SB(0, 0), cB, voffB); PG8_STAGE(PG8_SB(0, 1), cB + hstep, voffB); PG8_STAGE(PG8_SA(0, 0), cA, voffA); PG8_STAGE(PG8_SA(0, 1), cA + hstep, voffA);
        if (wr == 1) PG8_BAR;
        PG8_WAIT_V(2); PG8_BAR;
        PG8_STAGE(PG8_SB(1, 0), cB + kstep, voffB); PG8_STAGE(PG8_SA(1, 0), cA + kstep, voffA); PG8_STAGE(PG8_SB(1, 1), cB + hstep + kstep, voffB);
        PG8_WAIT_V(6); PG8_BAR;
    } else {
        PG8_STAGE(PG8_SB(0, 0), cB, voffB); PG8_STAGE(PG8_SA(0, 0), cA, voffA); PG8_STAGE(PG8_SB(0, 1), cB + hstep, voffB); PG8_STAGE(PG8_SA(0, 1), cA + hstep, voffA);
        if (wr == 1) PG8_BAR;
        PG8_WAIT_V(4); PG8_BAR;
        PG8_STAGE(PG8_SB(1, 0), cB + kstep, voffB); PG8_STAGE(PG8_SA(1, 0), cA + kstep, voffA); PG8_STAGE(PG8_SB(1, 1), cB + hstep + kstep, voffB);
        PG8_WAIT_V(6); PG8_BAR;
    }
    for (;;) {
        const bool has_next = S.next(ui + 1, nxt);
        const char* nA = has_next ? (const char*)g.A + (size_t)nxt.pm * tstep : cA; const char* nB = has_next ? (const char*)g.Bt + (size_t)nxt.pn * tstep : cB;
        for (int t = 0; t < nt; t += 2) {
            const bool last = (t == nt - 2);
            const char* a1 = cA + (size_t)(t + 1) * kstep;
            const char* a2 = last ? nA : cA + (size_t)(t + 2) * kstep; const char* b2 = last ? nB : cB + (size_t)(t + 2) * kstep;
            const char* a3 = a2 + kstep; const char* b3 = b2 + kstep;
            if (last && has_next) S.a_ready(nxt);
            if constexpr (SP2) {
            PG8_LDB(B0, 0, 0); PG8_LDB(B1, 0, 1); PG8_SCHED; PG8_LDA(At, 0, 0); PG8_STAGE(PG8_SA(1, 1), a1 + hstep, voffA);
            PG8_WAIT_V(8); PG8_WAIT_L(0); PG8_BAR; PG8_MMA(0, 0, At, B0); PG8_MMA(0, 1, At, B1); PG8_BAR; PG8_SCHED;
            PG8_LDA(At, 0, 1); PG8_STAGE(PG8_SB(0, 0), b2, voffB); PG8_STAGE(PG8_SB(0, 1), b2 + hstep, voffB); PG8_STAGE(PG8_SA(0, 0), a2, voffA);
            PG8_WAIT_V(8); PG8_WAIT_L(0); PG8_BAR; PG8_MMA(1, 0, At, B0); PG8_MMA(1, 1, At, B1); PG8_BAR; PG8_SCHED;
            PG8_LDB(B0, 1, 0); PG8_LDB(B1, 1, 1); PG8_SCHED; PG8_LDA(At, 1, 0); PG8_STAGE(PG8_SA(0, 1), a2 + hstep, voffA);
            PG8_WAIT_V(8); PG8_WAIT_L(0); PG8_BAR; PG8_MMA(0, 0, At, B0); PG8_MMA(0, 1, At, B1); PG8_BAR; PG8_SCHED;
            PG8_LDA(At, 1, 1); PG8_STAGE(PG8_SB(1, 0), b3, voffB); PG8_STAGE(PG8_SB(1, 1), b3 + hstep, voffB); PG8_STAGE(PG8_SA(1, 0), a3, voffA);
            PG8_WAIT_V(8); PG8_WAIT_L(0); PG8_BAR; PG8_MMA(1, 0, At, B0); PG8_MMA(1, 1, At, B1); PG8_BAR; PG8_SCHED;
            } else {
            PG8_LDB(B0, 0, 0); PG8_SCHED; PG8_LDA(At, 0, 0); PG8_STAGE(PG8_SA(1, 1), a1 + hstep, voffA);
            PG8_WAIT_L(8); PG8_BAR; PG8_WAIT_L(0); PG8_MMA(0, 0, At, B0); PG8_BAR; PG8_SCHED;
            PG8_LDB(B1, 0, 1); PG8_STAGE(PG8_SB(0, 0), b2, voffB);
            PG8_BAR; PG8_WAIT_L(0); PG8_MMA(0, 1, At, B1); PG8_BAR;
            PG8_LDA(At, 0, 1); PG8_STAGE(PG8_SA(0, 0), a2, voffA);
            PG8_BAR; PG8_WAIT_L(0); PG8_MMA(1, 0, At, B0); PG8_BAR; PG8_SCHED;
            PG8_STAGE(PG8_SB(0, 1), b2 + hstep, voffB);
            PG8_WAIT_V(6); PG8_BAR; PG8_MMA(1, 1, At, B1); PG8_BAR;
            PG8_LDB(B0, 1, 0); PG8_SCHED; PG8_LDA(At, 1, 0); PG8_STAGE(PG8_SA(0, 1), a2 + hstep, voffA);
            PG8_WAIT_L(8); PG8_BAR; PG8_WAIT_L(0); PG8_MMA(0, 0, At, B0); PG8_BAR; PG8_SCHED;
            PG8_LDB(B1, 1, 1); PG8_STAGE(PG8_SB(1, 0), b3, voffB);
            PG8_BAR; PG8_WAIT_L(0); PG8_MMA(0, 1, At, B1); PG8_BAR;
            PG8_LDA(At, 1, 1); PG8_STAGE(PG8_SA(1, 0), a3, voffA);
            PG8_BAR; PG8_WAIT_L(0); PG8_MMA(1, 0, At, B0); PG8_BAR; PG8_SCHED;
            PG8_STAGE(PG8_SB(1, 1), b3 + hstep, voffB);
            PG8_WAIT_V(6); PG8_BAR; PG8_MMA(1, 1, At, B1); PG8_BAR;
            }
        }
        if constexpr (ALIGN_EPI) { if (wr == 0) PG8_BAR; }
        if constexpr (!Epi::AFTER_DRAIN) { E(acc, cur, wr, wc, fr, fq); S.done(cur); }
        if (!has_next) break;
#pragma unroll
        for (int a = 0; a < 2; ++a)
#pragma unroll
            for (int b = 0; b < 2; ++b)
#pragma unroll
                for (int m = 0; m < 4; ++m)
#pragma unroll
                    for (int n = 0; n < 2; ++n) acc[a][b][m][n] = (f32x4){0.f, 0.f, 0.f, 0.f};
        cur = nxt; cA = nA; cB = nB; ++ui;
        if constexpr (ALIGN_EPI) { if (wr == 1) PG8_BAR; }
    }
    PG8_WAIT_V(0);
    if constexpr (!ALIGN_EPI) { if (wr == 0) PG8_BAR; }
    PG8_BAR;
    if constexpr (Epi::AFTER_DRAIN) { E.fused(acc, cur, wr, wc, fr, fq, lds, wid, lane); S.done(cur); }
#undef PG8_SA
#undef PG8_SB
#undef PG8_STAGE
#undef PG8_LDA
#undef PG8_LDB
#undef PG8_MMA
#undef PG8_WAIT_V
#undef PG8_WAIT_L
#undef PG8_BAR
#undef PG8_SCHED
}
}

constexpr int NWAVES = 8;
constexpr int NB = 8, SEQ = 8192, D = 1024, DEPTH = 2, CCH = 512, CONVW = 31, RH = 4, RD = 128, RW = 512, RC = 128, FF = 4096, PLE = 256, INC = 3072;
constexpr int M = NB * SEQ;
constexpr int ZP = 2560;
constexpr float LN_EPS = 1e-5f;
constexpr size_t MiB = 1u << 20;
constexpr size_t WS_CTL = 0, CTL_ZERO_BYTES = 1 * MiB;
constexpr size_t WS_W = 2 * MiB, W_LAYER = 27 * MiB;
constexpr size_t WO_IN = 0, WO_OUT = 6 * MiB, WO_FF1 = 8 * MiB, WO_FF2 = 16 * MiB, WO_GATE = 24 * MiB, WO_PROJ = 26 * MiB;
constexpr size_t WS_SS = 56 * MiB, SS_SITE = 4 * MiB;
constexpr size_t WS_ROPE = 84 * MiB;
constexpr size_t WS_XB = 100 * MiB;
constexpr size_t WS_PB = 228 * MiB;
constexpr size_t WS_PROJ = 292 * MiB;
constexpr size_t WS_ZB = 420 * MiB;
constexpr size_t WS_T = 740 * MiB;
constexpr size_t WS_MIX = 756 * MiB;
constexpr size_t WS_HID = 420 * MiB;
constexpr size_t WS_END = 932 * MiB;
constexpr size_t WS_U = WS_XB, WS_S = WS_PROJ;
constexpr int CW_TMO = 0, CW_BAR = 4096;
constexpr int LDS_BYTES = 163840, RING_OFF = 0, MISC_OFF = 163840 - 256, ARGS_OFF = 163840 - 512;

#define GAS __attribute__((address_space(1)))
#define LAS __attribute__((address_space(3)))
typedef unsigned short bf16;
typedef unsigned v4u __attribute__((ext_vector_type(4)));
typedef float f32x4 __attribute__((ext_vector_type(4)));
typedef GAS unsigned gu32;
#define RLX_AGENT __ATOMIC_RELAXED, __HIP_MEMORY_SCOPE_AGENT
#define LDS_WAIT() asm volatile("s_waitcnt lgkmcnt(0)" ::: "memory")
__device__ __forceinline__ unsigned f2bf(float f) { unsigned u = __builtin_bit_cast(unsigned, f); return (u + 0x7fffu + ((u >> 16) & 1u)) >> 16; }
__device__ __forceinline__ unsigned pk2(float lo, float hi) { return f2bf(lo) | (f2bf(hi) << 16); }
__device__ __forceinline__ float bf2f(unsigned short b) { return __uint_as_float(((unsigned)b) << 16); }

__device__ __forceinline__ float wave_sum(float v) {
#pragma unroll
    for (int o = 1; o < 64; o <<= 1) v += __shfl_xor(v, o);
    return v;
}
#define XB_TMO      128
#define XB_XCNT(j)  (256  + 64 * (j))
#define XB_XSUB(j)  (1280 + 64 * (j))
#define XB_XGEN(j)  (2304 + 64 * (j))
#define XB_TOP      3328
#define XB_TOPGEN   3392
#define XCD_BAR_WORDS 3456
#define XB_SPIN_CAP (1u << 18)

__device__ __forceinline__ unsigned xb_ld(unsigned* p)              { return __hip_atomic_load(p, __ATOMIC_RELAXED, __HIP_MEMORY_SCOPE_AGENT); }
__device__ __forceinline__ unsigned xb_add(unsigned* p, unsigned v) { return __hip_atomic_fetch_add(p, v, __ATOMIC_RELAXED, __HIP_MEMORY_SCOPE_AGENT); }
__device__ __forceinline__ unsigned xb_xcc_id() { return (unsigned)__builtin_amdgcn_s_getreg((3 << 11) | 20) & 0xFu; }
#define XB_SPIN(cond, bar) do { unsigned _sp = 0; while (cond) { __builtin_amdgcn_s_sleep(1); \
    if ((++_sp & 255u) == 0u) { if (xb_ld(&(bar)[XB_TMO])) break; if (_sp > XB_SPIN_CAP) { atomicAdd(&(bar)[XB_TMO], 1u); break; } } } } while (0)

__device__ __forceinline__ int xb_fresh_lane() { unsigned z = 0u; asm volatile("" : "+v"(z)); return (int)__builtin_amdgcn_mbcnt_hi(~0u, __builtin_amdgcn_mbcnt_lo(~0u, z)); }
struct XcdBarrier {
    unsigned* bar; unsigned x; int wave;
    volatile LAS unsigned* st;
};

__device__ __forceinline__ XcdBarrier xcd_barrier_post(unsigned* bar, volatile LAS unsigned* st, int wave) {
    XcdBarrier b; b.bar = bar; b.x = xb_xcc_id(); b.st = st; b.wave = wave;
    if (wave == 0 && xb_fresh_lane() == 0) (void)xb_add(&bar[XB_XCNT(b.x)], 1u);
    return b;
}
__device__ __forceinline__ void xcd_barrier_complete(unsigned* bar, unsigned x, unsigned& nloc, unsigned& nx) {
    const unsigned G = gridDim.x * gridDim.y * gridDim.z;
    unsigned sum, cnt, mine, sp = 0u;
    for (;;) {
        sum = 0u; cnt = 0u; mine = 0u;
#pragma unroll
        for (unsigned j = 0; j < 16; ++j) { const unsigned c = xb_ld(&bar[XB_XCNT(j)]); sum += c; cnt += (c > 0u) ? 1u : 0u; mine = (j == x) ? c : mine; }
        if (sum == G) break;
        __builtin_amdgcn_s_sleep(1);
        if ((++sp & 255u) == 0u) { if (xb_ld(&bar[XB_TMO])) break; if (sp > XB_SPIN_CAP) { atomicAdd(&bar[XB_TMO], 1u); break; } }
    }
    nloc = mine > 0u ? mine : 1u; nx = cnt > 0u ? cnt : 1u;
}

__device__ __forceinline__ void xcd_barrier(const XcdBarrier& b) {
    asm volatile("s_waitcnt vmcnt(0)" ::: "memory");
    __syncthreads();
    if (b.wave == 0 && xb_fresh_lane() == 0) {
        unsigned* bar = b.bar;
        __builtin_amdgcn_s_waitcnt(0);
        unsigned nloc = b.st[0], nx = b.st[1];
        if (nloc == 0u) { xcd_barrier_complete(bar, b.x, nloc, nx); b.st[0] = nloc; b.st[1] = nx; }
        const unsigned old = xb_add(&bar[XB_XSUB(b.x)], 1u);
        const unsigned gen = old / nloc;
        if (old + 1u == (gen + 1u) * nloc) {
            __builtin_amdgcn_fence(__ATOMIC_RELEASE, "agent");
            asm volatile("s_waitcnt vmcnt(0)" ::: "memory");
            const unsigned og = xb_add(&bar[XB_TOP], 1u);
            const unsigned tg = og / nx;
            if (og + 1u == (tg + 1u) * nx) xb_add(&bar[XB_TOPGEN], 1u);
            else XB_SPIN(xb_ld(&bar[XB_TOPGEN]) == tg, bar);
            __builtin_amdgcn_fence(__ATOMIC_ACQUIRE, "agent");
            xb_add(&bar[XB_XGEN(b.x)], 1u);
            asm volatile("s_waitcnt vmcnt(0)" ::: "memory");
        } else {
            XB_SPIN(xb_ld(&bar[XB_XGEN(b.x)]) == gen, bar);
            __builtin_amdgcn_fence(__ATOMIC_ACQUIRE, "agent");
            asm volatile("s_waitcnt vmcnt(0)" ::: "memory");
        }
    }
    __syncthreads();
}

namespace mx {
typedef short s16x4 __attribute__((ext_vector_type(4)));
typedef short v4i16_t __attribute__((ext_vector_type(4)));
typedef short bf16x8 __attribute__((ext_vector_type(8)));
typedef float f32x2 __attribute__((ext_vector_type(2)));
typedef unsigned u32x2 __attribute__((ext_vector_type(2)));
constexpr int KI = 0, VI = 32768, QI = 65536, SI = 98304;

__device__ __forceinline__ unsigned off_b(unsigned row, unsigned ch) { return 256u * row + 16u * (ch ^ (((row & 3u) << 2) | ((row >> 2) & 3u))); }
__device__ __forceinline__ unsigned tr_addr(unsigned lane, unsigned c, unsigned ks, unsigned t) {
    const unsigned g = lane >> 4, q = (lane & 15u) >> 2, p = lane & 3u; return off_b(32u * ks + 8u * g + 4u * t + q, 2u * c + (p >> 1)) + 8u * (p & 1u);
}
__device__ __forceinline__ bf16x8 tr_frag(LAS const unsigned char* img, unsigned lane, unsigned c, unsigned ks) {
    const s16x4 lo = __builtin_bit_cast(s16x4, __builtin_amdgcn_ds_read_tr16_b64_v4i16((LAS v4i16_t*)(img + tr_addr(lane, c, ks, 0))));
    const s16x4 hi = __builtin_bit_cast(s16x4, __builtin_amdgcn_ds_read_tr16_b64_v4i16((LAS v4i16_t*)(img + tr_addr(lane, c, ks, 1))));
    return __builtin_shufflevector(lo, hi, 0, 1, 2, 3, 4, 5, 6, 7);
}
__device__ __forceinline__ bf16x8 row_frag(LAS const unsigned char* img, unsigned row, unsigned ch) { return *(LAS const bf16x8*)(img + off_b(row, ch)); }
__device__ __forceinline__ float gamma_log(int h) { return logf(1.0f - exp2f(-5.0f - (float)h)); }
__device__ __forceinline__ float to_sgpr(float v) { return __builtin_bit_cast(float, __builtin_amdgcn_readfirstlane(__builtin_bit_cast(int, v))); }
__device__ __forceinline__ int opaque_s(int v) { asm volatile("" : "+s"(v)); return v; }

__device__ __forceinline__ void tile_load(v4u (&v)[4], const bf16* src, int tid) {
    const GAS v4u* g = (const GAS v4u*)(src + (size_t)(tid >> 2) * ZP + (tid & 3) * 32);
#pragma unroll
    for (int c = 0; c < 4; ++c) v[c] = g[c];
}
template <bool SCALE> __device__ __forceinline__ void tile_store(LAS unsigned char* img, const v4u (&v)[4], float rowscale, int tid) {
    const int row = tid >> 2, c0 = (tid & 3) * 4;
#pragma unroll
    for (int c = 0; c < 4; ++c) {
        v4u o = v[c];
        if (SCALE) {
            const unsigned w[4] = {o.x, o.y, o.z, o.w}; unsigned r[4];
#pragma unroll
            for (int i = 0; i < 4; ++i) r[i] = pg8::cvt_pk_bf16(__uint_as_float(w[i] << 16) * rowscale, __uint_as_float(w[i] & 0xffff0000u) * rowscale);
            o.x = r[0]; o.y = r[1]; o.z = r[2]; o.w = r[3];
        }
        *(LAS v4u*)(img + off_b(row, c0 + c)) = o;
    }
}
#define MX_MFMA(a, b, c) __builtin_amdgcn_mfma_f32_16x16x32_bf16((a), (b), (c), 0, 0, 0)

__device__ __forceinline__ void conv_phase(LAS unsigned char* L, const bf16* ZB, bf16* MIXB, const float* dw_w, const float* dw_b, const float* ln_g, const float* ln_b, int bx, int wave) {
    const int lane0 = xb_fresh_lane(), cp0 = (wave * 64 + lane0) & 255, half = wave >> 2;
    f32x2 w2[CONVW];
#pragma unroll
    for (int j = 0; j < CONVW; ++j) w2[j] = *(const GAS f32x2*)(dw_w + j * CCH + 2 * cp0);
    const f32x2 b2 = *(const GAS f32x2*)(dw_b + 2 * cp0);
    LAS float* CT = (LAS float*)L;
    for (int tile = 0; tile < 4; ++tile) {
        int lane = lane0; asm volatile("" : "+v"(lane));
        const int cp = (wave * 64 + lane) & 255;
        const int mt = bx * 256 + tile * 64, t0 = (mt % SEQ) + 32 * half;
        const bf16* src = ZB + ((long)(mt + 32 * half) - (CONVW - 1)) * ZP + 2 * cp;
        f32x2 acc[32];
#pragma unroll
        for (int t = 0; t < 32; ++t) acc[t] = b2;
#pragma unroll
        for (int r = 0; r < 32 + CONVW - 1; ++r) {
            unsigned u = 0u; if (t0 - (CONVW - 1) + r >= 0) u = *(const GAS unsigned*)(src + (long)r * ZP);
            const f32x2 h2 = {__uint_as_float(u << 16), __uint_as_float(u & 0xffff0000u)};
#pragma unroll
            for (int t = (r - (CONVW - 1) > 0 ? r - (CONVW - 1) : 0); t <= (r < 31 ? r : 31); ++t) acc[t] = w2[r - t] * h2 + acc[t];
        }
#pragma unroll
        for (int t = 0; t < 32; ++t) *(LAS f32x2*)(CT + (32 * half + t) * CCH + 2 * cp) = acc[t];
        __syncthreads();
        {
            const f32x4 g0 = *(const GAS f32x4*)(ln_g + 8 * lane), g1 = *(const GAS f32x4*)(ln_g + 8 * lane + 4), be0 = *(const GAS f32x4*)(ln_b + 8 * lane), be1 = *(const GAS f32x4*)(ln_b + 8 * lane + 4);
#pragma unroll 2
            for (int i = 0; i < 8; ++i) {
                const int tok = 8 * wave + i;
                f32x4 v0 = *(LAS f32x4*)(CT + tok * CCH + 8 * lane), v1 = *(LAS f32x4*)(CT + tok * CCH + 8 * lane + 4);
                const float mean = wave_sum((v0[0] + v0[1]) + (v0[2] + v0[3]) + (v1[0] + v1[1]) + (v1[2] + v1[3])) * (1.0f / CCH);
                v0 = v0 - mean; v1 = v1 - mean;
                const float rstd = rsqrtf(wave_sum((v0[0] * v0[0] + v0[1] * v0[1]) + (v0[2] * v0[2] + v0[3] * v0[3]) + (v1[0] * v1[0] + v1[1] * v1[1]) + (v1[2] * v1[2] + v1[3] * v1[3])) * (1.0f / CCH) + LN_EPS);
                v0 = v0 * rstd * g0 + be0; v1 = v1 * rstd * g1 + be1;
                v0 = v0 * pg8::sig4(v0); v1 = v1 * pg8::sig4(v1);
                *(GAS v4u*)(MIXB + (size_t)(mt + tok) * D + 8 * lane) = pg8::pack8(v0, v1);
            }
        }
        __syncthreads();
    }
}

__device__ __forceinline__ void state_mfma(f32x4 (&sacc)[8], LAS const unsigned char* Kimg, LAS const unsigned char* Vimg, int wave, int lane) {
#pragma unroll
    for (int kp = 0; kp < 4; ++kp) {
        const bf16x8 kf = tr_frag(Kimg, lane, wave, kp);
#pragma unroll
        for (int eb = 0; eb < 8; ++eb) { const bf16x8 vf = tr_frag(Vimg, lane, eb, kp); sacc[eb] = MX_MFMA(kf, vf, sacc[eb]); }
    }
}
__device__ __forceinline__ void ret_state_phase(LAS unsigned char* L, const bf16* ZB, float* Tf, int bx, int wave) {
    const int lane0 = xb_fresh_lane(), bh = bx >> 3, cg = bx & 7, b = bh >> 2, h = opaque_s(bh & 3);
    const float lg = to_sgpr(gamma_log(h)), kscale = expf(-(float)((wave * 64 + lane0) >> 2) * lg), g1 = to_sgpr(expf(lg)), g127 = to_sgpr(expf(127.0f * lg));
    f32x4 sacc[8];
#pragma unroll
    for (int eb = 0; eb < 8; ++eb) sacc[eb] = (f32x4){0.f, 0.f, 0.f, 0.f};
    v4u kr[4], vr[4];
    { const size_t m0 = (size_t)b * SEQ + (size_t)(cg * 8) * RC; const int tid0 = wave * 64 + lane0; tile_load(kr, ZB + m0 * ZP + 1024 + h * RD, tid0); tile_load(vr, ZB + m0 * ZP + 1536 + h * RD, tid0); }
    for (int j = 0; j < 8; ++j) {
        int lane = lane0; asm volatile("" : "+v"(lane));
        const int tid = wave * 64 + lane;
        tile_store<true>(L + KI, kr, kscale, tid); tile_store<false>(L + VI, vr, 1.0f, tid);
        __syncthreads();
        if (j < 7) { const size_t m1 = (size_t)b * SEQ + (size_t)(cg * 8 + j + 1) * RC; tile_load(kr, ZB + m1 * ZP + 1024 + h * RD, tid); tile_load(vr, ZB + m1 * ZP + 1536 + h * RD, tid); }
#pragma unroll
        for (int eb = 0; eb < 8; ++eb) sacc[eb] = sacc[eb] * g1;
        state_mfma(sacc, L + KI, L + VI, wave, lane);
#pragma unroll
        for (int eb = 0; eb < 8; ++eb) sacc[eb] = sacc[eb] * g127;
        __syncthreads();
    }
    GAS f32x4* dst = (GAS f32x4*)Tf + (size_t)(bx * 8 + wave) * 8 * 64 + lane0;
#pragma unroll
    for (int eb = 0; eb < 8; ++eb) dst[eb * 64] = sacc[eb];
}
__device__ __forceinline__ void ret_out_phase(LAS unsigned char* L, const bf16* ZB, bf16* MIXB, const float* Tf, const float* gn_g, const float* gn_b, int bx, int wave) {
    const int lane0 = xb_fresh_lane(), bh = bx >> 3, cg = bx & 7, b = bh >> 2, h = opaque_s(bh & 3);
    const float lg = to_sgpr(gamma_log(h)), kscale = expf(-(float)((wave * 64 + lane0) >> 2) * lg), qscale = expf((float)((wave * 64 + lane0) >> 2) * lg), g1 = to_sgpr(expf(lg)), g127 = to_sgpr(expf(127.0f * lg)), cd8 = to_sgpr(expf(1024.0f * lg));
    f32x4 sacc[8];
#pragma unroll
    for (int eb = 0; eb < 8; ++eb) sacc[eb] = (f32x4){0.f, 0.f, 0.f, 0.f};
    { float coef = 1.0f;
      for (int g2 = cg - 1; g2 >= 0; --g2) { const GAS f32x4* src = (const GAS f32x4*)Tf + (size_t)((bh * 8 + g2) * 8 + wave) * 8 * 64 + lane0;
#pragma unroll
          for (int eb = 0; eb < 8; ++eb) sacc[eb] = sacc[eb] + src[eb * 64] * coef;
          coef *= cd8; } }
    v4u kr[4], vr[4], qr[4];
    { const size_t m0 = (size_t)b * SEQ + (size_t)(cg * 8) * RC; const int tid0 = wave * 64 + lane0;
      tile_load(kr, ZB + m0 * ZP + 1024 + h * RD, tid0); tile_load(vr, ZB + m0 * ZP + 1536 + h * RD, tid0); tile_load(qr, ZB + m0 * ZP + 512 + h * RD, tid0); }
    for (int j = 0; j < 8; ++j) {
        int lane = lane0; asm volatile("" : "+v"(lane));
        const int tid = wave * 64 + lane, g = lane >> 4, li = lane & 15;
        const size_t m0 = (size_t)b * SEQ + (size_t)(cg * 8 + j) * RC;
        tile_store<true>(L + KI, kr, kscale, tid); tile_store<false>(L + VI, vr, 1.0f, tid); tile_store<true>(L + QI, qr, qscale, tid);
#pragma unroll
        for (int eb = 0; eb < 8; ++eb) { const f32x4 sv = sacc[eb] * g1; u32x2 w; w.x = pg8::cvt_pk_bf16(sv[0], sv[1]); w.y = pg8::cvt_pk_bf16(sv[2], sv[3]);
            *(LAS u32x2*)(L + SI + off_b(16 * eb + li, 2 * wave + (g >> 1)) + 8 * (g & 1)) = w; }
        __syncthreads();
        if (j < 7) { const size_t m1 = m0 + RC; tile_load(kr, ZB + m1 * ZP + 1024 + h * RD, tid); tile_load(vr, ZB + m1 * ZP + 1536 + h * RD, tid); tile_load(qr, ZB + m1 * ZP + 512 + h * RD, tid); }
        const size_t mrow = m0 + 16 * wave + li;
        u32x2 gw[8];
#pragma unroll
        for (int eb = 0; eb < 8; ++eb) gw[eb] = *(const GAS u32x2*)(ZB + mrow * ZP + 2048 + h * RD + 16 * eb + 4 * g);
        bf16x8 qf[4];
#pragma unroll
        for (int ks = 0; ks < 4; ++ks) qf[ks] = row_frag(L + QI, 16 * wave + li, 4 * ks + g);
        bf16x8 pf[4];
#pragma unroll
        for (int kp = 0; kp < 4; ++kp) {
            unsigned pw[4] = {0u, 0u, 0u, 0u};
            if (kp <= (wave >> 1)) {
#pragma unroll
                for (int t = 0; t < 2; ++t) {
                    f32x4 x = (f32x4){0.f, 0.f, 0.f, 0.f};
                    const unsigned krow = 32 * kp + 8 * (li >> 2) + 4 * t + (li & 3);
#pragma unroll
                    for (int ks = 0; ks < 4; ++ks) x = MX_MFMA(row_frag(L + KI, krow, 4 * ks + g), qf[ks], x);
                    { const int key0 = 32 * kp + 8 * g + 4 * t, ql = 16 * wave + li;
#pragma unroll
                        for (int r = 0; r < 4; ++r) x[r] = (key0 + r <= ql) ? x[r] : 0.f; }
                    pw[2 * t] = pg8::cvt_pk_bf16(x[0], x[1]); pw[2 * t + 1] = pg8::cvt_pk_bf16(x[2], x[3]);
                }
            }
            pf[kp] = __builtin_bit_cast(bf16x8, (v4u){pw[0], pw[1], pw[2], pw[3]});
        }
        f32x4 o[8];
#pragma unroll
        for (int eb = 0; eb < 8; ++eb) o[eb] = (f32x4){0.f, 0.f, 0.f, 0.f};
#pragma unroll
        for (int eb = 0; eb < 8; ++eb) {
#pragma unroll
            for (int ks = 0; ks < 4; ++ks) o[eb] = MX_MFMA(row_frag(L + SI, 16 * eb + li, 4 * ks + g), qf[ks], o[eb]);
            }
#pragma unroll
        for (int eb = 0; eb < 8; ++eb) sacc[eb] = sacc[eb] * g1;
#pragma unroll
        for (int kp = 0; kp < 4; ++kp) {
            const bf16x8 kf = tr_frag(L + KI, lane, wave, kp);
#pragma unroll
            for (int eb = 0; eb < 8; ++eb) { const bf16x8 vf = tr_frag(L + VI, lane, eb, kp);
                o[eb] = MX_MFMA(vf, pf[kp], o[eb]);
                sacc[eb] = MX_MFMA(kf, vf, sacc[eb]); }
        }
#pragma unroll
        for (int eb = 0; eb < 8; ++eb) sacc[eb] = sacc[eb] * g127;
        float s1 = 0.f;
#pragma unroll
        for (int eb = 0; eb < 8; ++eb) s1 += (o[eb][0] + o[eb][1]) + (o[eb][2] + o[eb][3]);
        s1 += __shfl_xor(s1, 16); s1 += __shfl_xor(s1, 32);
        const float mean = s1 * (1.0f / RD); float s2 = 0.f;
#pragma unroll
        for (int eb = 0; eb < 8; ++eb) { o[eb] = o[eb] - mean; s2 += (o[eb][0] * o[eb][0] + o[eb][1] * o[eb][1]) + (o[eb][2] * o[eb][2] + o[eb][3] * o[eb][3]); }
        s2 += __shfl_xor(s2, 16); s2 += __shfl_xor(s2, 32);
        const float rstd = rsqrtf(s2 * (1.0f / RD) + LN_EPS);
#pragma unroll
        for (int eb = 0; eb < 8; ++eb) { const int e0 = h * RD + 16 * eb + 4 * g;
            const f32x4 gg = *(const GAS f32x4*)(gn_g + e0), gb = *(const GAS f32x4*)(gn_b + e0);
            const f32x4 gt = (f32x4){__uint_as_float(gw[eb].x << 16), __uint_as_float(gw[eb].x & 0xffff0000u), __uint_as_float(gw[eb].y << 16), __uint_as_float(gw[eb].y & 0xffff0000u)};
            const f32x4 y = (o[eb] * rstd * gg + gb) * (gt * pg8::sig4(gt));
            u32x2 w; w.x = pg8::cvt_pk_bf16(y[0], y[1]); w.y = pg8::cvt_pk_bf16(y[2], y[3]);
            *(GAS u32x2*)(MIXB + mrow * D + CCH + e0) = w; }
        __syncthreads();
    }
}
#undef MX_MFMA
}

struct Args {
    const float* x; const float* p; const int* pos; const float* norm_mix_g; const float* w_in; const float* dw_w; const float* dw_b; const float* ln_g; const float* ln_b;
    const float* gn_g; const float* gn_b; const float* w_out; const float* norm_ffn_g; const float* w_ff1; const float* w_ff2; const float* norm_ple_g; const float* w_gate; const float* w_proj;
    const float* final_g; float* out; unsigned char* ws; int ph_lo, ph_hi, li, pad;
};
__device__ __forceinline__ int inmap(int s) {
    if (s < 512) return 256 * (s >> 7) + (s & 127);
    if (s < 1024) { const int ch = s - 512; return 256 * (ch >> 7) + 128 + (ch & 127); }
    if (s < 2048) { const int k = s >= 1536, r = s - (k ? 1536 : 1024), hq = r >> 7, dd = r & 127; return 256 * ((k ? 6 : 4) + (hq >> 1)) + 128 * (dd >> 6) + 64 * (hq & 1) + (dd & 63); }
    return s;
}
template <bool INMAP> __device__ __forceinline__ void tr_item(const float* W, int K, int N, const float* gain, bf16* WT, LAS float* scr, int item, int lane) {
    const int nblk = N / 32, kb = item / nblk, nb = item % nblk, k0 = 64 * kb, n0 = 32 * nb;
#pragma unroll 8
    for (int i = 0; i < 32; ++i) { const int kk = 2 * i + (lane >> 5); scr[kk * 33 + (lane & 31)] = W[(size_t)(k0 + kk) * N + n0 + (lane & 31)] * (gain ? gain[k0 + kk] : 1.0f); }
    LDS_WAIT(); asm volatile("" ::: "memory");
    const int c = lane & 7;
#pragma unroll
    for (int j = 0; j < 4; ++j) { const int n = (lane >> 3) + 8 * j; const LAS float* s = scr + (8 * c) * 33 + n;
        const int src = n0 + n; const int r = INMAP ? inmap(src) : src; const float cs = (INMAP && src >= 1536 && src < 2048) ? 0.088388347648318447f : 1.0f;
        v4u o; o.x = pk2(s[0 * 33] * cs, s[1 * 33] * cs); o.y = pk2(s[2 * 33] * cs, s[3 * 33] * cs); o.z = pk2(s[4 * 33] * cs, s[5 * 33] * cs); o.w = pk2(s[6 * 33] * cs, s[7 * 33] * cs);
        *(GAS v4u*)(WT + (size_t)r * K + k0 + 8 * c) = o; }
    LDS_WAIT(); asm volatile("" ::: "memory");
}

__device__ __forceinline__ const void* lds_ptr(LAS unsigned char* p) {
    const unsigned lo = __builtin_amdgcn_readfirstlane(((volatile LAS unsigned*)p)[0]), hi = __builtin_amdgcn_readfirstlane(((volatile LAS unsigned*)p)[1]);
    return (const void*)(((unsigned long long)hi << 32) | lo);
}
#ifndef PROBE_DUP
#define PROBE_DUP (-1)
#endif
#define DUPN(k) ((PROBE_DUP == (k)) ? 2 : 1)
__global__ void __launch_bounds__(NWAVES * 64, 2) mk_fwd(Args a) {
    extern __shared__ __attribute__((aligned(16))) unsigned char lds[];
    LAS unsigned char* const L = (LAS unsigned char*)lds;
    volatile LAS unsigned* MISC = (volatile LAS unsigned*)(L + MISC_OFF);
    const int wave = __builtin_amdgcn_readfirstlane(threadIdx.x >> 6);
#define LANE_ID() xb_fresh_lane()
    const int G = gridDim.x, bx = blockIdx.x;
    unsigned char* ws = a.ws;
    gu32* ctl = (gu32*)(ws + WS_CTL);
    if (threadIdx.x < 64) MISC[threadIdx.x] = 0u;
    if (threadIdx.x < sizeof(Args) / 4) ((volatile LAS unsigned*)(L + ARGS_OFF))[threadIdx.x] = ((const unsigned*)&a)[threadIdx.x];
    __syncthreads();
#define ARGP(field) ((decltype(a.field))lds_ptr(L + ARGS_OFF + offsetof(Args, field)))
    XcdBarrier bar = xcd_barrier_post((unsigned*)(ctl + CW_BAR) + a.li * XCD_BAR_WORDS, MISC + 8, wave);
    const int lo = a.ph_lo, hi = a.ph_hi;
#define IN(k) (lo <= (k) && (k) < hi)
#define SEAM(k) do { if (IN(k) && IN((k) + 1)) xcd_barrier(bar); } while (0)
    const int gw = bx * NWAVES + wave, NGW = G * NWAVES;
    const size_t NGT = (size_t)G * NWAVES * 64;
    bf16* const XB = (bf16*)(ws + WS_XB); bf16* const ZB = (bf16*)(ws + WS_ZB); bf16* const MIXB = (bf16*)(ws + WS_MIX); bf16* const HID = (bf16*)(ws + WS_HID);
    bf16* const XO = (bf16*)a.out;
    float* const TF = (float*)(ws + WS_T);
    bf16* const PROJ = (bf16*)(ws + WS_PROJ); bf16* const PB = (bf16*)(ws + WS_PB); unsigned* const ROPE = (unsigned*)(ws + WS_ROPE);

    if (IN(0))
#pragma clang loop unroll(full)
    for (int rep = 0; rep < DUPN(0); ++rep) {
        const int lane = LANE_ID(); const size_t gt = (size_t)bx * (NWAVES * 64) + wave * 64 + lane;
        LAS float* scr = (LAS float*)(L + RING_OFF + wave * 16384);
        constexpr int I_IN = (D / 64) * (INC / 32), I_OUT = (D / 64) * (D / 32), I_F1 = (D / 64) * (FF / 32), I_F2 = (FF / 64) * (D / 32), I_G = I_OUT, I_P = (PLE / 64) * (D / 32);
        constexpr int I_LAYER = I_IN + I_OUT + I_F1 + I_F2 + I_G + I_P;
        for (int it = gw; it < DEPTH * I_LAYER; it += NGW) {
            const int l = it / I_LAYER; int r = it % I_LAYER; unsigned char* wl = ws + WS_W + (size_t)l * W_LAYER;
            if (r < I_IN) { tr_item<true>(a.w_in + (size_t)l * D * INC, D, INC, a.norm_mix_g + l * D, (bf16*)(wl + WO_IN), scr, r, lane); continue; } r -= I_IN;
            if (r < I_OUT) { tr_item<false>(a.w_out + (size_t)l * D * D, D, D, nullptr, (bf16*)(wl + WO_OUT), scr, r, lane); continue; } r -= I_OUT;
            if (r < I_F1) { tr_item<false>(a.w_ff1 + (size_t)l * D * FF, D, FF, a.norm_ffn_g + l * D, (bf16*)(wl + WO_FF1), scr, r, lane); continue; } r -= I_F1;
            if (r < I_F2) { tr_item<false>(a.w_ff2 + (size_t)l * FF * D, FF, D, nullptr, (bf16*)(wl + WO_FF2), scr, r, lane); continue; } r -= I_F2;
            if (r < I_G) { tr_item<false>(a.w_gate + (size_t)l * D * D, D, D, a.norm_ple_g + l * D, (bf16*)(wl + WO_GATE), scr, r, lane); continue; } r -= I_G;
            tr_item<false>(a.w_proj + (size_t)l * PLE * D, PLE, D, nullptr, (bf16*)(wl + WO_PROJ), scr, r, lane);
        }
        float* ss0 = (float*)(ws + WS_SS);
        for (int m = gw; m < M; m += NGW) {
            const GAS f32x4* xr = (const GAS f32x4*)(a.x + (size_t)m * D) + lane; f32x4 v[4]; float s = 0.f;
#pragma unroll
            for (int j = 0; j < 4; ++j) { v[j] = xr[64 * j]; s += (v[j].x * v[j].x + v[j].y * v[j].y) + (v[j].z * v[j].z + v[j].w * v[j].w); }
            s = wave_sum(s);
            GAS unsigned long long* o8 = (GAS unsigned long long*)(XB + (size_t)m * D) + lane;
#pragma unroll
            for (int j = 0; j < 4; ++j) o8[64 * j] = (unsigned long long)pk2(v[j].x, v[j].y) | ((unsigned long long)pk2(v[j].z, v[j].w) << 32);
            if (lane < 16) ss0[(size_t)m * 16 + lane] = lane == 0 ? s : 0.f;
        }
        for (size_t i = gt; i < (size_t)DEPTH * M * PLE / 8; i += NGT) {
            const f32x4 p0 = *(const GAS f32x4*)(a.p + i * 8), p1 = *(const GAS f32x4*)(a.p + i * 8 + 4);
            v4u o; o.x = pk2(p0.x, p0.y); o.y = pk2(p0.z, p0.w); o.z = pk2(p1.x, p1.y); o.w = pk2(p1.z, p1.w);
            *(GAS v4u*)(PB + i * 8) = o;
        }
        for (size_t i = gt; i < (size_t)M * 64; i += NGT) {
            const int d = (int)(i & 63); const size_t m = i >> 6;
            const float inv_freq = 1.0f / powf(10000.0f, (float)d * (2.0f / RD)), ang = (float)a.pos[m] * inv_freq;
            const pg8::f16x2 cs = {(_Float16)cosf(ang), (_Float16)sinf(ang)};
            ROPE[i] = __builtin_bit_cast(unsigned, cs);
        }
    }
    SEAM(0);
#pragma clang loop unroll(full)
    for (int l = 0; l < DEPTH; ++l) {
        const int pb = 1 + 8 * l;
        bf16* const XC = (l & 1) ? XO : XB; bf16* const XN = (l & 1) ? XB : XO;
        unsigned char* wl = ws + WS_W + (size_t)l * W_LAYER;
        float* const ss_a = (float*)(ws + WS_SS + (size_t)(3 * l + 0) * SS_SITE);
        float* const ss_b = (float*)(ws + WS_SS + (size_t)(3 * l + 1) * SS_SITE);
        float* const ss_c = (float*)(ws + WS_SS + (size_t)(3 * l + 2) * SS_SITE);
        float* const ss_d = (float*)(ws + WS_SS + (size_t)(3 * l + 3) * SS_SITE);
        if (IN(pb + 0))
#pragma clang loop unroll(full)
        for (int rep = 0; rep < DUPN(pb + 0); ++rep) {
            pg8::Gemm g{XC, (const bf16*)(wl + WO_IN), M, INC, D}; pg8::StaticOrder S; S.init(M, INC, G, bx);
            pg8::EpiInProj E{ZB, ss_a, ROPE};
            pg8::gemm_phase<pg8::EpiInProj, pg8::StaticOrder, true, true>(L + RING_OFF, g, S, E, wave);
        }
        SEAM(pb + 0);
        if (IN(pb + 1))
#pragma clang loop unroll(full)
        for (int rep = 0; rep < DUPN(pb + 1); ++rep) {
            mx::conv_phase(L, ZB, MIXB, ARGP(dw_w) + l * CONVW * CCH, ARGP(dw_b) + l * CCH, ARGP(ln_g) + l * CCH, ARGP(ln_b) + l * CCH, bx, wave);
            mx::ret_state_phase(L, ZB, TF, bx, wave);
        }
        SEAM(pb + 1);
        if (IN(pb + 2))
#pragma clang loop unroll(full)
        for (int rep = 0; rep < DUPN(pb + 2); ++rep) mx::ret_out_phase(L, ZB, MIXB, TF, ARGP(gn_g) + l * RW, ARGP(gn_b) + l * RW, bx, wave);
        SEAM(pb + 2);
        if (IN(pb + 3))
#pragma clang loop unroll(full)
        for (int rep = 0; rep < 1; ++rep) {
            pg8::Gemm g{MIXB, (const bf16*)(wl + WO_OUT), M, D, D}; pg8::StaticOrder S; S.init(M, D, G, bx);
            pg8::EpiResid<0> E{XC, XC, ss_b, nullptr, nullptr};
            pg8::gemm_phase<pg8::EpiResid<0>, pg8::StaticOrder, true, true>(L + RING_OFF, g, S, E, wave);
        }
        SEAM(pb + 3);
        if (IN(pb + 4))
#pragma clang loop unroll(full)
        for (int rep = 0; rep < DUPN(pb + 4); ++rep) {
            pg8::Gemm g{XC, (const bf16*)(wl + WO_FF1), M, FF, D}; pg8::StaticOrder S; S.init(M, FF, G, bx);
            pg8::EpiFF1 E{HID, ss_b};
            pg8::gemm_phase<pg8::EpiFF1, pg8::StaticOrder, true, true>(L + RING_OFF, g, S, E, wave);
        }
        SEAM(pb + 4);
        if (IN(pb + 5)) {
            pg8::Gemm g{HID, (const bf16*)(wl + WO_FF2), M, D, FF}; pg8::StaticOrder S; S.init(M, D, G, bx);
            pg8::EpiResid<0> E{XC, XC, ss_c, nullptr, nullptr};
            pg8::gemm_phase<pg8::EpiResid<0>, pg8::StaticOrder, true, true>(L + RING_OFF, g, S, E, wave);
        }
        SEAM(pb + 5);
        if (IN(pb + 6))
#pragma clang loop unroll(full)
        for (int rep = 0; rep < DUPN(pb + 6); ++rep) {
            pg8::Gemm g{PB + (size_t)l * M * PLE, (const bf16*)(wl + WO_PROJ), M, D, PLE}; pg8::StaticOrder S; S.init(M, D, G, bx);
            pg8::EpiPlain E{PROJ};
            pg8::gemm_phase<pg8::EpiPlain, pg8::StaticOrder, true, true>(L + RING_OFF, g, S, E, wave);
        }
        SEAM(pb + 6);
        if (IN(pb + 7)) {
            pg8::Gemm g{XC, (const bf16*)(wl + WO_GATE), M, D, D}; pg8::StaticOrder S; S.init(M, D, G, bx);
            pg8::EpiResid<1> E{XC, XN, ss_d, ss_c, PROJ};
            pg8::gemm_phase<pg8::EpiResid<1>, pg8::StaticOrder, true, true>(L + RING_OFF, g, S, E, wave);
        }
        SEAM(pb + 7);
    }
    if (IN(17)) {
        const int lane = LANE_ID();
        const float* ssf = (const float*)(ws + WS_SS + (size_t)6 * SS_SITE);
        const bf16* XF = (DEPTH & 1) ? XO : XB;
        const GAS f32x4* gr = (const GAS f32x4*)ARGP(final_g) + 2 * lane; const f32x4 g0 = gr[0], g1 = gr[1], g2 = gr[128], g3 = gr[129];
        for (int m = gw; m < M; m += NGW) {
            const float rs = pg8::rstd_of(ssf, m);
            const GAS v4u* xr = (const GAS v4u*)(XF + (size_t)m * D) + lane; GAS f32x4* orow = (GAS f32x4*)(a.out + (size_t)m * D) + 2 * lane;
            f32x4 a0, a1, b0, b1; pg8::unpack8(xr[0], a0, a1); pg8::unpack8(xr[64], b0, b1);
            orow[0] = a0 * rs * g0; orow[1] = a1 * rs * g1; orow[128] = b0 * rs * g2; orow[129] = b1 * rs * g3;
        }
    }
#undef IN
#undef SEAM
}

extern "C" void kernel_launch(void* const* d_in, const int* in_sizes, int n_in, void* d_out, int out_size, void* d_ws, size_t ws_size, hipStream_t stream) {
    static int grid = 0;
    if (grid == 0) {
        if (n_in != 19 || out_size != M * D || ws_size < WS_END) { fprintf(stderr, "kernel_launch: unexpected problem (n_in %d, out %d, ws %zu < %zu); nothing launched\n", n_in, out_size, ws_size, (size_t)WS_END); grid = -1; return; }
        int dev = 0, cus = 0;
        if (hipGetDevice(&dev) != hipSuccess || hipDeviceGetAttribute(&cus, hipDeviceAttributeMultiprocessorCount, dev) != hipSuccess) { grid = -1; return; }
        if (hipFuncSetAttribute((const void*)mk_fwd, hipFuncAttributeMaxDynamicSharedMemorySize, LDS_BYTES) != hipSuccess) { fprintf(stderr, "kernel_launch: hipFuncSetAttribute failed\n"); grid = -1; return; }
        int per_cu = 0;
        if (hipOccupancyMaxActiveBlocksPerMultiprocessor(&per_cu, (const void*)mk_fwd, NWAVES * 64, LDS_BYTES) != hipSuccess || per_cu < 1) fprintf(stderr, "kernel_launch: occupancy query says %d\n", per_cu);
        (void)hipGetLastError();
        if (cus < 256) fprintf(stderr, "kernel_launch: %d CUs < 256: the grid cannot be resident\n", cus);
        grid = 256;
    }
    if (grid < 0) return;
    (void)hipMemsetAsync((char*)d_ws + WS_CTL, 0, CTL_ZERO_BYTES, stream);
    Args a{};
    a.x = (const float*)d_in[0]; a.p = (const float*)d_in[1]; a.pos = (const int*)d_in[2]; a.norm_mix_g = (const float*)d_in[3]; a.w_in = (const float*)d_in[4]; a.dw_w = (const float*)d_in[5];
    a.dw_b = (const float*)d_in[6]; a.ln_g = (const float*)d_in[7]; a.ln_b = (const float*)d_in[8]; a.gn_g = (const float*)d_in[9]; a.gn_b = (const float*)d_in[10]; a.w_out = (const float*)d_in[11];
    a.norm_ffn_g = (const float*)d_in[12]; a.w_ff1 = (const float*)d_in[13]; a.w_ff2 = (const float*)d_in[14]; a.norm_ple_g = (const float*)d_in[15]; a.w_gate = (const float*)d_in[16];
    a.w_proj = (const float*)d_in[17]; a.final_g = (const float*)d_in[18]; a.out = (float*)d_out; a.ws = (unsigned char*)d_ws;
    a.ph_lo = 0; a.ph_hi = 18; a.li = 0;
    hipLaunchKernelGGL(mk_fwd, dim3(grid), dim3(NWAVES * 64), LDS_BYTES, stream, a);
}
```

```cpp
#include <hip/hip_runtime.h>
#include <cstdio>
#include <cstdint>
#include <cstddef>
namespace pg8 {
#define PG8_LAS __attribute__((address_space(3)))
typedef unsigned short bf16_t;
typedef short bf16x8 __attribute__((ext_vector_type(8)));
typedef float f32x4 __attribute__((ext_vector_type(4)));
typedef unsigned u32x4 __attribute__((ext_vector_type(4)));
typedef unsigned u32x2 __attribute__((ext_vector_type(2)));
constexpr int BM = 256, BK = 64, HALF = 128, HTB = HALF * BK * 2  , STAGE_BYTES = 8 * HTB, NXCD = 8, WGM = 8;

__host__ __device__ __forceinline__ int lds_byte(int r, int c) { const int st = (r >> 4) * 2 + (c >> 5), rr = r & 15, cc = c & 31, ob = rr * 64 + cc * 2; return st * 1024 + (ob ^ (((ob >> 9) & 1) << 5)); }
__host__ __device__ __forceinline__ void stage_rc(int b, int& R, int& C) { const int st = b / 1024, sb = b % 1024, swz = sb ^ (((sb >> 9) & 1) << 5); R = (st >> 1) * 16 + swz / 64; C = (st & 1) * 32 + (swz % 64) / 2; }
__host__ __device__ __forceinline__ int perm32(int rho) { const int n = rho >> 4, i = rho & 15; return 8 * (i >> 2) + 4 * n + (i & 3); }

struct Unit { int pm, pn; };
struct Gemm { const bf16_t* A; const bf16_t* Bt; int M, N, K; };

struct StaticOrder {
    int nM, nN, nwg, G, c;
    __host__ __device__ void init(int M, int N, int G_, int c_) { nM = M / BM; nN = N / BM; nwg = nM * nN; G = G_; c = c_; }
    __host__ __device__ bool next(int i, Unit& u) const {
        const long L = (long)i * G + c; if (L >= nwg) return false;
        int wgid = (int)L; { const int q = nwg / NXCD, r = nwg % NXCD, xcd = wgid % NXCD, off = wgid / NXCD; wgid = (xcd < r ? xcd * (q + 1) : r * (q + 1) + (xcd - r) * q) + off; }
        const int nig = WGM * nN, gid = wgid / nig, fm = gid * WGM, gsz = (nM - fm) < WGM ? (nM - fm) : WGM;
        u.pm = fm + ((wgid % nig) % gsz); u.pn = (wgid % nig) / gsz; return true;
    }
    __device__ __forceinline__ void a_ready(const Unit&) const {}
    __device__ __forceinline__ void done(const Unit&) const {}
};

__device__ __forceinline__ unsigned cvt_pk_bf16(float lo, float hi) { unsigned r; asm volatile("v_cvt_pk_bf16_f32 %0, %1, %2" : "=v"(r) : "v"(lo), "v"(hi)); return r; }
__device__ __forceinline__ u32x4 pack8(const f32x4 a, const f32x4 b) { u32x4 w; w.x = cvt_pk_bf16(a[0], a[1]); w.y = cvt_pk_bf16(a[2], a[3]); w.z = cvt_pk_bf16(b[0], b[1]); w.w = cvt_pk_bf16(b[2], b[3]); return w; }
__device__ __forceinline__ float fast_sigmoid(float x) { return __builtin_amdgcn_rcpf(1.0f + __builtin_amdgcn_exp2f(x * -1.4426950408889634f)); }
__device__ __forceinline__ f32x4 sig4(const f32x4 v) { return (f32x4){fast_sigmoid(v[0]), fast_sigmoid(v[1]), fast_sigmoid(v[2]), fast_sigmoid(v[3])}; }
constexpr int SSP = 16;
constexpr float RMS_EPS_ = 1e-6f;
__device__ __forceinline__ float rstd_of(const float* ss, int row) {
    const f32x4* p = (const f32x4*)(ss + (size_t)row * SSP); const f32x4 a = p[0], b = p[1], c = p[2], d = p[3];
    const f32x4 s = (a + b) + (c + d); return rsqrtf(((s[0] + s[1]) + (s[2] + s[3])) * (1.0f / 1024.0f) + RMS_EPS_);
}
typedef _Float16 f16x2 __attribute__((ext_vector_type(2)));

struct EpiInProj {
    static constexpr bool PERM = true, AFTER_DRAIN = false;
    bf16_t* ZB; const float* ss; const unsigned* rope;
    static constexpr int ZP = 2560;
    __device__ __forceinline__ void operator()(const f32x4 (&acc)[2][2][4][2], const Unit& u, int wr, int wc, int fr, int fq) const {
        const int row0 = u.pm * BM + wr * 64 + fr, pn = u.pn, lc = wc * 32 + 8 * fq;
        if (pn < 4) {
#pragma unroll
            for (int ai = 0; ai < 2; ++ai)
#pragma unroll
                for (int m = 0; m < 4; ++m) { const int row = row0 + ai * HALF + m * 16; const float rs = rstd_of(ss, row);
                    const f32x4 h0 = (acc[ai][0][m][0] * rs) * sig4(acc[ai][1][m][0] * rs), h1 = (acc[ai][0][m][1] * rs) * sig4(acc[ai][1][m][1] * rs);
                    *(u32x4*)(ZB + (size_t)row * ZP + pn * 128 + lc) = pack8(h0, h1); asm volatile("" ::: "memory"); }
        } else if (pn < 8) {
            const int head = 2 * (pn & 1) + (wc >> 1), d0 = lc & 63, colb = (pn < 6 ? 512 : 1024) + head * 128 + d0;
#pragma unroll
            for (int ai = 0; ai < 2; ++ai)
#pragma unroll
                for (int m = 0; m < 4; ++m) { const int row = row0 + ai * HALF + m * 16; const float rs = rstd_of(ss, row);
                    const u32x4* rp = (const u32x4*)(rope + (size_t)row * 64 + d0); const u32x4 r0 = rp[0], r1 = rp[1];
                    f32x4 o1[2], o2[2];
                    const unsigned rv[8] = {r0.x, r0.y, r0.z, r0.w, r1.x, r1.y, r1.z, r1.w};
#pragma unroll
                    for (int n = 0; n < 2; ++n) {
#pragma unroll
                        for (int i = 0; i < 4; ++i) { const f16x2 cs = __builtin_bit_cast(f16x2, rv[4 * n + i]); const float c = (float)cs[0], s = (float)cs[1];
                            const float t1 = acc[ai][0][m][n][i] * rs, t2 = acc[ai][1][m][n][i] * rs; o1[n][i] = t1 * c - t2 * s; o2[n][i] = t2 * c + t1 * s; } }
                    bf16_t* zp = ZB + (size_t)row * ZP + colb; *(u32x4*)zp = pack8(o1[0], o1[1]); *(u32x4*)(zp + 64) = pack8(o2[0], o2[1]); asm volatile("" ::: "memory"); }
        } else {
            const int colb = 1536 + (pn - 8) * 256 + lc;
#pragma unroll
            for (int ai = 0; ai < 2; ++ai)
#pragma unroll
                for (int m = 0; m < 4; ++m) { const int row = row0 + ai * HALF + m * 16; const float rs = rstd_of(ss, row);
#pragma unroll
                    for (int bj = 0; bj < 2; ++bj) { f32x4 v0 = acc[ai][bj][m][0] * rs, v1 = acc[ai][bj][m][1] * rs;
                        *(u32x4*)(ZB + (size_t)row * ZP + colb + bj * HALF) = pack8(v0, v1); } asm volatile("" ::: "memory"); }
        }
    }
};
__device__ __forceinline__ void unpack8(const u32x4 w, f32x4& a, f32x4& b) {
    a = (f32x4){__uint_as_float(w.x << 16), __uint_as_float(w.x & 0xffff0000u), __uint_as_float(w.y << 16), __uint_as_float(w.y & 0xffff0000u)};
    b = (f32x4){__uint_as_float(w.z << 16), __uint_as_float(w.z & 0xffff0000u), __uint_as_float(w.w << 16), __uint_as_float(w.w & 0xffff0000u)};
}
template <int MODE> struct EpiResid {
    static constexpr bool PERM = true, AFTER_DRAIN = false;
    const bf16_t* XI; bf16_t* XO; float* ss_out; const float* ss_in; const bf16_t* proj;
    __device__ __forceinline__ void operator()(const f32x4 (&acc)[2][2][4][2], const Unit& u, int wr, int wc, int fr, int fq) const {
        const int row0 = u.pm * BM + wr * 64 + fr, col0 = u.pn * BM + wc * 32 + 8 * fq;
#pragma unroll
        for (int ai = 0; ai < 2; ++ai)
#pragma unroll
            for (int m = 0; m < 4; ++m) { const int row = row0 + ai * HALF + m * 16; const size_t off = (size_t)row * 1024 + col0; float q = 0.f;
                float rs = 1.f; if (MODE == 1) rs = rstd_of(ss_in, row);
#pragma unroll
                for (int bj = 0; bj < 2; ++bj) { f32x4 b0, b1; unpack8(*(const u32x4*)(XI + off + bj * HALF), b0, b1);
                    f32x4 v0, v1;
                    if (MODE == 1) { f32x4 p0, p1; unpack8(*(const u32x4*)(proj + off + bj * HALF), p0, p1);
                        v0 = b0 + sig4(acc[ai][bj][m][0] * rs) * p0; v1 = b1 + sig4(acc[ai][bj][m][1] * rs) * p1; }
                    else { v0 = b0 + acc[ai][bj][m][0]; v1 = b1 + acc[ai][bj][m][1]; }
                    *(u32x4*)(XO + off + bj * HALF) = pack8(v0, v1);
                    q += (v0[0] * v0[0] + v0[1] * v0[1]) + (v0[2] * v0[2] + v0[3] * v0[3]) + (v1[0] * v1[0] + v1[1] * v1[1]) + (v1[2] * v1[2] + v1[3] * v1[3]); }
                q += __shfl_xor(q, 16); q += __shfl_xor(q, 32);
                if (fq == 0) ss_out[(size_t)row * SSP + u.pn * 4 + wc] = q; asm volatile("" ::: "memory"); }
    }
};
struct EpiFF1 {
    static constexpr bool PERM = true, AFTER_DRAIN = false;
    bf16_t* H; const float* ss;
    __device__ __forceinline__ void operator()(const f32x4 (&acc)[2][2][4][2], const Unit& u, int wr, int wc, int fr, int fq) const {
        const int row0 = u.pm * BM + wr * 64 + fr, col0 = u.pn * BM + wc * 32 + 8 * fq;
#pragma unroll
        for (int ai = 0; ai < 2; ++ai)
#pragma unroll
            for (int m = 0; m < 4; ++m) { const int row = row0 + ai * HALF + m * 16; const float rs = rstd_of(ss, row);
#pragma unroll
                for (int bj = 0; bj < 2; ++bj) { f32x4 v0 = acc[ai][bj][m][0] * rs, v1 = acc[ai][bj][m][1] * rs;
                    v0 = __builtin_elementwise_max(v0, (f32x4){0.f, 0.f, 0.f, 0.f}); v1 = __builtin_elementwise_max(v1, (f32x4){0.f, 0.f, 0.f, 0.f}); v0 = v0 * v0; v1 = v1 * v1;
                    *(u32x4*)(H + (size_t)row * 4096 + col0 + bj * HALF) = pack8(v0, v1); } asm volatile("" ::: "memory"); }
    }
};
struct EpiPlain {
    static constexpr bool PERM = true, AFTER_DRAIN = false;
    bf16_t* O;
    __device__ __forceinline__ void operator()(const f32x4 (&acc)[2][2][4][2], const Unit& u, int wr, int wc, int fr, int fq) const {
        const int row0 = u.pm * BM + wr * 64 + fr, col0 = u.pn * BM + wc * 32 + 8 * fq;
#pragma unroll
        for (int ai = 0; ai < 2; ++ai)
#pragma unroll
            for (int m = 0; m < 4; ++m) { const int row = row0 + ai * HALF + m * 16;
#pragma unroll
                for (int bj = 0; bj < 2; ++bj) *(u32x4*)(O + (size_t)row * 1024 + col0 + bj * HALF) = pack8(acc[ai][bj][m][0], acc[ai][bj][m][1]); }
    }
};

template <class Epi, class Sched, bool ALIGN_EPI = false, bool SP2 = false>
__device__ __forceinline__ void gemm_phase(PG8_LAS unsigned char* lds, const Gemm g, const Sched& S, const Epi& E, const int wave_id) {
    unsigned z_ = 0u; asm volatile("" : "+v"(z_)); const int tid_ = wave_id * 64 + (int)__builtin_amdgcn_mbcnt_hi(~0u, __builtin_amdgcn_mbcnt_lo(~0u, z_));
    const int tid = tid_, wid = wave_id, lane = tid & 63, wr = wid >> 2, wc = wid & 3, fr = lane & 15, fq = lane >> 4;
    const int K = g.K, nt = K / BK;
    unsigned voffA[2], voffB[2];
#pragma unroll
    for (int i = 0; i < 2; ++i) { int R, C; stage_rc(tid * 16 + i * 8192, R, C); const int Rb = Epi::PERM ? ((R & ~31) + perm32(R & 31)) : R;
        voffA[i] = (unsigned)(R * K + C) * 2u; voffB[i] = (unsigned)(Rb * K + C) * 2u; }
    const size_t kstep = (size_t)(BK * 2);
    const size_t hstep = (size_t)HALF * K * 2;
    const size_t tstep = 2 * hstep;
    const unsigned ldsw = (unsigned)wid * 1024u;
    const int aoff = lds_byte(wr * 64 + fr, fq * 8), boff = lds_byte(wc * 32 + fr, fq * 8);
#define PG8_SA(b, h) (((b) * 2 + (h)) * HTB)
#define PG8_SB(b, h) ((4 + (b) * 2 + (h)) * HTB)
#define PG8_STAGE(bufoff, gbase, voff) do { _Pragma("unroll") for (int _i = 0; _i < 2; ++_i) \
        __builtin_amdgcn_global_load_lds((const unsigned*)((const char*)(gbase) + (voff)[_i]), (PG8_LAS unsigned*)(lds + (bufoff) + ldsw + _i * 8192), 16, 0, 0); } while (0)
#define PG8_LDA(dst, b, h) do { _Pragma("unroll") for (int m = 0; m < 4; ++m) _Pragma("unroll") for (int k = 0; k < 2; ++k) dst[m][k] = *(const PG8_LAS bf16x8*)(lds + PG8_SA(b, h) + aoff + m * 2048 + k * 1024); } while (0)
#define PG8_LDB(dst, b, h) do { _Pragma("unroll") for (int n = 0; n < 2; ++n) _Pragma("unroll") for (int k = 0; k < 2; ++k) dst[n][k] = *(const PG8_LAS bf16x8*)(lds + PG8_SB(b, h) + boff + n * 2048 + k * 1024); } while (0)
#define PG8_MMA(ai, bj, At, Bt) do { __builtin_amdgcn_s_setprio(1); _Pragma("unroll") for (int m = 0; m < 4; ++m) _Pragma("unroll") for (int n = 0; n < 2; ++n) _Pragma("unroll") for (int k = 0; k < 2; ++k) \
        acc[ai][bj][m][n] = __builtin_amdgcn_mfma_f32_16x16x32_bf16(Bt[n][k], At[m][k], acc[ai][bj][m][n], 0, 0, 0); __builtin_amdgcn_s_setprio(0); } while (0)
#define PG8_WAIT_V(n) asm volatile("s_waitcnt vmcnt(" #n ")" ::: "memory")
#define PG8_WAIT_L(n) asm volatile("s_waitcnt lgkmcnt(" #n ")" ::: "memory")
#define PG8_BAR __builtin_amdgcn_s_barrier()
#define PG8_SCHED __builtin_amdgcn_sched_barrier(0)
    Unit cur, nxt; int ui = 0;
    if (!S.next(0, cur)) return;
    f32x4 acc[2][2][4][2];
#pragma unroll
    for (int a = 0; a < 2; ++a)
#pragma unroll
        for (int b = 0; b < 2; ++b)
#pragma unroll
            for (int m = 0; m < 4; ++m)
#pragma unroll
                for (int n = 0; n < 2; ++n) acc[a][b][m][n] = (f32x4){0.f, 0.f, 0.f, 0.f};
    bf16x8 At[4][2], B0[2][2], B1[2][2];
    const char* cA = (const char*)g.A + (size_t)cur.pm * tstep; const char* cB = (const char*)g.Bt + (size_t)cur.pn * tstep;
    S.a_ready(cur);
    if constexpr (SP2) {
        PG8_STAGE(PG8_SB(0, 0), cB, voffB); PG8_STAGE(PG8_SB(0, 1), cB + hstep, voffB); PG8_STAGE(PG8_SA(0, 0), cA, voffA); PG8_STAGE(PG8_SA(0, 1), cA + hstep, voffA);
        if (wr == 1) PG8_BAR;
        PG8_WAIT_V(2); PG8_BAR;
        PG8_STAGE(PG8_SB(1, 0), cB + kstep, voffB); PG8_STAGE(PG8_SA(1, 0), cA + kstep, voffA); PG8_STAGE(PG8_SB(1, 1), cB + hstep + kstep, voffB);
        PG8_WAIT_V(6); PG8_BAR;
    } else {
        PG8_STAGE(PG8_SB(0, 0), cB, voffB); PG8_STAGE(PG8_SA(0, 0), cA, voffA); PG8_STAGE(PG8_SB(0, 1), cB + hstep, voffB); PG8_STAGE(PG8_SA(0, 1), cA + hstep, voffA);
        if (wr == 1) PG8_BAR;
        PG8_WAIT_V(4); PG8_BAR;
        PG8_STAGE(PG8_SB(1, 0), cB + kstep, voffB); PG8_STAGE(PG8_SA(1, 0), cA + kstep, voffA); PG8_STAGE(PG8_SB(1, 1), cB + hstep + kstep, voffB);
        PG8_WAIT_V(6); PG8_BAR;
    }
    for (;;) {
        const bool has_next = S.next(ui + 1, nxt);
        const char* nA = has_next ? (const char*)g.A + (size_t)nxt.pm * tstep : cA; const char* nB = has_next ? (const char*)g.Bt + (size_t)nxt.pn * tstep : cB;
        for (int t = 0; t < nt; t += 2) {
            const bool last = (t == nt - 2);
            const char* a1 = cA + (size_t)(t + 1) * kstep;
            const char* a2 = last ? nA : cA + (size_t)(t + 2) * kstep; const char* b2 = last ? nB : cB + (size_t)(t + 2) * kstep;
            const char* a3 = a2 + kstep; const char* b3 = b2 + kstep;
            if (last && has_next) S.a_ready(nxt);
            if constexpr (SP2) {
            PG8_LDB(B0, 0, 0); PG8_LDB(B1, 0, 1); PG8_SCHED; PG8_LDA(At, 0, 0); PG8_STAGE(PG8_SA(1, 1), a1 + hstep, voffA);
            PG8_WAIT_V(8); PG8_WAIT_L(0); PG8_BAR; PG8_MMA(0, 0, At, B0); PG8_MMA(0, 1, At, B1); PG8_BAR; PG8_SCHED;
            PG8_LDA(At, 0, 1); PG8_STAGE(PG8_SB(0, 0), b2, voffB); PG8_STAGE(PG8_SB(0, 1), b2 + hstep, voffB); PG8_STAGE(PG8_SA(0, 0), a2, voffA);
            PG8_WAIT_V(8); PG8_WAIT_L(0); PG8_BAR; PG8_MMA(1, 0, At, B0); PG8_MMA(1, 1, At, B1); PG8_BAR; PG8_SCHED;
            PG8_LDB(B0, 1, 0); PG8_LDB(B1, 1, 1); PG8_SCHED; PG8_LDA(At, 1, 0); PG8_STAGE(PG8_SA(0, 1), a2 + hstep, voffA);
            PG8_WAIT_V(8); PG8_WAIT_L(0); PG8_BAR; PG8_MMA(0, 0, At, B0); PG8_MMA(0, 1, At, B1); PG8_BAR; PG8_SCHED;
            PG8_LDA(At, 1, 1); PG8_STAGE(PG8_SB(1, 0), b3, voffB); PG8_STAGE(PG8_SB(1, 1), b3 + hstep, voffB); PG8_STAGE(PG8_SA(1, 0), a3, voffA);
            PG8_WAIT_V(8); PG8_WAIT_L(0); PG8_BAR; PG8_MMA(1, 0, At, B0); PG8_MMA(1, 1, At, B1); PG8_BAR; PG8_SCHED;
            } else {
            PG8_LDB(B0, 0, 0); PG8_SCHED; PG8_LDA(At, 0, 0); PG8_STAGE(PG8_SA(1, 1), a1 + hstep, voffA);
            PG8_WAIT_L(8); PG8_BAR; PG8_WAIT_L(0); PG8_MMA(0, 0, At, B0); PG8_BAR; PG8_SCHED;
            PG8_LDB(B1, 0, 1); PG8_STAGE(PG8_SB(0, 0), b2, voffB);
            PG8_BAR; PG8_WAIT_L(0); PG8_MMA(0, 1, At, B1); PG8_BAR;
            PG8_LDA(At, 0, 1); PG8_STAGE(PG8_SA(0, 0), a2, voffA);
            PG8_BAR; PG8_WAIT_L(0); PG8_MMA(1, 0, At, B0); PG8_BAR; PG8_SCHED;
            PG8_STAGE(PG8_SB(0, 1), b2 + hstep, voffB);
            PG8_WAIT_V(6); PG8_BAR; PG8_MMA(1, 1, At, B1); PG8_BAR;
            PG8_LDB(B0, 1, 0); PG8_SCHED; PG8_LDA(At, 1, 0); PG8_STAGE(PG8_SA(0, 1), a2 + hstep, voffA);
            PG8_WAIT_L(8); PG8_BAR; PG8_WAIT_L(0); PG8_MMA(0, 0, At, B0); PG8_BAR; PG8_SCHED;
            PG8_LDB(B1, 1, 1); PG8_STAGE(PG8_SB(1, 0), b3, voffB);
            PG8_BAR; PG8_WAIT_L(0); PG8_MMA(0, 1, At, B1); PG8_BAR;
            PG8_LDA(At, 1, 1); PG8_STAGE(PG8_SA(1, 0), a3, voffA);
            PG8_BAR; PG8_WAIT_L(0); PG8_MMA(1, 0, At, B0); PG8_BAR; PG8_SCHED;
            PG8_STAGE(PG8_SB(1, 1), b3 + hstep, voffB);
            PG8_WAIT_V(6); PG8_BAR; PG8_MMA(1, 1, At, B1); PG8_BAR;
            }
        }
        if constexpr (ALIGN_EPI) { if (wr == 0) PG8_BAR; }
        if constexpr (!Epi::AFTER_DRAIN) { E(acc, cur, wr, wc, fr, fq); S.done(cur); }
        if (!has_next) break;
#pragma unroll
        for (int a = 0; a < 2; ++a)
#pragma unroll
            for (int b = 0; b < 2; ++b)
#pragma unroll
                for (int m = 0; m < 4; ++m)
#pragma unroll
                    for (int n = 0; n < 2; ++n) acc[a][b][m][n] = (f32x4){0.f, 0.f, 0.f, 0.f};
        cur = nxt; cA = nA; cB = nB; ++ui;
        if constexpr (ALIGN_EPI) { if (wr == 1) PG8_BAR; }
    }
    PG8_WAIT_V(0);
    if constexpr (!ALIGN_EPI) { if (wr == 0) PG8_BAR; }
    PG8_BAR;
    if constexpr (Epi::AFTER_DRAIN) { E.fused(acc, cur, wr, wc, fr, fq, lds, wid, lane); S.done(cur); }
#undef PG8_SA
#undef PG8_SB
#undef PG8_STAGE
#undef PG8_LDA
#undef PG8_LDB
#undef PG8_MMA
#undef PG8_WAIT_V
#undef PG8_WAIT_L
#undef PG8_BAR
#undef PG8_SCHED
}
}

constexpr int NWAVES = 8;
constexpr int NB = 8, SEQ = 8192, D = 1024, DEPTH = 2, CCH = 512, CONVW = 31, RH = 4, RD = 128, RW = 512, RC = 128, FF = 4096, PLE = 256, INC = 3072;
constexpr int M = NB * SEQ;
constexpr int ZP = 2560;
constexpr float LN_EPS = 1e-5f;
constexpr size_t MiB = 1u << 20;
constexpr size_t WS_CTL = 0, CTL_ZERO_BYTES = 1 * MiB;
constexpr size_t WS_W = 2 * MiB, W_LAYER = 27 * MiB;
constexpr size_t WO_IN = 0, WO_OUT = 6 * MiB, WO_FF1 = 8 * MiB, WO_FF2 = 16 * MiB, WO_GATE = 24 * MiB, WO_PROJ = 26 * MiB;
constexpr size_t WS_SS = 56 * MiB, SS_SITE = 4 * MiB;
constexpr size_t WS_ROPE = 84 * MiB;
constexpr size_t WS_XB = 100 * MiB;
constexpr size_t WS_PB = 228 * MiB;
constexpr size_t WS_PROJ = 292 * MiB;
constexpr size_t WS_ZB = 420 * MiB;
constexpr size_t WS_T = 740 * MiB;
constexpr size_t WS_MIX = 756 * MiB;
constexpr size_t WS_HID = 420 * MiB;
constexpr size_t WS_END = 932 * MiB;
constexpr size_t WS_U = WS_XB, WS_S = WS_PROJ;
constexpr int CW_TMO = 0, CW_BAR = 4096;
constexpr int LDS_BYTES = 163840, RING_OFF = 0, MISC_OFF = 163840 - 256, ARGS_OFF = 163840 - 512;

#define GAS __attribute__((address_space(1)))
#define LAS __attribute__((address_space(3)))
typedef unsigned short bf16;
typedef unsigned v4u __attribute__((ext_vector_type(4)));
typedef float f32x4 __attribute__((ext_vector_type(4)));
typedef GAS unsigned gu32;
#define RLX_AGENT __ATOMIC_RELAXED, __HIP_MEMORY_SCOPE_AGENT
#define LDS_WAIT() asm volatile("s_waitcnt lgkmcnt(0)" ::: "memory")
__device__ __forceinline__ unsigned f2bf(float f) { unsigned u = __builtin_bit_cast(unsigned, f); return (u + 0x7fffu + ((u >> 16) & 1u)) >> 16; }
__device__ __forceinline__ unsigned pk2(float lo, float hi) { return f2bf(lo) | (f2bf(hi) << 16); }
__device__ __forceinline__ float bf2f(unsigned short b) { return __uint_as_float(((unsigned)b) << 16); }

__device__ __forceinline__ float wave_sum(float v) {
#pragma unroll
    for (int o = 1; o < 64; o <<= 1) v += __shfl_xor(v, o);
    return v;
}
#define XB_TMO      128
#define XB_XCNT(j)  (256  + 64 * (j))
#define XB_XSUB(j)  (1280 + 64 * (j))
#define XB_XGEN(j)  (2304 + 64 * (j))
#define XB_TOP      3328
#define XB_TOPGEN   3392
#define XCD_BAR_WORDS 3456
#define XB_SPIN_CAP (1u << 18)

__device__ __forceinline__ unsigned xb_ld(unsigned* p)              { return __hip_atomic_load(p, __ATOMIC_RELAXED, __HIP_MEMORY_SCOPE_AGENT); }
__device__ __forceinline__ unsigned xb_add(unsigned* p, unsigned v) { return __hip_atomic_fetch_add(p, v, __ATOMIC_RELAXED, __HIP_MEMORY_SCOPE_AGENT); }
__device__ __forceinline__ unsigned xb_xcc_id() { return (unsigned)__builtin_amdgcn_s_getreg((3 << 11) | 20) & 0xFu; }
#define XB_SPIN(cond, bar) do { unsigned _sp = 0; while (cond) { __builtin_amdgcn_s_sleep(1); \
    if ((++_sp & 255u) == 0u) { if (xb_ld(&(bar)[XB_TMO])) break; if (_sp > XB_SPIN_CAP) { atomicAdd(&(bar)[XB_TMO], 1u); break; } } } } while (0)

__device__ __forceinline__ int xb_fresh_lane() { unsigned z = 0u; asm volatile("" : "+v"(z)); return (int)__builtin_amdgcn_mbcnt_hi(~0u, __builtin_amdgcn_mbcnt_lo(~0u, z)); }
struct XcdBarrier {
    unsigned* bar; unsigned x; int wave;
    volatile LAS unsigned* st;
};

__device__ __forceinline__ XcdBarrier xcd_barrier_post(unsigned* bar, volatile LAS unsigned* st, int wave) {
    XcdBarrier b; b.bar = bar; b.x = xb_xcc_id(); b.st = st; b.wave = wave;
    if (wave == 0 && xb_fresh_lane() == 0) (void)xb_add(&bar[XB_XCNT(b.x)], 1u);
    return b;
}
__device__ __forceinline__ void xcd_barrier_complete(unsigned* bar, unsigned x, unsigned& nloc, unsigned& nx) {
    const unsigned G = gridDim.x * gridDim.y * gridDim.z;
    unsigned sum, cnt, mine, sp = 0u;
    for (;;) {
        sum = 0u; cnt = 0u; mine = 0u;
#pragma unroll
        for (unsigned j = 0; j < 16; ++j) { const unsigned c = xb_ld(&bar[XB_XCNT(j)]); sum += c; cnt += (c > 0u) ? 1u : 0u; mine = (j == x) ? c : mine; }
        if (sum == G) break;
        __builtin_amdgcn_s_sleep(1);
        if ((++sp & 255u) == 0u) { if (xb_ld(&bar[XB_TMO])) break; if (sp > XB_SPIN_CAP) { atomicAdd(&bar[XB_TMO], 1u); break; } }
    }
    nloc = mine > 0u ? mine : 1u; nx = cnt > 0u ? cnt : 1u;
}

__device__ __forceinline__ void xcd_barrier(const XcdBarrier& b) {
    asm volatile("s_waitcnt vmcnt(0)" ::: "memory");
    __syncthreads();
    if (b.wave == 0 && xb_fresh_lane() == 0) {
        unsigned* bar = b.bar;
        __builtin_amdgcn_s_waitcnt(0);
        unsigned nloc = b.st[0], nx = b.st[1];
        if (nloc == 0u) { xcd_barrier_complete(bar, b.x, nloc, nx); b.st[0] = nloc; b.st[1] = nx; }
        const unsigned old = xb_add(&bar[XB_XSUB(b.x)], 1u);
        const unsigned gen = old / nloc;
        if (old + 1u == (gen + 1u) * nloc) {
            __builtin_amdgcn_fence(__ATOMIC_RELEASE, "agent");
            asm volatile("s_waitcnt vmcnt(0)" ::: "memory");
            const unsigned og = xb_add(&bar[XB_TOP], 1u);
            const unsigned tg = og / nx;
            if (og + 1u == (tg + 1u) * nx) xb_add(&bar[XB_TOPGEN], 1u);
            else XB_SPIN(xb_ld(&bar[XB_TOPGEN]) == tg, bar);
            __builtin_amdgcn_fence(__ATOMIC_ACQUIRE, "agent");
            xb_add(&bar[XB_XGEN(b.x)], 1u);
            asm volatile("s_waitcnt vmcnt(0)" ::: "memory");
        } else {
            XB_SPIN(xb_ld(&bar[XB_XGEN(b.x)]) == gen, bar);
            __builtin_amdgcn_fence(__ATOMIC_ACQUIRE, "agent");
            asm volatile("s_waitcnt vmcnt(0)" ::: "memory");
        }
    }
    __syncthreads();
}

namespace mx {
typedef short s16x4 __attribute__((ext_vector_type(4)));
typedef short v4i16_t __attribute__((ext_vector_type(4)));
typedef short bf16x8 __attribute__((ext_vector_type(8)));
typedef float f32x2 __attribute__((ext_vector_type(2)));
typedef unsigned u32x2 __attribute__((ext_vector_type(2)));
constexpr int KI = 0, VI = 32768, QI = 65536, SI = 98304;

__device__ __forceinline__ unsigned off_a(unsigned row, unsigned ch) { return 2048u * (row >> 3) + 512u * (ch >> 2) + 64u * (row & 7u) + 16u * ((ch & 3u) ^ ((row >> 2) & 3u)); }
struct LaneAddr { unsigned tr[2][2], row, kap[2]; };
__device__ __forceinline__ void lane_addr(LaneAddr& A, unsigned lane) {
    const unsigned g = lane >> 4, li = lane & 15u, q = li >> 2, p = lane & 3u;
#pragma unroll
    for (unsigned cp = 0; cp < 2; ++cp)
#pragma unroll
        for (unsigned t = 0; t < 2; ++t) A.tr[cp][t] = 2048u * g + 64u * q + 32u * (cp ^ (g & 1u)) + 16u * ((p >> 1) ^ t) + 8u * (p & 1u);
    A.row = 2048u * (li >> 3) + 64u * (li & 7u) + 16u * (g ^ ((li >> 2) & 3u));
#pragma unroll
    for (unsigned t = 0; t < 2; ++t) A.kap[t] = 2048u * (li >> 2) + 64u * (li & 3u) + 16u * ((g ^ (2u * ((li >> 2) & 1u))) ^ t);
}
__device__ __forceinline__ bf16x8 tr_frag(LAS const unsigned char* img, const LaneAddr& A, int c, int ks) {
    const s16x4 lo = __builtin_bit_cast(s16x4, __builtin_amdgcn_ds_read_tr16_b64_v4i16((LAS v4i16_t*)(img + A.tr[c & 1][0] + (8192 * ks + 512 * (c >> 1)))));
    const s16x4 hi = __builtin_bit_cast(s16x4, __builtin_amdgcn_ds_read_tr16_b64_v4i16((LAS v4i16_t*)(img + A.tr[c & 1][1] + (8192 * ks + 512 * (c >> 1) + 256))));
    return __builtin_shufflevector(lo, hi, 0, 1, 2, 3, 4, 5, 6, 7);
}
__device__ __forceinline__ bf16x8 row_frag(LAS const unsigned char* img, const LaneAddr& A, int rb, int s) { return *(LAS const bf16x8*)(img + A.row + (4096 * rb + 512 * s)); }
__device__ __forceinline__ bf16x8 kap_frag(LAS const unsigned char* img, const LaneAddr& A, int kp, int t, int ks) { return *(LAS const bf16x8*)(img + A.kap[t] + (8192 * kp + 512 * ks + 256 * t)); }
__device__ __forceinline__ float gamma_log(int h) { return logf(1.0f - exp2f(-5.0f - (float)h)); }
__device__ __forceinline__ float to_sgpr(float v) { return __builtin_bit_cast(float, __builtin_amdgcn_readfirstlane(__builtin_bit_cast(int, v))); }
__device__ __forceinline__ int opaque_s(int v) { asm volatile("" : "+s"(v)); return v; }

__device__ __forceinline__ void tile_load(v4u (&v)[4], const bf16* src, int tid) {
    const GAS v4u* g = (const GAS v4u*)(src + (size_t)(tid >> 2) * ZP + (tid & 3) * 32);
#pragma unroll
    for (int c = 0; c < 4; ++c) v[c] = g[c];
}
template <bool SCALE> __device__ __forceinline__ void tile_store(LAS unsigned char* img, const v4u (&v)[4], float rowscale, int tid) {
    const unsigned row = (unsigned)tid >> 2, sb = 2048u * (row >> 3) + 512u * ((unsigned)tid & 3u) + 64u * (row & 7u), r2 = (row >> 2) & 3u;
#pragma unroll
    for (int c = 0; c < 4; ++c) {
        v4u o = v[c];
        if (SCALE) {
            const unsigned w[4] = {o.x, o.y, o.z, o.w}; unsigned r[4];
#pragma unroll
            for (int i = 0; i < 4; ++i) r[i] = pg8::cvt_pk_bf16(__uint_as_float(w[i] << 16) * rowscale, __uint_as_float(w[i] & 0xffff0000u) * rowscale);
            o.x = r[0]; o.y = r[1]; o.z = r[2]; o.w = r[3];
        }
        *(LAS v4u*)(img + sb + 16u * ((unsigned)c ^ r2)) = o;
    }
}
#define MX_MFMA(a, b, c) __builtin_amdgcn_mfma_f32_16x16x32_bf16((a), (b), (c), 0, 0, 0)

__device__ __forceinline__ void conv_phase(LAS unsigned char* L, const bf16* ZB, bf16* MIXB, const float* dw_w, const float* dw_b, const float* ln_g, const float* ln_b, int bx, int wave) {
    const int lane0 = xb_fresh_lane(), cp0 = (wave * 64 + lane0) & 255, half = wave >> 2;
    f32x2 w2[CONVW];
#pragma unroll
    for (int j = 0; j < CONVW; ++j) w2[j] = *(const GAS f32x2*)(dw_w + j * CCH + 2 * cp0);
    const f32x2 b2 = *(const GAS f32x2*)(dw_b + 2 * cp0);
    LAS float* CT = (LAS float*)L;
    for (int tile = 0; tile < 4; ++tile) {
        int lane = lane0; asm volatile("" : "+v"(lane));
        const int cp = (wave * 64 + lane) & 255;
        const int mt = bx * 256 + tile * 64, t0 = (mt % SEQ) + 32 * half;
        const bf16* src = ZB + ((long)(mt + 32 * half) - (CONVW - 1)) * ZP + 2 * cp;
        f32x2 acc[32];
#pragma unroll
        for (int t = 0; t < 32; ++t) acc[t] = b2;
#pragma unroll
        for (int r = 0; r < 32 + CONVW - 1; ++r) {
            unsigned u = 0u; if (t0 - (CONVW - 1) + r >= 0) u = *(const GAS unsigned*)(src + (long)r * ZP);
            const f32x2 h2 = {__uint_as_float(u << 16), __uint_as_float(u & 0xffff0000u)};
#pragma unroll
            for (int t = (r - (CONVW - 1) > 0 ? r - (CONVW - 1) : 0); t <= (r < 31 ? r : 31); ++t) acc[t] = w2[r - t] * h2 + acc[t];
        }
#pragma unroll
        for (int t = 0; t < 32; ++t) *(LAS f32x2*)(CT + (32 * half + t) * CCH + 2 * cp) = acc[t];
        __syncthreads();
        {
            const f32x4 g0 = *(const GAS f32x4*)(ln_g + 8 * lane), g1 = *(const GAS f32x4*)(ln_g + 8 * lane + 4), be0 = *(const GAS f32x4*)(ln_b + 8 * lane), be1 = *(const GAS f32x4*)(ln_b + 8 * lane + 4);
#pragma unroll 2
            for (int i = 0; i < 8; ++i) {
                const int tok = 8 * wave + i;
                f32x4 v0 = *(LAS f32x4*)(CT + tok * CCH + 8 * lane), v1 = *(LAS f32x4*)(CT + tok * CCH + 8 * lane + 4);
                const float mean = wave_sum((v0[0] + v0[1]) + (v0[2] + v0[3]) + (v1[0] + v1[1]) + (v1[2] + v1[3])) * (1.0f / CCH);
                v0 = v0 - mean; v1 = v1 - mean;
                const float rstd = rsqrtf(wave_sum((v0[0] * v0[0] + v0[1] * v0[1]) + (v0[2] * v0[2] + v0[3] * v0[3]) + (v1[0] * v1[0] + v1[1] * v1[1]) + (v1[2] * v1[2] + v1[3] * v1[3])) * (1.0f / CCH) + LN_EPS);
                v0 = v0 * rstd * g0 + be0; v1 = v1 * rstd * g1 + be1;
                v0 = v0 * pg8::sig4(v0); v1 = v1 * pg8::sig4(v1);
                *(GAS v4u*)(MIXB + (size_t)(mt + tok) * D + 8 * lane) = pg8::pack8(v0, v1);
            }
        }
        __syncthreads();
    }
}

__device__ __forceinline__ void state_mfma(f32x4 (&sacc)[8], LAS const unsigned char* Kimg, LAS const unsigned char* Vimg, const LaneAddr& A, int wave) {
    LAS const unsigned char* Kw = Kimg + 512 * (wave >> 1);
#pragma unroll
    for (int kp = 0; kp < 4; ++kp) {
        const bf16x8 kf = (wave & 1) ? tr_frag(Kw, A, 1, kp) : tr_frag(Kw, A, 0, kp);
#pragma unroll
        for (int eb = 0; eb < 8; ++eb) { const bf16x8 vf = tr_frag(Vimg, A, eb, kp); sacc[eb] = MX_MFMA(kf, vf, sacc[eb]); }
    }
}
__device__ __forceinline__ void ret_state_phase(LAS unsigned char* L, const bf16* ZB, float* Tf, int bx, int wave) {
    const int lane0 = xb_fresh_lane(), bh = bx >> 3, cg = bx & 7, b = bh >> 2, h = opaque_s(bh & 3);
    const float lg = to_sgpr(gamma_log(h)), kscale = expf(-(float)((wave * 64 + lane0) >> 2) * lg), g1 = to_sgpr(expf(lg)), g127 = to_sgpr(expf(127.0f * lg));
    f32x4 sacc[8];
#pragma unroll
    for (int eb = 0; eb < 8; ++eb) sacc[eb] = (f32x4){0.f, 0.f, 0.f, 0.f};
    v4u kr[4], vr[4];
    { const size_t m0 = (size_t)b * SEQ + (size_t)(cg * 8) * RC; const int tid0 = wave * 64 + lane0; tile_load(kr, ZB + m0 * ZP + 1024 + h * RD, tid0); tile_load(vr, ZB + m0 * ZP + 1536 + h * RD, tid0); }
    for (int j = 0; j < 8; ++j) {
        int lane = lane0; asm volatile("" : "+v"(lane));
        const int tid = wave * 64 + lane;
        tile_store<true>(L + KI, kr, kscale, tid); tile_store<false>(L + VI, vr, 1.0f, tid);
        __syncthreads();
        if (j < 7) { const size_t m1 = (size_t)b * SEQ + (size_t)(cg * 8 + j + 1) * RC; tile_load(kr, ZB + m1 * ZP + 1024 + h * RD, tid); tile_load(vr, ZB + m1 * ZP + 1536 + h * RD, tid); }
#pragma unroll
        for (int eb = 0; eb < 8; ++eb) sacc[eb] = sacc[eb] * g1;
        LaneAddr A; lane_addr(A, (unsigned)lane);
        state_mfma(sacc, L + KI, L + VI, A, wave);
#pragma unroll
        for (int eb = 0; eb < 8; ++eb) sacc[eb] = sacc[eb] * g127;
        __syncthreads();
    }
    GAS f32x4* dst = (GAS f32x4*)Tf + (size_t)(bx * 8 + wave) * 8 * 64 + lane0;
#pragma unroll
    for (int eb = 0; eb < 8; ++eb) dst[eb * 64] = sacc[eb];
}
__device__ __forceinline__ void ret_out_phase(LAS unsigned char* L, const bf16* ZB, bf16* MIXB, const float* Tf, const float* gn_g, const float* gn_b, int bx, int wave) {
    const int lane0 = xb_fresh_lane(), bh = bx >> 3, cg = bx & 7, b = bh >> 2, h = opaque_s(bh & 3);
    const float lg = to_sgpr(gamma_log(h)), kscale = expf(-(float)((wave * 64 + lane0) >> 2) * lg), qscale = expf((float)((wave * 64 + lane0) >> 2) * lg), g1 = to_sgpr(expf(lg)), g127 = to_sgpr(expf(127.0f * lg)), cd8 = to_sgpr(expf(1024.0f * lg));
    f32x4 sacc[8];
#pragma unroll
    for (int eb = 0; eb < 8; ++eb) sacc[eb] = (f32x4){0.f, 0.f, 0.f, 0.f};
    { float coef = 1.0f;
      for (int g2 = cg - 1; g2 >= 0; --g2) { const GAS f32x4* src = (const GAS f32x4*)Tf + (size_t)((bh * 8 + g2) * 8 + wave) * 8 * 64 + lane0;
#pragma unroll
          for (int eb = 0; eb < 8; ++eb) sacc[eb] = sacc[eb] + src[eb * 64] * coef;
          coef *= cd8; } }
    v4u kr[4], vr[4], qr[4];
    { const size_t m0 = (size_t)b * SEQ + (size_t)(cg * 8) * RC; const int tid0 = wave * 64 + lane0;
      tile_load(kr, ZB + m0 * ZP + 1024 + h * RD, tid0); tile_load(vr, ZB + m0 * ZP + 1536 + h * RD, tid0); tile_load(qr, ZB + m0 * ZP + 512 + h * RD, tid0); }
    for (int j = 0; j < 8; ++j) {
        int lane = lane0; asm volatile("" : "+v"(lane));
        const int tid = wave * 64 + lane, g = lane >> 4, li = lane & 15;
        const size_t m0 = (size_t)b * SEQ + (size_t)(cg * 8 + j) * RC;
        tile_store<true>(L + KI, kr, kscale, tid); tile_store<false>(L + VI, vr, 1.0f, tid); tile_store<true>(L + QI, qr, qscale, tid);
        LaneAddr A; lane_addr(A, (unsigned)lane);
        { const unsigned stb = 2048u * ((unsigned)li >> 3) + 512u * ((unsigned)wave >> 1) + 64u * ((unsigned)li & 7u) + 16u * ((2u * ((unsigned)wave & 1u) + ((unsigned)g >> 1)) ^ (((unsigned)li >> 2) & 3u)) + 8u * ((unsigned)g & 1u);
#pragma unroll
          for (int eb = 0; eb < 8; ++eb) { const f32x4 sv = sacc[eb] * g1; u32x2 w; w.x = pg8::cvt_pk_bf16(sv[0], sv[1]); w.y = pg8::cvt_pk_bf16(sv[2], sv[3]);
              *(LAS u32x2*)(L + SI + stb + 4096 * eb) = w; } }
        __syncthreads();
        if (j < 7) { const size_t m1 = m0 + RC; tile_load(kr, ZB + m1 * ZP + 1024 + h * RD, tid); tile_load(vr, ZB + m1 * ZP + 1536 + h * RD, tid); tile_load(qr, ZB + m1 * ZP + 512 + h * RD, tid); }
        const size_t mrow = m0 + 16 * wave + li;
        u32x2 gw[8];
#pragma unroll
        for (int eb = 0; eb < 8; ++eb) gw[eb] = *(const GAS u32x2*)(ZB + mrow * ZP + 2048 + h * RD + 16 * eb + 4 * g);
        bf16x8 qf[4];
#pragma unroll
        for (int ks = 0; ks < 4; ++ks) qf[ks] = row_frag(L + QI + 4096 * wave, A, 0, ks);
        bf16x8 pf[4];
#pragma unroll
        for (int kp = 0; kp < 4; ++kp) {
            unsigned pw[4] = {0u, 0u, 0u, 0u};
            if (kp <= (wave >> 1)) {
#pragma unroll
                for (int t = 0; t < 2; ++t) {
                    f32x4 x = (f32x4){0.f, 0.f, 0.f, 0.f};
#pragma unroll
                    for (int ks = 0; ks < 4; ++ks) x = MX_MFMA(kap_frag(L + KI, A, kp, t, ks), qf[ks], x);
                    { const int key0 = 32 * kp + 8 * g + 4 * t, ql = 16 * wave + li;
#pragma unroll
                        for (int r = 0; r < 4; ++r) x[r] = (key0 + r <= ql) ? x[r] : 0.f; }
                    pw[2 * t] = pg8::cvt_pk_bf16(x[0], x[1]); pw[2 * t + 1] = pg8::cvt_pk_bf16(x[2], x[3]);
                }
            }
            pf[kp] = __builtin_bit_cast(bf16x8, (v4u){pw[0], pw[1], pw[2], pw[3]});
        }
        f32x4 o[8];
#pragma unroll
        for (int eb = 0; eb < 8; ++eb) o[eb] = (f32x4){0.f, 0.f, 0.f, 0.f};
#pragma unroll
        for (int eb = 0; eb < 8; ++eb) {
#pragma unroll
            for (int ks = 0; ks < 4; ++ks) o[eb] = MX_MFMA(row_frag(L + SI, A, eb, ks), qf[ks], o[eb]);
            }
#pragma unroll
        for (int eb = 0; eb < 8; ++eb) sacc[eb] = sacc[eb] * g1;
#pragma unroll
        for (int kp = 0; kp < 4; ++kp) {
            const bf16x8 kf = (wave & 1) ? tr_frag(L + KI + 512 * (wave >> 1), A, 1, kp) : tr_frag(L + KI + 512 * (wave >> 1), A, 0, kp);
#pragma unroll
            for (int eb = 0; eb < 8; ++eb) { const bf16x8 vf = tr_frag(L + VI, A, eb, kp);
                o[eb] = MX_MFMA(vf, pf[kp], o[eb]);
                sacc[eb] = MX_MFMA(kf, vf, sacc[eb]); }
        }
#pragma unroll
        for (int eb = 0; eb < 8; ++eb) sacc[eb] = sacc[eb] * g127;
        float s1 = 0.f;
#pragma unroll
        for (int eb = 0; eb < 8; ++eb) s1 += (o[eb][0] + o[eb][1]) + (o[eb][2] + o[eb][3]);
        s1 += __shfl_xor(s1, 16); s1 += __shfl_xor(s1, 32);
        const float mean = s1 * (1.0f / RD); float s2 = 0.f;
#pragma unroll
        for (int eb = 0; eb < 8; ++eb) { o[eb] = o[eb] - mean; s2 += (o[eb][0] * o[eb][0] + o[eb][1] * o[eb][1]) + (o[eb][2] * o[eb][2] + o[eb][3] * o[eb][3]); }
        s2 += __shfl_xor(s2, 16); s2 += __shfl_xor(s2, 32);
        const float rstd = rsqrtf(s2 * (1.0f / RD) + LN_EPS);
#pragma unroll
        for (int eb = 0; eb < 8; ++eb) { const int e0 = h * RD + 16 * eb + 4 * g;
            const f32x4 gg = *(const GAS f32x4*)(gn_g + e0), gb = *(const GAS f32x4*)(gn_b + e0);
            const f32x4 gt = (f32x4){__uint_as_float(gw[eb].x << 16), __uint_as_float(gw[eb].x & 0xffff0000u), __uint_as_float(gw[eb].y << 16), __uint_as_float(gw[eb].y & 0xffff0000u)};
            const f32x4 y = (o[eb] * rstd * gg + gb) * (gt * pg8::sig4(gt));
            u32x2 w; w.x = pg8::cvt_pk_bf16(y[0], y[1]); w.y = pg8::cvt_pk_bf16(y[2], y[3]);
            *(GAS u32x2*)(MIXB + mrow * D + CCH + e0) = w; }
        __syncthreads();
    }
}
#undef MX_MFMA
}

struct Args {
    const float* x; const float* p; const int* pos; const float* norm_mix_g; const float* w_in; const float* dw_w; const float* dw_b; const float* ln_g; const float* ln_b;
    const float* gn_g; const float* gn_b; const float* w_out; const float* norm_ffn_g; const float* w_ff1; const float* w_ff2; const float* norm_ple_g; const float* w_gate; const float* w_proj;
    const float* final_g; float* out; unsigned char* ws; int ph_lo, ph_hi, li, pad;
};
__device__ __forceinline__ int inmap(int s) {
    if (s < 512) return 256 * (s >> 7) + (s & 127);
    if (s < 1024) { const int ch = s - 512; return 256 * (ch >> 7) + 128 + (ch & 127); }
    if (s < 2048) { const int k = s >= 1536, r = s - (k ? 1536 : 1024), hq = r >> 7, dd = r & 127; return 256 * ((k ? 6 : 4) + (hq >> 1)) + 128 * (dd >> 6) + 64 * (hq & 1) + (dd & 63); }
    return s;
}
template <bool INMAP> __device__ __forceinline__ void tr_item(const float* W, int K, int N, const float* gain, bf16* WT, LAS float* scr, int item, int lane) {
    const int nblk = N / 32, kb = item / nblk, nb = item % nblk, k0 = 64 * kb, n0 = 32 * nb;
#pragma unroll 8
    for (int i = 0; i < 32; ++i) { const int kk = 2 * i + (lane >> 5); scr[kk * 33 + (lane & 31)] = W[(size_t)(k0 + kk) * N + n0 + (lane & 31)] * (gain ? gain[k0 + kk] : 1.0f); }
    LDS_WAIT(); asm volatile("" ::: "memory");
    const int c = lane & 7;
#pragma unroll
    for (int j = 0; j < 4; ++j) { const int n = (lane >> 3) + 8 * j; const LAS float* s = scr + (8 * c) * 33 + n;
        const int src = n0 + n; const int r = INMAP ? inmap(src) : src; const float cs = (INMAP && src >= 1536 && src < 2048) ? 0.088388347648318447f : 1.0f;
        v4u o; o.x = pk2(s[0 * 33] * cs, s[1 * 33] * cs); o.y = pk2(s[2 * 33] * cs, s[3 * 33] * cs); o.z = pk2(s[4 * 33] * cs, s[5 * 33] * cs); o.w = pk2(s[6 * 33] * cs, s[7 * 33] * cs);
        *(GAS v4u*)(WT + (size_t)r * K + k0 + 8 * c) = o; }
    LDS_WAIT(); asm volatile("" ::: "memory");
}

__device__ __forceinline__ const void* lds_ptr(LAS unsigned char* p) {
    const unsigned lo = __builtin_amdgcn_readfirstlane(((volatile LAS unsigned*)p)[0]), hi = __builtin_amdgcn_readfirstlane(((volatile LAS unsigned*)p)[1]);
    return (const void*)(((unsigned long long)hi << 32) | lo);
}
#ifndef PROBE_DUP
#define PROBE_DUP (-1)
#endif
#define DUPN(k) ((PROBE_DUP == (k)) ? 2 : 1)
__global__ void __launch_bounds__(NWAVES * 64, 2) mk_fwd(Args a) {
    extern __shared__ __attribute__((aligned(16))) unsigned char lds[];
    LAS unsigned char* const L = (LAS unsigned char*)lds;
    volatile LAS unsigned* MISC = (volatile LAS unsigned*)(L + MISC_OFF);
    const int wave = __builtin_amdgcn_readfirstlane(threadIdx.x >> 6);
#define LANE_ID() xb_fresh_lane()
    const int G = gridDim.x, bx = blockIdx.x;
    unsigned char* ws = a.ws;
    gu32* ctl = (gu32*)(ws + WS_CTL);
    if (threadIdx.x < 64) MISC[threadIdx.x] = 0u;
    if (threadIdx.x < sizeof(Args) / 4) ((volatile LAS unsigned*)(L + ARGS_OFF))[threadIdx.x] = ((const unsigned*)&a)[threadIdx.x];
    __syncthreads();
#define ARGP(field) ((decltype(a.field))lds_ptr(L + ARGS_OFF + offsetof(Args, field)))
    XcdBarrier bar = xcd_barrier_post((unsigned*)(ctl + CW_BAR) + a.li * XCD_BAR_WORDS, MISC + 8, wave);
    const int lo = a.ph_lo, hi = a.ph_hi;
#define IN(k) (lo <= (k) && (k) < hi)
#define SEAM(k) do { if (IN(k) && IN((k) + 1)) xcd_barrier(bar); } while (0)
    const int gw = bx * NWAVES + wave, NGW = G * NWAVES;
    const size_t NGT = (size_t)G * NWAVES * 64;
    bf16* const XB = (bf16*)(ws + WS_XB); bf16* const ZB = (bf16*)(ws + WS_ZB); bf16* const MIXB = (bf16*)(ws + WS_MIX); bf16* const HID = (bf16*)(ws + WS_HID);
    bf16* const XO = (bf16*)a.out;
    float* const TF = (float*)(ws + WS_T);
    bf16* const PROJ = (bf16*)(ws + WS_PROJ); bf16* const PB = (bf16*)(ws + WS_PB); unsigned* const ROPE = (unsigned*)(ws + WS_ROPE);

    if (IN(0))
#pragma clang loop unroll(full)
    for (int rep = 0; rep < DUPN(0); ++rep) {
        const int lane = LANE_ID(); const size_t gt = (size_t)bx * (NWAVES * 64) + wave * 64 + lane;
        LAS float* scr = (LAS float*)(L + RING_OFF + wave * 16384);
        constexpr int I_IN = (D / 64) * (INC / 32), I_OUT = (D / 64) * (D / 32), I_F1 = (D / 64) * (FF / 32), I_F2 = (FF / 64) * (D / 32), I_G = I_OUT, I_P = (PLE / 64) * (D / 32);
        constexpr int I_LAYER = I_IN + I_OUT + I_F1 + I_F2 + I_G + I_P;
        for (int it = gw; it < DEPTH * I_LAYER; it += NGW) {
            const int l = it / I_LAYER; int r = it % I_LAYER; unsigned char* wl = ws + WS_W + (size_t)l * W_LAYER;
            if (r < I_IN) { tr_item<true>(a.w_in + (size_t)l * D * INC, D, INC, a.norm_mix_g + l * D, (bf16*)(wl + WO_IN), scr, r, lane); continue; } r -= I_IN;
            if (r < I_OUT) { tr_item<false>(a.w_out + (size_t)l * D * D, D, D, nullptr, (bf16*)(wl + WO_OUT), scr, r, lane); continue; } r -= I_OUT;
            if (r < I_F1) { tr_item<false>(a.w_ff1 + (size_t)l * D * FF, D, FF, a.norm_ffn_g + l * D, (bf16*)(wl + WO_FF1), scr, r, lane); continue; } r -= I_F1;
            if (r < I_F2) { tr_item<false>(a.w_ff2 + (size_t)l * FF * D, FF, D, nullptr, (bf16*)(wl + WO_FF2), scr, r, lane); continue; } r -= I_F2;
            if (r < I_G) { tr_item<false>(a.w_gate + (size_t)l * D * D, D, D, a.norm_ple_g + l * D, (bf16*)(wl + WO_GATE), scr, r, lane); continue; } r -= I_G;
            tr_item<false>(a.w_proj + (size_t)l * PLE * D, PLE, D, nullptr, (bf16*)(wl + WO_PROJ), scr, r, lane);
        }
        float* ss0 = (float*)(ws + WS_SS);
        for (int m = gw; m < M; m += NGW) {
            const GAS f32x4* xr = (const GAS f32x4*)(a.x + (size_t)m * D) + lane; f32x4 v[4]; float s = 0.f;
#pragma unroll
            for (int j = 0; j < 4; ++j) { v[j] = xr[64 * j]; s += (v[j].x * v[j].x + v[j].y * v[j].y) + (v[j].z * v[j].z + v[j].w * v[j].w); }
            s = wave_sum(s);
            GAS unsigned long long* o8 = (GAS unsigned long long*)(XB + (size_t)m * D) + lane;
#pragma unroll
            for (int j = 0; j < 4; ++j) o8[64 * j] = (unsigned long long)pk2(v[j].x, v[j].y) | ((unsigned long long)pk2(v[j].z, v[j].w) << 32);
            if (lane < 16) ss0[(size_t)m * 16 + lane] = lane == 0 ? s : 0.f;
        }
        for (size_t i = gt; i < (size_t)DEPTH * M * PLE / 8; i += NGT) {
            const f32x4 p0 = *(const GAS f32x4*)(a.p + i * 8), p1 = *(const GAS f32x4*)(a.p + i * 8 + 4);
            v4u o; o.x = pk2(p0.x, p0.y); o.y = pk2(p0.z, p0.w); o.z = pk2(p1.x, p1.y); o.w = pk2(p1.z, p1.w);
            *(GAS v4u*)(PB + i * 8) = o;
        }
        for (size_t i = gt; i < (size_t)M * 64; i += NGT) {
            const int d = (int)(i & 63); const size_t m = i >> 6;
            const float inv_freq = 1.0f / powf(10000.0f, (float)d * (2.0f / RD)), ang = (float)a.pos[m] * inv_freq;
            const pg8::f16x2 cs = {(_Float16)cosf(ang), (_Float16)sinf(ang)};
            ROPE[i] = __builtin_bit_cast(unsigned, cs);
        }
    }
    SEAM(0);
#pragma clang loop unroll(full)
    for (int l = 0; l < DEPTH; ++l) {
        const int pb = 1 + 8 * l;
        bf16* const XC = (l & 1) ? XO : XB; bf16* const XN = (l & 1) ? XB : XO;
        unsigned char* wl = ws + WS_W + (size_t)l * W_LAYER;
        float* const ss_a = (float*)(ws + WS_SS + (size_t)(3 * l + 0) * SS_SITE);
        float* const ss_b = (float*)(ws + WS_SS + (size_t)(3 * l + 1) * SS_SITE);
        float* const ss_c = (float*)(ws + WS_SS + (size_t)(3 * l + 2) * SS_SITE);
        float* const ss_d = (float*)(ws + WS_SS + (size_t)(3 * l + 3) * SS_SITE);
        if (IN(pb + 0))
#pragma clang loop unroll(full)
        for (int rep = 0; rep < DUPN(pb + 0); ++rep) {
            pg8::Gemm g{XC, (const bf16*)(wl + WO_IN), M, INC, D}; pg8::StaticOrder S; S.init(M, INC, G, bx);
            pg8::EpiInProj E{ZB, ss_a, ROPE};
            pg8::gemm_phase<pg8::EpiInProj, pg8::StaticOrder, true, true>(L + RING_OFF, g, S, E, wave);
        }
        SEAM(pb + 0);
        if (IN(pb + 1))
#pragma clang loop unroll(full)
        for (int rep = 0; rep < DUPN(pb + 1); ++rep) {
            mx::conv_phase(L, ZB, MIXB, ARGP(dw_w) + l * CONVW * CCH, ARGP(dw_b) + l * CCH, ARGP(ln_g) + l * CCH, ARGP(ln_b) + l * CCH, bx, wave);
            mx::ret_state_phase(L, ZB, TF, bx, wave);
        }
        SEAM(pb + 1);
        if (IN(pb + 2))
#pragma clang loop unroll(full)
        for (int rep = 0; rep < DUPN(pb + 2); ++rep) mx::ret_out_phase(L, ZB, MIXB, TF, ARGP(gn_g) + l * RW, ARGP(gn_b) + l * RW, bx, wave);
        SEAM(pb + 2);
        if (IN(pb + 3))
#pragma clang loop unroll(full)
        for (int rep = 0; rep < 1; ++rep) {
            pg8::Gemm g{MIXB, (const bf16*)(wl + WO_OUT), M, D, D}; pg8::StaticOrder S; S.init(M, D, G, bx);
            pg8::EpiResid<0> E{XC, XC, ss_b, nullptr, nullptr};
            pg8::gemm_phase<pg8::EpiResid<0>, pg8::StaticOrder, true, true>(L + RING_OFF, g, S, E, wave);
        }
        SEAM(pb + 3);
        if (IN(pb + 4))
#pragma clang loop unroll(full)
        for (int rep = 0; rep < DUPN(pb + 4); ++rep) {
            pg8::Gemm g{XC, (const bf16*)(wl + WO_FF1), M, FF, D}; pg8::StaticOrder S; S.init(M, FF, G, bx);
            pg8::EpiFF1 E{HID, ss_b};
            pg8::gemm_phase<pg8::EpiFF1, pg8::StaticOrder, true, true>(L + RING_OFF, g, S, E, wave);
        }
        SEAM(pb + 4);
        if (IN(pb + 5)) {
            pg8::Gemm g{HID, (const bf16*)(wl + WO_FF2), M, D, FF}; pg8::StaticOrder S; S.init(M, D, G, bx);
            pg8::EpiResid<0> E{XC, XC, ss_c, nullptr, nullptr};
            pg8::gemm_phase<pg8::EpiResid<0>, pg8::StaticOrder, true, true>(L + RING_OFF, g, S, E, wave);
        }
        SEAM(pb + 5);
        if (IN(pb + 6))
#pragma clang loop unroll(full)
        for (int rep = 0; rep < DUPN(pb + 6); ++rep) {
            pg8::Gemm g{PB + (size_t)l * M * PLE, (const bf16*)(wl + WO_PROJ), M, D, PLE}; pg8::StaticOrder S; S.init(M, D, G, bx);
            pg8::EpiPlain E{PROJ};
            pg8::gemm_phase<pg8::EpiPlain, pg8::StaticOrder, true, true>(L + RING_OFF, g, S, E, wave);
        }
        SEAM(pb + 6);
        if (IN(pb + 7)) {
            pg8::Gemm g{XC, (const bf16*)(wl + WO_GATE), M, D, D}; pg8::StaticOrder S; S.init(M, D, G, bx);
            pg8::EpiResid<1> E{XC, XN, ss_d, ss_c, PROJ};
            pg8::gemm_phase<pg8::EpiResid<1>, pg8::StaticOrder, true, true>(L + RING_OFF, g, S, E, wave);
        }
        SEAM(pb + 7);
    }
    if (IN(17)) {
        const int lane = LANE_ID();
        const float* ssf = (const float*)(ws + WS_SS + (size_t)6 * SS_SITE);
        const bf16* XF = (DEPTH & 1) ? XO : XB;
        const GAS f32x4* gr = (const GAS f32x4*)ARGP(final_g) + 2 * lane; const f32x4 g0 = gr[0], g1 = gr[1], g2 = gr[128], g3 = gr[129];
        for (int m = gw; m < M; m += NGW) {
            const float rs = pg8::rstd_of(ssf, m);
            const GAS v4u* xr = (const GAS v4u*)(XF + (size_t)m * D) + lane; GAS f32x4* orow = (GAS f32x4*)(a.out + (size_t)m * D) + 2 * lane;
            f32x4 a0, a1, b0, b1; pg8::unpack8(xr[0], a0, a1); pg8::unpack8(xr[64], b0, b1);
            orow[0] = a0 * rs * g0; orow[1] = a1 * rs * g1; orow[128] = b0 * rs * g2; orow[129] = b1 * rs * g3;
        }
    }
#undef IN
#undef SEAM
}

extern "C" void kernel_launch(void* const* d_in, const int* in_sizes, int n_in, void* d_out, int out_size, void* d_ws, size_t ws_size, hipStream_t stream) {
    static int grid = 0;
    if (grid == 0) {
        if (n_in != 19 || out_size != M * D || ws_size < WS_END) { fprintf(stderr, "kernel_launch: unexpected problem (n_in %d, out %d, ws %zu < %zu); nothing launched\n", n_in, out_size, ws_size, (size_t)WS_END); grid = -1; return; }
        int dev = 0, cus = 0;
        if (hipGetDevice(&dev) != hipSuccess || hipDeviceGetAttribute(&cus, hipDeviceAttributeMultiprocessorCount, dev) != hipSuccess) { grid = -1; return; }
        if (hipFuncSetAttribute((const void*)mk_fwd, hipFuncAttributeMaxDynamicSharedMemorySize, LDS_BYTES) != hipSuccess) { fprintf(stderr, "kernel_launch: hipFuncSetAttribute failed\n"); grid = -1; return; }
        int per_cu = 0;
        if (hipOccupancyMaxActiveBlocksPerMultiprocessor(&per_cu, (const void*)mk_fwd, NWAVES * 64, LDS_BYTES) != hipSuccess || per_cu < 1) fprintf(stderr, "kernel_launch: occupancy query says %d\n", per_cu);
        (void)hipGetLastError();
        if (cus < 256) fprintf(stderr, "kernel_launch: %d CUs < 256: the grid cannot be resident\n", cus);
        grid = 256;
    }
    if (grid < 0) return;
    (void)hipMemsetAsync((char*)d_ws + WS_CTL, 0, CTL_ZERO_BYTES, stream);
    Args a{};
    a.x = (const float*)d_in[0]; a.p = (const float*)d_in[1]; a.pos = (const int*)d_in[2]; a.norm_mix_g = (const float*)d_in[3]; a.w_in = (const float*)d_in[4]; a.dw_w = (const float*)d_in[5];
    a.dw_b = (const float*)d_in[6]; a.ln_g = (const float*)d_in[7]; a.ln_b = (const float*)d_in[8]; a.gn_g = (const float*)d_in[9]; a.gn_b = (const float*)d_in[10]; a.w_out = (const float*)d_in[11];
    a.norm_ffn_g = (const float*)d_in[12]; a.w_ff1 = (const float*)d_in[13]; a.w_ff2 = (const float*)d_in[14]; a.norm_ple_g = (const float*)d_in[15]; a.w_gate = (const float*)d_in[16];
    a.w_proj = (const float*)d_in[17]; a.final_g = (const float*)d_in[18]; a.out = (float*)d_out; a.ws = (unsigned char*)d_ws;
    a.ph_lo = 0; a.ph_hi = 18; a.li = 0;
    hipLaunchKernelGGL(mk_fwd, dim3(grid), dim3(NWAVES * 64), LDS_BYTES, stream, a);
}
```

```cpp
#include <hip/hip_runtime.h>
#include <cstdio>
#include <cstdint>
#include <cstddef>
namespace pg8 {
#define PG8_LAS __attribute__((address_space(3)))
typedef unsigned short bf16_t;
typedef short bf16x8 __attribute__((ext_vector_type(8)));
typedef float f32x4 __attribute__((ext_vector_type(4)));
typedef unsigned u32x4 __attribute__((ext_vector_type(4)));
typedef unsigned u32x2 __attribute__((ext_vector_type(2)));
constexpr int BM = 256, BK = 64, HALF = 128, HTB = HALF * BK * 2  , STAGE_BYTES = 8 * HTB, NXCD = 8, WGM = 8;

__host__ __device__ __forceinline__ int lds_byte(int r, int c) { const int st = (r >> 4) * 2 + (c >> 5), rr = r & 15, cc = c & 31, ob = rr * 64 + cc * 2; return st * 1024 + (ob ^ (((ob >> 9) & 1) << 5)); }
__host__ __device__ __forceinline__ void stage_rc(int b, int& R, int& C) { const int st = b / 1024, sb = b % 1024, swz = sb ^ (((sb >> 9) & 1) << 5); R = (st >> 1) * 16 + swz / 64; C = (st & 1) * 32 + (swz % 64) / 2; }
__host__ __device__ __forceinline__ int perm32(int rho) { const int n = rho >> 4, i = rho & 15; return 8 * (i >> 2) + 4 * n + (i & 3); }

struct Unit { int pm, pn; };
struct Gemm { const bf16_t* A; const bf16_t* Bt; int M, N, K; };

struct StaticOrder {
    int nM, nN, nwg, G, c;
    __host__ __device__ void init(int M, int N, int G_, int c_) { nM = M / BM; nN = N / BM; nwg = nM * nN; G = G_; c = c_; }
    __host__ __device__ bool next(int i, Unit& u) const {
        const long L = (long)i * G + c; if (L >= nwg) return false;
        int wgid = (int)L; { const int q = nwg / NXCD, r = nwg % NXCD, xcd = wgid % NXCD, off = wgid / NXCD; wgid = (xcd < r ? xcd * (q + 1) : r * (q + 1) + (xcd - r) * q) + off; }
        const int nig = WGM * nN, gid = wgid / nig, fm = gid * WGM, gsz = (nM - fm) < WGM ? (nM - fm) : WGM;
        u.pm = fm + ((wgid % nig) % gsz); u.pn = (wgid % nig) / gsz; return true;
    }
    __device__ __forceinline__ void a_ready(const Unit&) const {}
    __device__ __forceinline__ void done(const Unit&) const {}
};

__device__ __forceinline__ unsigned cvt_pk_bf16(float lo, float hi) { unsigned r; asm volatile("v_cvt_pk_bf16_f32 %0, %1, %2" : "=v"(r) : "v"(lo), "v"(hi)); return r; }
__device__ __forceinline__ u32x4 pack8(const f32x4 a, const f32x4 b) { u32x4 w; w.x = cvt_pk_bf16(a[0], a[1]); w.y = cvt_pk_bf16(a[2], a[3]); w.z = cvt_pk_bf16(b[0], b[1]); w.w = cvt_pk_bf16(b[2], b[3]); return w; }
__device__ __forceinline__ float fast_sigmoid(float x) { return __builtin_amdgcn_rcpf(1.0f + __builtin_amdgcn_exp2f(x * -1.4426950408889634f)); }
__device__ __forceinline__ f32x4 sig4(const f32x4 v) { return (f32x4){fast_sigmoid(v[0]), fast_sigmoid(v[1]), fast_sigmoid(v[2]), fast_sigmoid(v[3])}; }
constexpr int SSP = 16;
constexpr float RMS_EPS_ = 1e-6f;
__device__ __forceinline__ float rstd_of(const float* ss, int row) {
    const f32x4* p = (const f32x4*)(ss + (size_t)row * SSP); const f32x4 a = p[0], b = p[1], c = p[2], d = p[3];
    const f32x4 s = (a + b) + (c + d); return rsqrtf(((s[0] + s[1]) + (s[2] + s[3])) * (1.0f / 1024.0f) + RMS_EPS_);
}
typedef _Float16 f16x2 __attribute__((ext_vector_type(2)));

struct EpiInProj {
    static constexpr bool PERM = true, AFTER_DRAIN = false;
    bf16_t* ZB; const float* ss; const unsigned* rope;
    static constexpr int ZP = 2560;
    __device__ __forceinline__ void operator()(const f32x4 (&acc)[2][2][4][2], const Unit& u, int wr, int wc, int fr, int fq) const {
        const int row0 = u.pm * BM + wr * 64 + fr, pn = u.pn, lc = wc * 32 + 8 * fq;
        if (pn < 4) {
#pragma unroll
            for (int ai = 0; ai < 2; ++ai)
#pragma unroll
                for (int m = 0; m < 4; ++m) { const int row = row0 + ai * HALF + m * 16; const float rs = rstd_of(ss, row);
                    const f32x4 h0 = (acc[ai][0][m][0] * rs) * sig4(acc[ai][1][m][0] * rs), h1 = (acc[ai][0][m][1] * rs) * sig4(acc[ai][1][m][1] * rs);
                    *(u32x4*)(ZB + (size_t)row * ZP + pn * 128 + lc) = pack8(h0, h1); asm volatile("" ::: "memory"); }
        } else if (pn < 8) {
            const int head = 2 * (pn & 1) + (wc >> 1), d0 = lc & 63, colb = (pn < 6 ? 512 : 1024) + head * 128 + d0;
#pragma unroll
            for (int ai = 0; ai < 2; ++ai)
#pragma unroll
                for (int m = 0; m < 4; ++m) { const int row = row0 + ai * HALF + m * 16; const float rs = rstd_of(ss, row);
                    const u32x4* rp = (const u32x4*)(rope + (size_t)row * 64 + d0); const u32x4 r0 = rp[0], r1 = rp[1];
                    f32x4 o1[2], o2[2];
                    const unsigned rv[8] = {r0.x, r0.y, r0.z, r0.w, r1.x, r1.y, r1.z, r1.w};
#pragma unroll
                    for (int n = 0; n < 2; ++n) {
#pragma unroll
                        for (int i = 0; i < 4; ++i) { const f16x2 cs = __builtin_bit_cast(f16x2, rv[4 * n + i]); const float c = (float)cs[0], s = (float)cs[1];
                            const float t1 = acc[ai][0][m][n][i] * rs, t2 = acc[ai][1][m][n][i] * rs; o1[n][i] = t1 * c - t2 * s; o2[n][i] = t2 * c + t1 * s; } }
                    bf16_t* zp = ZB + (size_t)row * ZP + colb; *(u32x4*)zp = pack8(o1[0], o1[1]); *(u32x4*)(zp + 64) = pack8(o2[0], o2[1]); asm volatile("" ::: "memory"); }
        } else {
            const int colb = 1536 + (pn - 8) * 256 + lc;
#pragma unroll
            for (int ai = 0; ai < 2; ++ai)
#pragma unroll
                for (int m = 0; m < 4; ++m) { const int row = row0 + ai * HALF + m * 16; const float rs = rstd_of(ss, row);
#pragma unroll
                    for (int bj = 0; bj < 2; ++bj) { f32x4 v0 = acc[ai][bj][m][0] * rs, v1 = acc[ai][bj][m][1] * rs;
                        *(u32x4*)(ZB + (size_t)row * ZP + colb + bj * HALF) = pack8(v0, v1); } asm volatile("" ::: "memory"); }
        }
    }
};
__device__ __forceinline__ void unpack8(const u32x4 w, f32x4& a, f32x4& b) {
    a = (f32x4){__uint_as_float(w.x << 16), __uint_as_float(w.x & 0xffff0000u), __uint_as_float(w.y << 16), __uint_as_float(w.y & 0xffff0000u)};
    b = (f32x4){__uint_as_float(w.z << 16), __uint_as_float(w.z & 0xffff0000u), __uint_as_float(w.w << 16), __uint_as_float(w.w & 0xffff0000u)};
}
template <int MODE> struct EpiResid {
    static constexpr bool PERM = true, AFTER_DRAIN = false;
    const bf16_t* XI; bf16_t* XO; float* ss_out; const float* ss_in; const bf16_t* proj;
    __device__ __forceinline__ void operator()(const f32x4 (&acc)[2][2][4][2], const Unit& u, int wr, int wc, int fr, int fq) const {
        const int row0 = u.pm * BM + wr * 64 + fr, col0 = u.pn * BM + wc * 32 + 8 * fq;
#pragma unroll
        for (int ai = 0; ai < 2; ++ai)
#pragma unroll
            for (int m = 0; m < 4; ++m) { const int row = row0 + ai * HALF + m * 16; const size_t off = (size_t)row * 1024 + col0; float q = 0.f;
                float rs = 1.f; if (MODE == 1) rs = rstd_of(ss_in, row);
#pragma unroll
                for (int bj = 0; bj < 2; ++bj) { f32x4 b0, b1; unpack8(*(const u32x4*)(XI + off + bj * HALF), b0, b1);
                    f32x4 v0, v1;
                    if (MODE == 1) { f32x4 p0, p1; unpack8(*(const u32x4*)(proj + off + bj * HALF), p0, p1);
                        v0 = b0 + sig4(acc[ai][bj][m][0] * rs) * p0; v1 = b1 + sig4(acc[ai][bj][m][1] * rs) * p1; }
                    else { v0 = b0 + acc[ai][bj][m][0]; v1 = b1 + acc[ai][bj][m][1]; }
                    *(u32x4*)(XO + off + bj * HALF) = pack8(v0, v1);
                    q += (v0[0] * v0[0] + v0[1] * v0[1]) + (v0[2] * v0[2] + v0[3] * v0[3]) + (v1[0] * v1[0] + v1[1] * v1[1]) + (v1[2] * v1[2] + v1[3] * v1[3]); }
                q += __shfl_xor(q, 16); q += __shfl_xor(q, 32);
                if (fq == 0) ss_out[(size_t)row * SSP + u.pn * 4 + wc] = q; asm volatile("" ::: "memory"); }
    }
};
struct EpiFF1 {
    static constexpr bool PERM = true, AFTER_DRAIN = false;
    bf16_t* H; const float* ss;
    __device__ __forceinline__ void operator()(const f32x4 (&acc)[2][2][4][2], const Unit& u, int wr, int wc, int fr, int fq) const {
        const int row0 = u.pm * BM + wr * 64 + fr, col0 = u.pn * BM + wc * 32 + 8 * fq;
#pragma unroll
        for (int ai = 0; ai < 2; ++ai)
#pragma unroll
            for (int m = 0; m < 4; ++m) { const int row = row0 + ai * HALF + m * 16; const float rs = rstd_of(ss, row);
#pragma unroll
                for (int bj = 0; bj < 2; ++bj) { f32x4 v0 = acc[ai][bj][m][0] * rs, v1 = acc[ai][bj][m][1] * rs;
                    v0 = __builtin_elementwise_max(v0, (f32x4){0.f, 0.f, 0.f, 0.f}); v1 = __builtin_elementwise_max(v1, (f32x4){0.f, 0.f, 0.f, 0.f}); v0 = v0 * v0; v1 = v1 * v1;
                    *(u32x4*)(H + (size_t)row * 4096 + col0 + bj * HALF) = pack8(v0, v1); } asm volatile("" ::: "memory"); }
    }
};
struct EpiPlain {
    static constexpr bool PERM = true, AFTER_DRAIN = false;
    bf16_t* O;
    __device__ __forceinline__ void operator()(const f32x4 (&acc)[2][2][4][2], const Unit& u, int wr, int wc, int fr, int fq) const {
        const int row0 = u.pm * BM + wr * 64 + fr, col0 = u.pn * BM + wc * 32 + 8 * fq;
#pragma unroll
        for (int ai = 0; ai < 2; ++ai)
#pragma unroll
            for (int m = 0; m < 4; ++m) { const int row = row0 + ai * HALF + m * 16;
#pragma unroll
                for (int bj = 0; bj < 2; ++bj) *(u32x4*)(O + (size_t)row * 1024 + col0 + bj * HALF) = pack8(acc[ai][bj][m][0], acc[ai][bj][m][1]); }
    }
};

template <class Epi, class Sched, bool ALIGN_EPI = false, bool SP2 = false>
__device__ __forceinline__ void gemm_phase(PG8_LAS unsigned char* lds, const Gemm g, const Sched& S, const Epi& E, const int wave_id) {
    unsigned z_ = 0u; asm volatile("" : "+v"(z_)); const int tid_ = wave_id * 64 + (int)__builtin_amdgcn_mbcnt_hi(~0u, __builtin_amdgcn_mbcnt_lo(~0u, z_));
    const int tid = tid_, wid = wave_id, lane = tid & 63, wr = wid >> 2, wc = wid & 3, fr = lane & 15, fq = lane >> 4;
    const int K = g.K, nt = K / BK;
    unsigned voffA[2], voffB[2];
#pragma unroll
    for (int i = 0; i < 2; ++i) { int R, C; stage_rc(tid * 16 + i * 8192, R, C); const int Rb = Epi::PERM ? ((R & ~31) + perm32(R & 31)) : R;
        voffA[i] = (unsigned)(R * K + C) * 2u; voffB[i] = (unsigned)(Rb * K + C) * 2u; }
    const size_t kstep = (size_t)(BK * 2);
    const size_t hstep = (size_t)HALF * K * 2;
    const size_t tstep = 2 * hstep;
    const unsigned ldsw = (unsigned)wid * 1024u;
    const int aoff = lds_byte(wr * 64 + fr, fq * 8), boff = lds_byte(wc * 32 + fr, fq * 8);
#define PG8_SA(b, h) (((b) * 2 + (h)) * HTB)
#define PG8_SB(b, h) ((4 + (b) * 2 + (h)) * HTB)
#define PG8_STAGE(bufoff, gbase, voff) do { _Pragma("unroll") for (int _i = 0; _i < 2; ++_i) \
        __builtin_amdgcn_global_load_lds((const unsigned*)((const char*)(gbase) + (voff)[_i]), (PG8_LAS unsigned*)(lds + (bufoff) + ldsw + _i * 8192), 16, 0, 0); } while (0)
#define PG8_LDA(dst, b, h) do { _Pragma("unroll") for (int m = 0; m < 4; ++m) _Pragma("unroll") for (int k = 0; k < 2; ++k) dst[m][k] = *(const PG8_LAS bf16x8*)(lds + PG8_SA(b, h) + aoff + m * 2048 + k * 1024); } while (0)
#define PG8_LDB(dst, b, h) do { _Pragma("unroll") for (int n = 0; n < 2; ++n) _Pragma("unroll") for (int k = 0; k < 2; ++k) dst[n][k] = *(const PG8_LAS bf16x8*)(lds + PG8_SB(b, h) + boff + n * 2048 + k * 1024); } while (0)
#define PG8_MMA(ai, bj, At, Bt) do { __builtin_amdgcn_s_setprio(1); _Pragma("unroll") for (int m = 0; m < 4; ++m) _Pragma("unroll") for (int n = 0; n < 2; ++n) _Pragma("unroll") for (int k = 0; k < 2; ++k) \
        acc[ai][bj][m][n] = __builtin_amdgcn_mfma_f32_16x16x32_bf16(Bt[n][k], At[m][k], acc[ai][bj][m][n], 0, 0, 0); __builtin_amdgcn_s_setprio(0); } while (0)
#define PG8_WAIT_V(n) asm volatile("s_waitcnt vmcnt(" #n ")" ::: "memory")
#define PG8_WAIT_L(n) asm volatile("s_waitcnt lgkmcnt(" #n ")" ::: "memory")
#define PG8_BAR __builtin_amdgcn_s_barrier()
#define PG8_SCHED __builtin_amdgcn_sched_barrier(0)
    Unit cur, nxt; int ui = 0;
    if (!S.next(0, cur)) return;
    f32x4 acc[2][2][4][2];
#pragma unroll
    for (int a = 0; a < 2; ++a)
#pragma unroll
        for (int b = 0; b < 2; ++b)
#pragma unroll
            for (int m = 0; m < 4; ++m)
#pragma unroll
                for (int n = 0; n < 2; ++n) acc[a][b][m][n] = (f32x4){0.f, 0.f, 0.f, 0.f};
    bf16x8 At[4][2], B0[2][2], B1[2][2];
    const char* cA = (const char*)g.A + (size_t)cur.pm * tstep; const char* cB = (const char*)g.Bt + (size_t)cur.pn * tstep;
    S.a_ready(cur);
    if constexpr (SP2) {
        PG8_STAGE(PG8_SB(0, 0), cB, voffB); PG8_STAGE(PG8_SB(0, 1), cB + hstep, voffB); PG8_STAGE(PG8_SA(0, 0), cA, voffA); PG8_STAGE(PG8_SA(0, 1), cA + hstep, voffA);
        if (wr == 1) PG8_BAR;
        PG8_WAIT_V(2); PG8_BAR;
        PG8_STAGE(PG8_SB(1, 0), cB + kstep, voffB); PG8_STAGE(PG8_SA(1, 0), cA + kstep, voffA); PG8_STAGE(PG8_SB(1, 1), cB + hstep + kstep, voffB);
        PG8_WAIT_V(6); PG8_BAR;
    } else {
        PG8_STAGE(PG8_SB(0, 0), cB, voffB); PG8_STAGE(PG8_SA(0, 0), cA, voffA); PG8_STAGE(PG8_SB(0, 1), cB + hstep, voffB); PG8_STAGE(PG8_SA(0, 1), cA + hstep, voffA);
        if (wr == 1) PG8_BAR;
        PG8_WAIT_V(4); PG8_BAR;
        PG8_STAGE(PG8_SB(1, 0), cB + kstep, voffB); PG8_STAGE(PG8_SA(1, 0), cA + kstep, voffA); PG8_STAGE(PG8_SB(1, 1), cB + hstep + kstep, voffB);
        PG8_WAIT_V(6); PG8_BAR;
    }
    for (;;) {
        const bool has_next = S.next(ui + 1, nxt);
        const char* nA = has_next ? (const char*)g.A + (size_t)nxt.pm * tstep : cA; const char* nB = has_next ? (const char*)g.Bt + (size_t)nxt.pn * tstep : cB;
        for (int t = 0; t < nt; t += 2) {
            const bool last = (t == nt - 2);
            const char* a1 = cA + (size_t)(t + 1) * kstep;
            const char* a2 = last ? nA : cA + (size_t)(t + 2) * kstep; const char* b2 = last ? nB : cB + (size_t)(t + 2) * kstep;
            const char* a3 = a2 + kstep; const char* b3 = b2 + kstep;
            if (last && has_next) S.a_ready(nxt);
            if constexpr (SP2) {
            PG8_LDB(B0, 0, 0); PG8_LDB(B1, 0, 1); PG8_SCHED; PG8_LDA(At, 0, 0); PG8_STAGE(PG8_SA(1, 1), a1 + hstep, voffA);
            PG8_WAIT_V(8); PG8_WAIT_L(0); PG8_BAR; PG8_MMA(0, 0, At, B0); PG8_MMA(0, 1, At, B1); PG8_BAR; PG8_SCHED;
            PG8_LDA(At, 0, 1); PG8_STAGE(PG8_SB(0, 0), b2, voffB); PG8_STAGE(PG8_SB(0, 1), b2 + hstep, voffB); PG8_STAGE(PG8_SA(0, 0), a2, voffA);
            PG8_WAIT_V(8); PG8_WAIT_L(0); PG8_BAR; PG8_MMA(1, 0, At, B0); PG8_MMA(1, 1, At, B1); PG8_BAR; PG8_SCHED;
            PG8_LDB(B0, 1, 0); PG8_LDB(B1, 1, 1); PG8_SCHED; PG8_LDA(At, 1, 0); PG8_STAGE(PG8_SA(0, 1), a2 + hstep, voffA);
            PG8_WAIT_V(8); PG8_WAIT_L(0); PG8_BAR; PG8_MMA(0, 0, At, B0); PG8_MMA(0, 1, At, B1); PG8_BAR; PG8_SCHED;
            PG8_LDA(At, 1, 1); PG8_STAGE(PG8_SB(1, 0), b3, voffB); PG8_STAGE(PG8_SB(1, 1), b3 + hstep, voffB); PG8_STAGE(PG8_SA(1, 0), a3, voffA);
            PG8_WAIT_V(8); PG8_WAIT_L(0); PG8_BAR; PG8_MMA(1, 0, At, B0); PG8_MMA(1, 1, At, B1); PG8_BAR; PG8_SCHED;
            } else {
            PG8_LDB(B0, 0, 0); PG8_SCHED; PG8_LDA(At, 0, 0); PG8_STAGE(PG8_SA(1, 1), a1 + hstep, voffA);
            PG8_WAIT_L(8); PG8_BAR; PG8_WAIT_L(0); PG8_MMA(0, 0, At, B0); PG8_BAR; PG8_SCHED;
            PG8_LDB(B1, 0, 1); PG8_STAGE(PG8_SB(0, 0), b2, voffB);
            PG8_BAR; PG8_WAIT_L(0); PG8_MMA(0, 1, At, B1); PG8_BAR;
            PG8_LDA(At, 0, 1); PG8_STAGE(PG8_SA(0, 0), a2, voffA);
            PG8_BAR; PG8_WAIT_L(0); PG8_MMA(1, 0, At, B0); PG8_BAR; PG8_SCHED;
            PG8_STAGE(PG8_SB(0, 1), b2 + hstep, voffB);
            PG8_WAIT_V(6); PG8_BAR; PG8_MMA(1, 1, At, B1); PG8_BAR;
            PG8_LDB(B0, 1, 0); PG8_SCHED; PG8_LDA(At, 1, 0); PG8_STAGE(PG8_SA(0, 1), a2 + hstep, voffA);
            PG8_WAIT_L(8); PG8_BAR; PG8_WAIT_L(0); PG8_MMA(0, 0, At, B0); PG8_BAR; PG8_SCHED;
            PG8_LDB(B1, 1, 1); PG8_STAGE(PG8_SB(1, 0), b3, voffB);
            PG8_BAR; PG8_WAIT_L(0); PG8_MMA(0, 1, At, B1); PG8_BAR;
            PG8_LDA(At, 1, 1); PG8_STAGE(PG8_SA(1, 0), a3, voffA);
            PG8_BAR; PG8_WAIT_L(0); PG8_MMA(1, 0, At, B0); PG8_BAR; PG8_SCHED;
            PG8_STAGE(PG8_SB(1, 1), b3 + hstep, voffB);
            PG8_WAIT_V(6); PG8_BAR; PG8_MMA(1, 1, At, B1); PG8_BAR;
            }
        }
        if constexpr (ALIGN_EPI) { if (wr == 0) PG8_BAR; }
        if constexpr (!Epi::AFTER_DRAIN) { E(acc, cur, wr, wc, fr, fq); S.done(cur); }
        if (!has_next) break;
#pragma unroll
        for (int a = 0; a < 2; ++a)
#pragma unroll
            for (int b = 0; b < 2; ++b)
#pragma unroll
                for (int m = 0; m < 4; ++m)
#pragma unroll
                    for (int n = 0; n < 2; ++n) acc[a][b][m][n] = (f32x4){0.f, 0.f, 0.f, 0.f};
        cur = nxt; cA = nA; cB = nB; ++ui;
        if constexpr (ALIGN_EPI) { if (wr == 1) PG8_BAR; }
    }
    PG8_WAIT_V(0);
    if constexpr (!ALIGN_EPI) { if (wr == 0) PG8_BAR; }
    PG8_BAR;
    if constexpr (Epi::AFTER_DRAIN) { E.fused(acc, cur, wr, wc, fr, fq, lds, wid, lane); S.done(cur); }
#undef PG8_SA
#undef PG8_SB
#undef PG8_STAGE
#undef PG8_LDA
#undef PG8_LDB
#undef PG8_MMA
#undef PG8_WAIT_V
#undef PG8_WAIT_L
#undef PG8_BAR
#undef PG8_SCHED
}
}

constexpr int NWAVES = 8;
constexpr int NB = 8, SEQ = 8192, D = 1024, DEPTH = 2, CCH = 512, CONVW = 31, RH = 4, RD = 128, RW = 512, RC = 128, FF = 4096, PLE = 256, INC = 3072;
constexpr int M = NB * SEQ;
constexpr int ZP = 2560;
constexpr float LN_EPS = 1e-5f;
constexpr size_t MiB = 1u << 20;
constexpr size_t WS_CTL = 0, CTL_ZERO_BYTES = 1 * MiB;
constexpr size_t WS_W = 2 * MiB, W_LAYER = 27 * MiB;
constexpr size_t WO_IN = 0, WO_OUT = 6 * MiB, WO_FF1 = 8 * MiB, WO_FF2 = 16 * MiB, WO_GATE = 24 * MiB, WO_PROJ = 26 * MiB;
constexpr size_t WS_SS = 56 * MiB, SS_SITE = 4 * MiB;
constexpr size_t WS_ROPE = 84 * MiB;
constexpr size_t WS_XB = 100 * MiB;
constexpr size_t WS_PB = 228 * MiB;
constexpr size_t WS_PROJ = 292 * MiB;
constexpr size_t WS_ZB = 420 * MiB;
constexpr size_t WS_T = 740 * MiB;
constexpr size_t WS_MIX = 756 * MiB;
constexpr size_t WS_HID = 420 * MiB;
constexpr size_t WS_END = 932 * MiB;
constexpr size_t WS_U = WS_XB, WS_S = WS_PROJ;
constexpr int CW_TMO = 0, CW_BAR = 4096;
constexpr int LDS_BYTES = 163840, RING_OFF = 0, MISC_OFF = 163840 - 256, ARGS_OFF = 163840 - 512;

#define GAS __attribute__((address_space(1)))
#define LAS __attribute__((address_space(3)))
typedef unsigned short bf16;
typedef unsigned v4u __attribute__((ext_vector_type(4)));
typedef float f32x4 __attribute__((ext_vector_type(4)));
typedef GAS unsigned gu32;
#define RLX_AGENT __ATOMIC_RELAXED, __HIP_MEMORY_SCOPE_AGENT
#define LDS_WAIT() asm volatile("s_waitcnt lgkmcnt(0)" ::: "memory")
__device__ __forceinline__ unsigned f2bf(float f) { unsigned u = __builtin_bit_cast(unsigned, f); return (u + 0x7fffu + ((u >> 16) & 1u)) >> 16; }
__device__ __forceinline__ unsigned pk2(float lo, float hi) { return f2bf(lo) | (f2bf(hi) << 16); }
__device__ __forceinline__ float bf2f(unsigned short b) { return __uint_as_float(((unsigned)b) << 16); }

__device__ __forceinline__ float wave_sum(float v) {
#pragma unroll
    for (int o = 1; o < 64; o <<= 1) v += __shfl_xor(v, o);
    return v;
}
#define XB_TMO      128
#define XB_XCNT(j)  (256  + 64 * (j))
#define XB_XSUB(j)  (1280 + 64 * (j))
#define XB_XGEN(j)  (2304 + 64 * (j))
#define XB_TOP      3328
#define XB_TOPGEN   3392
#define XCD_BAR_WORDS 3456
#define XB_SPIN_CAP (1u << 18)

__device__ __forceinline__ unsigned xb_ld(unsigned* p)              { return __hip_atomic_load(p, __ATOMIC_RELAXED, __HIP_MEMORY_SCOPE_AGENT); }
__device__ __forceinline__ unsigned xb_add(unsigned* p, unsigned v) { return __hip_atomic_fetch_add(p, v, __ATOMIC_RELAXED, __HIP_MEMORY_SCOPE_AGENT); }
__device__ __forceinline__ unsigned xb_xcc_id() { return (unsigned)__builtin_amdgcn_s_getreg((3 << 11) | 20) & 0xFu; }
#define XB_SPIN(cond, bar) do { unsigned _sp = 0; while (cond) { __builtin_amdgcn_s_sleep(1); \
    if ((++_sp & 255u) == 0u) { if (xb_ld(&(bar)[XB_TMO])) break; if (_sp > XB_SPIN_CAP) { atomicAdd(&(bar)[XB_TMO], 1u); break; } } } } while (0)

__device__ __forceinline__ int xb_fresh_lane() { unsigned z = 0u; asm volatile("" : "+v"(z)); return (int)__builtin_amdgcn_mbcnt_hi(~0u, __builtin_amdgcn_mbcnt_lo(~0u, z)); }
struct XcdBarrier {
    unsigned* bar; unsigned x; int wave;
    volatile LAS unsigned* st;
};

__device__ __forceinline__ XcdBarrier xcd_barrier_post(unsigned* bar, volatile LAS unsigned* st, int wave) {
    XcdBarrier b; b.bar = bar; b.x = xb_xcc_id(); b.st = st; b.wave = wave;
    if (wave == 0 && xb_fresh_lane() == 0) (void)xb_add(&bar[XB_XCNT(b.x)], 1u);
    return b;
}
__device__ __forceinline__ void xcd_barrier_complete(unsigned* bar, unsigned x, unsigned& nloc, unsigned& nx) {
    const unsigned G = gridDim.x * gridDim.y * gridDim.z;
    unsigned sum, cnt, mine, sp = 0u;
    for (;;) {
        sum = 0u; cnt = 0u; mine = 0u;
#pragma unroll
        for (unsigned j = 0; j < 16; ++j) { const unsigned c = xb_ld(&bar[XB_XCNT(j)]); sum += c; cnt += (c > 0u) ? 1u : 0u; mine = (j == x) ? c : mine; }
        if (sum == G) break;
        __builtin_amdgcn_s_sleep(1);
        if ((++sp & 255u) == 0u) { if (xb_ld(&bar[XB_TMO])) break; if (sp > XB_SPIN_CAP) { atomicAdd(&bar[XB_TMO], 1u); break; } }
    }
    nloc = mine > 0u ? mine : 1u; nx = cnt > 0u ? cnt : 1u;
}

__device__ __forceinline__ void xcd_barrier(const XcdBarrier& b) {
    asm volatile("s_waitcnt vmcnt(0)" ::: "memory");
    __syncthreads();
    if (b.wave == 0 && xb_fresh_lane() == 0) {
        unsigned* bar = b.bar;
        __builtin_amdgcn_s_waitcnt(0);
        unsigned nloc = b.st[0], nx = b.st[1];
        if (nloc == 0u) { xcd_barrier_complete(bar, b.x, nloc, nx); b.st[0] = nloc; b.st[1] = nx; }
        const unsigned old = xb_add(&bar[XB_XSUB(b.x)], 1u);
        const unsigned gen = old / nloc;
        if (old + 1u == (gen + 1u) * nloc) {
            __builtin_amdgcn_fence(__ATOMIC_RELEASE, "agent");
            asm volatile("s_waitcnt vmcnt(0)" ::: "memory");
            const unsigned og = xb_add(&bar[XB_TOP], 1u);
            const unsigned tg = og / nx;
            if (og + 1u == (tg + 1u) * nx) xb_add(&bar[XB_TOPGEN], 1u);
            else XB_SPIN(xb_ld(&bar[XB_TOPGEN]) == tg, bar);
            __builtin_amdgcn_fence(__ATOMIC_ACQUIRE, "agent");
            xb_add(&bar[XB_XGEN(b.x)], 1u);
            asm volatile("s_waitcnt vmcnt(0)" ::: "memory");
        } else {
            XB_SPIN(xb_ld(&bar[XB_XGEN(b.x)]) == gen, bar);
            __builtin_amdgcn_fence(__ATOMIC_ACQUIRE, "agent");
            asm volatile("s_waitcnt vmcnt(0)" ::: "memory");
        }
    }
    __syncthreads();
}

namespace mx {
typedef short s16x4 __attribute__((ext_vector_type(4)));
typedef short v4i16_t __attribute__((ext_vector_type(4)));
typedef short bf16x8 __attribute__((ext_vector_type(8)));
typedef float f32x2 __attribute__((ext_vector_type(2)));
typedef unsigned u32x2 __attribute__((ext_vector_type(2)));
constexpr int KI = 0, VI = 32768, QI = 65536, SI = 98304;

__device__ __forceinline__ unsigned off_a(unsigned row, unsigned ch) { return 2048u * (row >> 3) + 512u * (ch >> 2) + 64u * (row & 7u) + 16u * ((ch & 3u) ^ ((row >> 2) & 3u)); }
struct LaneAddr { unsigned tr[2][2], row, kap[2]; };
__device__ __forceinline__ void lane_addr(LaneAddr& A, unsigned lane) {
    const unsigned g = lane >> 4, li = lane & 15u, q = li >> 2, p = lane & 3u;
#pragma unroll
    for (unsigned cp = 0; cp < 2; ++cp)
#pragma unroll
        for (unsigned t = 0; t < 2; ++t) A.tr[cp][t] = 2048u * g + 64u * q + 32u * (cp ^ (g & 1u)) + 16u * ((p >> 1) ^ t) + 8u * (p & 1u);
    A.row = 2048u * (li >> 3) + 64u * (li & 7u) + 16u * (g ^ ((li >> 2) & 3u));
#pragma unroll
    for (unsigned t = 0; t < 2; ++t) A.kap[t] = 2048u * (li >> 2) + 64u * (li & 3u) + 16u * ((g ^ (2u * ((li >> 2) & 1u))) ^ t);
}
__device__ __forceinline__ bf16x8 tr_frag(LAS const unsigned char* img, const LaneAddr& A, int c, int ks) {
    const s16x4 lo = __builtin_bit_cast(s16x4, __builtin_amdgcn_ds_read_tr16_b64_v4i16((LAS v4i16_t*)(img + A.tr[c & 1][0] + (8192 * ks + 512 * (c >> 1)))));
    const s16x4 hi = __builtin_bit_cast(s16x4, __builtin_amdgcn_ds_read_tr16_b64_v4i16((LAS v4i16_t*)(img + A.tr[c & 1][1] + (8192 * ks + 512 * (c >> 1) + 256))));
    return __builtin_shufflevector(lo, hi, 0, 1, 2, 3, 4, 5, 6, 7);
}
__device__ __forceinline__ bf16x8 row_frag(LAS const unsigned char* img, const LaneAddr& A, int rb, int s) { return *(LAS const bf16x8*)(img + A.row + (4096 * rb + 512 * s)); }
__device__ __forceinline__ bf16x8 kap_frag(LAS const unsigned char* img, const LaneAddr& A, int kp, int t, int ks) { return *(LAS const bf16x8*)(img + A.kap[t] + (8192 * kp + 512 * ks + 256 * t)); }
__device__ __forceinline__ float gamma_log(int h) { return logf(1.0f - exp2f(-5.0f - (float)h)); }
__device__ __forceinline__ float to_sgpr(float v) { return __builtin_bit_cast(float, __builtin_amdgcn_readfirstlane(__builtin_bit_cast(int, v))); }
__device__ __forceinline__ int opaque_s(int v) { asm volatile("" : "+s"(v)); return v; }

__device__ __forceinline__ void tile_load(v4u (&v)[4], const bf16* src, int tid) {
    const GAS v4u* g = (const GAS v4u*)(src + (size_t)(tid >> 2) * ZP + (tid & 3) * 32);
#pragma unroll
    for (int c = 0; c < 4; ++c) v[c] = g[c];
}
template <bool SCALE> __device__ __forceinline__ void tile_store(LAS unsigned char* img, const v4u (&v)[4], float rowscale, int tid) {
    const unsigned row = (unsigned)tid >> 2, sb = 2048u * (row >> 3) + 512u * ((unsigned)tid & 3u) + 64u * (row & 7u), r2 = (row >> 2) & 3u;
#pragma unroll
    for (int c = 0; c < 4; ++c) {
        v4u o = v[c];
        if (SCALE) {
            const unsigned w[4] = {o.x, o.y, o.z, o.w}; unsigned r[4];
#pragma unroll
            for (int i = 0; i < 4; ++i) r[i] = pg8::cvt_pk_bf16(__uint_as_float(w[i] << 16) * rowscale, __uint_as_float(w[i] & 0xffff0000u) * rowscale);
            o.x = r[0]; o.y = r[1]; o.z = r[2]; o.w = r[3];
        }
        *(LAS v4u*)(img + sb + 16u * ((unsigned)c ^ r2)) = o;
    }
}
#define MX_MFMA(a, b, c) __builtin_amdgcn_mfma_f32_16x16x32_bf16((a), (b), (c), 0, 0, 0)

__device__ __forceinline__ void conv_phase(LAS unsigned char* L, const bf16* ZB, bf16* MIXB, const float* dw_w, const float* dw_b, const float* ln_g, const float* ln_b, int bx, int wave) {
    const int lane0 = xb_fresh_lane(), cp0 = (wave * 64 + lane0) & 255, half = wave >> 2;
    f32x2 w2[CONVW];
#pragma unroll
    for (int j = 0; j < CONVW; ++j) w2[j] = *(const GAS f32x2*)(dw_w + j * CCH + 2 * cp0);
    const f32x2 b2 = *(const GAS f32x2*)(dw_b + 2 * cp0);
    LAS float* CT = (LAS float*)L;
    for (int tile = 0; tile < 4; ++tile) {
        int lane = lane0; asm volatile("" : "+v"(lane));
        const int cp = (wave * 64 + lane) & 255;
        const int mt = bx * 256 + tile * 64, t0 = (mt % SEQ) + 32 * half;
        const bf16* src = ZB + ((long)(mt + 32 * half) - (CONVW - 1)) * ZP + 2 * cp;
        f32x2 acc[32];
#pragma unroll
        for (int t = 0; t < 32; ++t) acc[t] = b2;
#pragma unroll
        for (int r = 0; r < 32 + CONVW - 1; ++r) {
            unsigned u = 0u; if (t0 - (CONVW - 1) + r >= 0) u = *(const GAS unsigned*)(src + (long)r * ZP);
            const f32x2 h2 = {__uint_as_float(u << 16), __uint_as_float(u & 0xffff0000u)};
#pragma unroll
            for (int t = (r - (CONVW - 1) > 0 ? r - (CONVW - 1) : 0); t <= (r < 31 ? r : 31); ++t) acc[t] = w2[r - t] * h2 + acc[t];
        }
#pragma unroll
        for (int t = 0; t < 32; ++t) *(LAS f32x2*)(CT + (32 * half + t) * CCH + 2 * cp) = acc[t];
        __syncthreads();
        {
            const f32x4 g0 = *(const GAS f32x4*)(ln_g + 8 * lane), g1 = *(const GAS f32x4*)(ln_g + 8 * lane + 4), be0 = *(const GAS f32x4*)(ln_b + 8 * lane), be1 = *(const GAS f32x4*)(ln_b + 8 * lane + 4);
#pragma unroll 2
            for (int i = 0; i < 8; ++i) {
                const int tok = 8 * wave + i;
                f32x4 v0 = *(LAS f32x4*)(CT + tok * CCH + 8 * lane), v1 = *(LAS f32x4*)(CT + tok * CCH + 8 * lane + 4);
                const float mean = wave_sum((v0[0] + v0[1]) + (v0[2] + v0[3]) + (v1[0] + v1[1]) + (v1[2] + v1[3])) * (1.0f / CCH);
                v0 = v0 - mean; v1 = v1 - mean;
                const float rstd = rsqrtf(wave_sum((v0[0] * v0[0] + v0[1] * v0[1]) + (v0[2] * v0[2] + v0[3] * v0[3]) + (v1[0] * v1[0] + v1[1] * v1[1]) + (v1[2] * v1[2] + v1[3] * v1[3])) * (1.0f / CCH) + LN_EPS);
                v0 = v0 * rstd * g0 + be0; v1 = v1 * rstd * g1 + be1;
                v0 = v0 * pg8::sig4(v0); v1 = v1 * pg8::sig4(v1);
                *(GAS v4u*)(MIXB + (size_t)(mt + tok) * D + 8 * lane) = pg8::pack8(v0, v1);
            }
        }
        __syncthreads();
    }
}

__device__ __forceinline__ void state_mfma(f32x4 (&sacc)[8], LAS const unsigned char* Kimg, LAS const unsigned char* Vimg, const LaneAddr& A, int wave) {
    LAS const unsigned char* Kw = Kimg + 512 * (wave >> 1);
#pragma unroll
    for (int kp = 0; kp < 4; ++kp) {
        const bf16x8 kf = (wave & 1) ? tr_frag(Kw, A, 1, kp) : tr_frag(Kw, A, 0, kp);
#pragma unroll
        for (int eb = 0; eb < 8; ++eb) { const bf16x8 vf = tr_frag(Vimg, A, eb, kp); sacc[eb] = MX_MFMA(kf, vf, sacc[eb]); }
    }
}
__device__ __forceinline__ void ret_state_phase(LAS unsigned char* L, const bf16* ZB, float* Tf, int bx, int wave) {
    const int lane0 = xb_fresh_lane(), bh = bx >> 3, cg = bx & 7, b = bh >> 2, h = opaque_s(bh & 3);
    const float lg = to_sgpr(gamma_log(h)), kscale = expf(-(float)((wave * 64 + lane0) >> 2) * lg), g1 = to_sgpr(expf(lg)), g127 = to_sgpr(expf(127.0f * lg));
    f32x4 sacc[8];
#pragma unroll
    for (int eb = 0; eb < 8; ++eb) sacc[eb] = (f32x4){0.f, 0.f, 0.f, 0.f};
    v4u kr[4], vr[4];
    { const size_t m0 = (size_t)b * SEQ + (size_t)(cg * 8) * RC; const int tid0 = wave * 64 + lane0; tile_load(kr, ZB + m0 * ZP + 1024 + h * RD, tid0); tile_load(vr, ZB + m0 * ZP + 1536 + h * RD, tid0); }
    for (int j = 0; j < 8; ++j) {
        int lane = lane0; asm volatile("" : "+v"(lane));
        const int tid = wave * 64 + lane;
        tile_store<true>(L + KI, kr, kscale, tid); tile_store<false>(L + VI, vr, 1.0f, tid);
        __syncthreads();
        if (j < 7) { const size_t m1 = (size_t)b * SEQ + (size_t)(cg * 8 + j + 1) * RC; tile_load(kr, ZB + m1 * ZP + 1024 + h * RD, tid); tile_load(vr, ZB + m1 * ZP + 1536 + h * RD, tid); }
#pragma unroll
        for (int eb = 0; eb < 8; ++eb) sacc[eb] = sacc[eb] * g1;
        LaneAddr A; lane_addr(A, (unsigned)lane);
        state_mfma(sacc, L + KI, L + VI, A, wave);
#pragma unroll
        for (int eb = 0; eb < 8; ++eb) sacc[eb] = sacc[eb] * g127;
        __syncthreads();
    }
    GAS f32x4* dst = (GAS f32x4*)Tf + (size_t)(bx * 8 + wave) * 8 * 64 + lane0;
#pragma unroll
    for (int eb = 0; eb < 8; ++eb) dst[eb * 64] = sacc[eb];
}
template <int ABL> __device__ __forceinline__ void ret_out_phase(LAS unsigned char* L, const bf16* ZB, bf16* MIXB, const float* Tf, const float* gn_g, const float* gn_b, int bx, int wave) {
    const int lane0 = xb_fresh_lane(), bh = bx >> 3, cg = bx & 7, b = bh >> 2, h = opaque_s(bh & 3);
    const float lg = to_sgpr(gamma_log(h)), kscale = expf(-(float)((wave * 64 + lane0) >> 2) * lg), qscale = expf((float)((wave * 64 + lane0) >> 2) * lg), g1 = to_sgpr(expf(lg)), g127 = to_sgpr(expf(127.0f * lg)), cd8 = to_sgpr(expf(1024.0f * lg));
    f32x4 sacc[8];
#pragma unroll
    for (int eb = 0; eb < 8; ++eb) sacc[eb] = (f32x4){0.f, 0.f, 0.f, 0.f};
    { float coef = 1.0f;
      for (int g2 = cg - 1; g2 >= 0; --g2) { const GAS f32x4* src = (const GAS f32x4*)Tf + (size_t)((bh * 8 + g2) * 8 + wave) * 8 * 64 + lane0;
#pragma unroll
          for (int eb = 0; eb < 8; ++eb) sacc[eb] = sacc[eb] + src[eb * 64] * coef;
          coef *= cd8; } }
    v4u kr[4], vr[4], qr[4];
    { const size_t m0 = (size_t)b * SEQ + (size_t)(cg * 8) * RC; const int tid0 = wave * 64 + lane0;
      if (!(ABL & 1)) { tile_load(kr, ZB + m0 * ZP + 1024 + h * RD, tid0); tile_load(vr, ZB + m0 * ZP + 1536 + h * RD, tid0); tile_load(qr, ZB + m0 * ZP + 512 + h * RD, tid0); }
      else { for (int c = 0; c < 4; ++c) { kr[c] = (v4u){0u, 0u, 0u, 0u}; vr[c] = kr[c]; qr[c] = kr[c]; } } }
    for (int j = 0; j < 8; ++j) {
        int lane = lane0; asm volatile("" : "+v"(lane));
        const int tid = wave * 64 + lane, g = lane >> 4, li = lane & 15;
        const size_t m0 = (size_t)b * SEQ + (size_t)(cg * 8 + j) * RC;
        if (!(ABL & 2)) { tile_store<true>(L + KI, kr, kscale, tid); tile_store<false>(L + VI, vr, 1.0f, tid); tile_store<true>(L + QI, qr, qscale, tid); }
        LaneAddr A; lane_addr(A, (unsigned)lane);
        { const unsigned stb = 2048u * ((unsigned)li >> 3) + 512u * ((unsigned)wave >> 1) + 64u * ((unsigned)li & 7u) + 16u * ((2u * ((unsigned)wave & 1u) + ((unsigned)g >> 1)) ^ (((unsigned)li >> 2) & 3u)) + 8u * ((unsigned)g & 1u);
#pragma unroll
          for (int eb = 0; eb < 8; ++eb) { const f32x4 sv = sacc[eb] * g1; u32x2 w; w.x = pg8::cvt_pk_bf16(sv[0], sv[1]); w.y = pg8::cvt_pk_bf16(sv[2], sv[3]);
              *(LAS u32x2*)(L + SI + stb + 4096 * eb) = w; } }
        __syncthreads();
        if (j < 7 && !(ABL & 1)) { const size_t m1 = m0 + RC; tile_load(kr, ZB + m1 * ZP + 1024 + h * RD, tid); tile_load(vr, ZB + m1 * ZP + 1536 + h * RD, tid); tile_load(qr, ZB + m1 * ZP + 512 + h * RD, tid); }
        const size_t mrow = m0 + 16 * wave + li;
        u32x2 gw[8];
#pragma unroll
        for (int eb = 0; eb < 8; ++eb) gw[eb] = (ABL & 1) ? (u32x2){0u, 0u} : *(const GAS u32x2*)(ZB + mrow * ZP + 2048 + h * RD + 16 * eb + 4 * g);
        f32x4 o[8];
#pragma unroll
        for (int eb = 0; eb < 8; ++eb) o[eb] = (f32x4){0.f, 0.f, 0.f, 0.f};
        if (!(ABL & 4)) {
        bf16x8 qf[4];
#pragma unroll
        for (int ks = 0; ks < 4; ++ks) qf[ks] = row_frag(L + QI + 4096 * wave, A, 0, ks);
        bf16x8 pf[4];
#pragma unroll
        for (int kp = 0; kp < 4; ++kp) {
            unsigned pw[4] = {0u, 0u, 0u, 0u};
            if (kp <= (wave >> 1)) {
#pragma unroll
                for (int t = 0; t < 2; ++t) {
                    f32x4 x = (f32x4){0.f, 0.f, 0.f, 0.f};
#pragma unroll
                    for (int ks = 0; ks < 4; ++ks) x = MX_MFMA(kap_frag(L + KI, A, kp, t, ks), qf[ks], x);
                    { const int key0 = 32 * kp + 8 * g + 4 * t, ql = 16 * wave + li;
#pragma unroll
                        for (int r = 0; r < 4; ++r) x[r] = (key0 + r <= ql) ? x[r] : 0.f; }
                    pw[2 * t] = pg8::cvt_pk_bf16(x[0], x[1]); pw[2 * t + 1] = pg8::cvt_pk_bf16(x[2], x[3]);
                }
            }
            pf[kp] = __builtin_bit_cast(bf16x8, (v4u){pw[0], pw[1], pw[2], pw[3]});
        }
#pragma unroll
        for (int eb = 0; eb < 8; ++eb) {
#pragma unroll
            for (int ks = 0; ks < 4; ++ks) o[eb] = MX_MFMA(row_frag(L + SI, A, eb, ks), qf[ks], o[eb]);
            }
#pragma unroll
        for (int eb = 0; eb < 8; ++eb) sacc[eb] = sacc[eb] * g1;
#pragma unroll
        for (int kp = 0; kp < 4; ++kp) {
            const bf16x8 kf = (wave & 1) ? tr_frag(L + KI + 512 * (wave >> 1), A, 1, kp) : tr_frag(L + KI + 512 * (wave >> 1), A, 0, kp);
#pragma unroll
            for (int eb = 0; eb < 8; ++eb) { const bf16x8 vf = tr_frag(L + VI, A, eb, kp);
                o[eb] = MX_MFMA(vf, pf[kp], o[eb]);
                sacc[eb] = MX_MFMA(kf, vf, sacc[eb]); }
        }
#pragma unroll
        for (int eb = 0; eb < 8; ++eb) sacc[eb] = sacc[eb] * g127;
        }
        if (!(ABL & 8)) {
        float s1 = 0.f;
#pragma unroll
        for (int eb = 0; eb < 8; ++eb) s1 += (o[eb][0] + o[eb][1]) + (o[eb][2] + o[eb][3]);
        s1 += __shfl_xor(s1, 16); s1 += __shfl_xor(s1, 32);
        const float mean = s1 * (1.0f / RD); float s2 = 0.f;
#pragma unroll
        for (int eb = 0; eb < 8; ++eb) { o[eb] = o[eb] - mean; s2 += (o[eb][0] * o[eb][0] + o[eb][1] * o[eb][1]) + (o[eb][2] * o[eb][2] + o[eb][3] * o[eb][3]); }
        s2 += __shfl_xor(s2, 16); s2 += __shfl_xor(s2, 32);
        const float rstd = rsqrtf(s2 * (1.0f / RD) + LN_EPS);
#pragma unroll
        for (int eb = 0; eb < 8; ++eb) { const int e0 = h * RD + 16 * eb + 4 * g;
            const f32x4 gg = *(const GAS f32x4*)(gn_g + e0), gb = *(const GAS f32x4*)(gn_b + e0);
            const f32x4 gt = (f32x4){__uint_as_float(gw[eb].x << 16), __uint_as_float(gw[eb].x & 0xffff0000u), __uint_as_float(gw[eb].y << 16), __uint_as_float(gw[eb].y & 0xffff0000u)};
            const f32x4 y = (o[eb] * rstd * gg + gb) * (gt * pg8::sig4(gt));
            u32x2 w; w.x = pg8::cvt_pk_bf16(y[0], y[1]); w.y = pg8::cvt_pk_bf16(y[2], y[3]);
            *(GAS u32x2*)(MIXB + mrow * D + CCH + e0) = w; }
        }
        __syncthreads();
    }
}
#undef MX_MFMA
}

struct Args {
    const float* x; const float* p; const int* pos; const float* norm_mix_g; const float* w_in; const float* dw_w; const float* dw_b; const float* ln_g; const float* ln_b;
    const float* gn_g; const float* gn_b; const float* w_out; const float* norm_ffn_g; const float* w_ff1; const float* w_ff2; const float* norm_ple_g; const float* w_gate; const float* w_proj;
    const float* final_g; float* out; unsigned char* ws; int ph_lo, ph_hi, li, pad;
};
__device__ __forceinline__ int inmap(int s) {
    if (s < 512) return 256 * (s >> 7) + (s & 127);
    if (s < 1024) { const int ch = s - 512; return 256 * (ch >> 7) + 128 + (ch & 127); }
    if (s < 2048) { const int k = s >= 1536, r = s - (k ? 1536 : 1024), hq = r >> 7, dd = r & 127; return 256 * ((k ? 6 : 4) + (hq >> 1)) + 128 * (dd >> 6) + 64 * (hq & 1) + (dd & 63); }
    return s;
}
template <bool INMAP> __device__ __forceinline__ void tr_item(const float* W, int K, int N, const float* gain, bf16* WT, LAS float* scr, int item, int lane) {
    const int nblk = N / 32, kb = item / nblk, nb = item % nblk, k0 = 64 * kb, n0 = 32 * nb;
#pragma unroll 8
    for (int i = 0; i < 32; ++i) { const int kk = 2 * i + (lane >> 5); scr[kk * 33 + (lane & 31)] = W[(size_t)(k0 + kk) * N + n0 + (lane & 31)] * (gain ? gain[k0 + kk] : 1.0f); }
    LDS_WAIT(); asm volatile("" ::: "memory");
    const int c = lane & 7;
#pragma unroll
    for (int j = 0; j < 4; ++j) { const int n = (lane >> 3) + 8 * j; const LAS float* s = scr + (8 * c) * 33 + n;
        const int src = n0 + n; const int r = INMAP ? inmap(src) : src; const float cs = (INMAP && src >= 1536 && src < 2048) ? 0.088388347648318447f : 1.0f;
        v4u o; o.x = pk2(s[0 * 33] * cs, s[1 * 33] * cs); o.y = pk2(s[2 * 33] * cs, s[3 * 33] * cs); o.z = pk2(s[4 * 33] * cs, s[5 * 33] * cs); o.w = pk2(s[6 * 33] * cs, s[7 * 33] * cs);
        *(GAS v4u*)(WT + (size_t)r * K + k0 + 8 * c) = o; }
    LDS_WAIT(); asm volatile("" ::: "memory");
}

__device__ __forceinline__ const void* lds_ptr(LAS unsigned char* p) {
    const unsigned lo = __builtin_amdgcn_readfirstlane(((volatile LAS unsigned*)p)[0]), hi = __builtin_amdgcn_readfirstlane(((volatile LAS unsigned*)p)[1]);
    return (const void*)(((unsigned long long)hi << 32) | lo);
}
#ifndef PROBE_DUP
#define PROBE_DUP (-1)
#endif
#ifndef PROBE_ABL
#define PROBE_ABL 0
#endif
#define DUPN(k) ((PROBE_DUP == (k)) ? 2 : 1)
__global__ void __launch_bounds__(NWAVES * 64, 2) mk_fwd(Args a) {
    extern __shared__ __attribute__((aligned(16))) unsigned char lds[];
    LAS unsigned char* const L = (LAS unsigned char*)lds;
    volatile LAS unsigned* MISC = (volatile LAS unsigned*)(L + MISC_OFF);
    const int wave = __builtin_amdgcn_readfirstlane(threadIdx.x >> 6);
#define LANE_ID() xb_fresh_lane()
    const int G = gridDim.x, bx = blockIdx.x;
    unsigned char* ws = a.ws;
    gu32* ctl = (gu32*)(ws + WS_CTL);
    if (threadIdx.x < 64) MISC[threadIdx.x] = 0u;
    if (threadIdx.x < sizeof(Args) / 4) ((volatile LAS unsigned*)(L + ARGS_OFF))[threadIdx.x] = ((const unsigned*)&a)[threadIdx.x];
    __syncthreads();
#define ARGP(field) ((decltype(a.field))lds_ptr(L + ARGS_OFF + offsetof(Args, field)))
    XcdBarrier bar = xcd_barrier_post((unsigned*)(ctl + CW_BAR) + a.li * XCD_BAR_WORDS, MISC + 8, wave);
    const int lo = a.ph_lo, hi = a.ph_hi;
#define IN(k) (lo <= (k) && (k) < hi)
#define SEAM(k) do { if (IN(k) && IN((k) + 1)) xcd_barrier(bar); } while (0)
    const int gw = bx * NWAVES + wave, NGW = G * NWAVES;
    const size_t NGT = (size_t)G * NWAVES * 64;
    bf16* const XB = (bf16*)(ws + WS_XB); bf16* const ZB = (bf16*)(ws + WS_ZB); bf16* const MIXB = (bf16*)(ws + WS_MIX); bf16* const HID = (bf16*)(ws + WS_HID);
    bf16* const XO = (bf16*)a.out;
    float* const TF = (float*)(ws + WS_T);
    bf16* const PROJ = (bf16*)(ws + WS_PROJ); bf16* const PB = (bf16*)(ws + WS_PB); unsigned* const ROPE = (unsigned*)(ws + WS_ROPE);

    if (IN(0))
#pragma clang loop unroll(full)
    for (int rep = 0; rep < DUPN(0); ++rep) {
        const int lane = LANE_ID(); const size_t gt = (size_t)bx * (NWAVES * 64) + wave * 64 + lane;
        LAS float* scr = (LAS float*)(L + RING_OFF + wave * 16384);
        constexpr int I_IN = (D / 64) * (INC / 32), I_OUT = (D / 64) * (D / 32), I_F1 = (D / 64) * (FF / 32), I_F2 = (FF / 64) * (D / 32), I_G = I_OUT, I_P = (PLE / 64) * (D / 32);
        constexpr int I_LAYER = I_IN + I_OUT + I_F1 + I_F2 + I_G + I_P;
        for (int it = gw; it < DEPTH * I_LAYER; it += NGW) {
            const int l = it / I_LAYER; int r = it % I_LAYER; unsigned char* wl = ws + WS_W + (size_t)l * W_LAYER;
            if (r < I_IN) { tr_item<true>(a.w_in + (size_t)l * D * INC, D, INC, a.norm_mix_g + l * D, (bf16*)(wl + WO_IN), scr, r, lane); continue; } r -= I_IN;
            if (r < I_OUT) { tr_item<false>(a.w_out + (size_t)l * D * D, D, D, nullptr, (bf16*)(wl + WO_OUT), scr, r, lane); continue; } r -= I_OUT;
            if (r < I_F1) { tr_item<false>(a.w_ff1 + (size_t)l * D * FF, D, FF, a.norm_ffn_g + l * D, (bf16*)(wl + WO_FF1), scr, r, lane); continue; } r -= I_F1;
            if (r < I_F2) { tr_item<false>(a.w_ff2 + (size_t)l * FF * D, FF, D, nullptr, (bf16*)(wl + WO_FF2), scr, r, lane); continue; } r -= I_F2;
            if (r < I_G) { tr_item<false>(a.w_gate + (size_t)l * D * D, D, D, a.norm_ple_g + l * D, (bf16*)(wl + WO_GATE), scr, r, lane); continue; } r -= I_G;
            tr_item<false>(a.w_proj + (size_t)l * PLE * D, PLE, D, nullptr, (bf16*)(wl + WO_PROJ), scr, r, lane);
        }
        float* ss0 = (float*)(ws + WS_SS);
        for (int m = gw; m < M; m += NGW) {
            const GAS f32x4* xr = (const GAS f32x4*)(a.x + (size_t)m * D) + lane; f32x4 v[4]; float s = 0.f;
#pragma unroll
            for (int j = 0; j < 4; ++j) { v[j] = xr[64 * j]; s += (v[j].x * v[j].x + v[j].y * v[j].y) + (v[j].z * v[j].z + v[j].w * v[j].w); }
            s = wave_sum(s);
            GAS unsigned long long* o8 = (GAS unsigned long long*)(XB + (size_t)m * D) + lane;
#pragma unroll
            for (int j = 0; j < 4; ++j) o8[64 * j] = (unsigned long long)pk2(v[j].x, v[j].y) | ((unsigned long long)pk2(v[j].z, v[j].w) << 32);
            if (lane < 16) ss0[(size_t)m * 16 + lane] = lane == 0 ? s : 0.f;
        }
        for (size_t i = gt; i < (size_t)DEPTH * M * PLE / 8; i += NGT) {
            const f32x4 p0 = *(const GAS f32x4*)(a.p + i * 8), p1 = *(const GAS f32x4*)(a.p + i * 8 + 4);
            v4u o; o.x = pk2(p0.x, p0.y); o.y = pk2(p0.z, p0.w); o.z = pk2(p1.x, p1.y); o.w = pk2(p1.z, p1.w);
            *(GAS v4u*)(PB + i * 8) = o;
        }
        for (size_t i = gt; i < (size_t)M * 64; i += NGT) {
            const int d = (int)(i & 63); const size_t m = i >> 6;
            const float inv_freq = 1.0f / powf(10000.0f, (float)d * (2.0f / RD)), ang = (float)a.pos[m] * inv_freq;
            const pg8::f16x2 cs = {(_Float16)cosf(ang), (_Float16)sinf(ang)};
            ROPE[i] = __builtin_bit_cast(unsigned, cs);
        }
    }
    SEAM(0);
#pragma clang loop unroll(full)
    for (int l = 0; l < DEPTH; ++l) {
        const int pb = 1 + 8 * l;
        bf16* const XC = (l & 1) ? XO : XB; bf16* const XN = (l & 1) ? XB : XO;
        unsigned char* wl = ws + WS_W + (size_t)l * W_LAYER;
        float* const ss_a = (float*)(ws + WS_SS + (size_t)(3 * l + 0) * SS_SITE);
        float* const ss_b = (float*)(ws + WS_SS + (size_t)(3 * l + 1) * SS_SITE);
        float* const ss_c = (float*)(ws + WS_SS + (size_t)(3 * l + 2) * SS_SITE);
        float* const ss_d = (float*)(ws + WS_SS + (size_t)(3 * l + 3) * SS_SITE);
        if (IN(pb + 0))
#pragma clang loop unroll(full)
        for (int rep = 0; rep < DUPN(pb + 0); ++rep) {
            pg8::Gemm g{XC, (const bf16*)(wl + WO_IN), M, INC, D}; pg8::StaticOrder S; S.init(M, INC, G, bx);
            pg8::EpiInProj E{ZB, ss_a, ROPE};
            pg8::gemm_phase<pg8::EpiInProj, pg8::StaticOrder, true, true>(L + RING_OFF, g, S, E, wave);
        }
        SEAM(pb + 0);
        if (IN(pb + 1))
#pragma clang loop unroll(full)
        for (int rep = 0; rep < DUPN(pb + 1); ++rep) {
            if (!(DUPN(pb + 1) == 2 && rep == 0 && (PROBE_ABL & 1))) mx::conv_phase(L, ZB, MIXB, ARGP(dw_w) + l * CONVW * CCH, ARGP(dw_b) + l * CCH, ARGP(ln_g) + l * CCH, ARGP(ln_b) + l * CCH, bx, wave);
            if (!(DUPN(pb + 1) == 2 && rep == 0 && (PROBE_ABL & 2))) mx::ret_state_phase(L, ZB, TF, bx, wave);
        }
        SEAM(pb + 1);
        if (IN(pb + 2))
#pragma clang loop unroll(full)
        for (int rep = 0; rep < DUPN(pb + 2); ++rep) {
            if (DUPN(pb + 2) == 2 && rep == 0) mx::ret_out_phase<PROBE_ABL>(L, ZB, MIXB, TF, ARGP(gn_g) + l * RW, ARGP(gn_b) + l * RW, bx, wave);
            else mx::ret_out_phase<0>(L, ZB, MIXB, TF, ARGP(gn_g) + l * RW, ARGP(gn_b) + l * RW, bx, wave);
        }
        SEAM(pb + 2);
        if (IN(pb + 3))
#pragma clang loop unroll(full)
        for (int rep = 0; rep < 1; ++rep) {
            pg8::Gemm g{MIXB, (const bf16*)(wl + WO_OUT), M, D, D}; pg8::StaticOrder S; S.init(M, D, G, bx);
            pg8::EpiResid<0> E{XC, XC, ss_b, nullptr, nullptr};
            pg8::gemm_phase<pg8::EpiResid<0>, pg8::StaticOrder, true, true>(L + RING_OFF, g, S, E, wave);
        }
        SEAM(pb + 3);
        if (IN(pb + 4))
#pragma clang loop unroll(full)
        for (int rep = 0; rep < DUPN(pb + 4); ++rep) {
            pg8::Gemm g{XC, (const bf16*)(wl + WO_FF1), M, FF, D}; pg8::StaticOrder S; S.init(M, FF, G, bx);
            pg8::EpiFF1 E{HID, ss_b};
            pg8::gemm_phase<pg8::EpiFF1, pg8::StaticOrder, true, true>(L + RING_OFF, g, S, E, wave);
        }
        SEAM(pb + 4);
        if (IN(pb + 5)) {
            pg8::Gemm g{HID, (const bf16*)(wl + WO_FF2), M, D, FF}; pg8::StaticOrder S; S.init(M, D, G, bx);
            pg8::EpiResid<0> E{XC, XC, ss_c, nullptr, nullptr};
            pg8::gemm_phase<pg8::EpiResid<0>, pg8::StaticOrder, true, true>(L + RING_OFF, g, S, E, wave);
        }
        SEAM(pb + 5);
        if (IN(pb + 6))
#pragma clang loop unroll(full)
        for (int rep = 0; rep < DUPN(pb + 6); ++rep) {
            pg8::Gemm g{PB + (size_t)l * M * PLE, (const bf16*)(wl + WO_PROJ), M, D, PLE}; pg8::StaticOrder S; S.init(M, D, G, bx);
            pg8::EpiPlain E{PROJ};
            pg8::gemm_phase<pg8::EpiPlain, pg8::StaticOrder, true, true>(L + RING_OFF, g, S, E, wave);
        }
        SEAM(pb + 6);
        if (IN(pb + 7)) {
            pg8::Gemm g{XC, (const bf16*)(wl + WO_GATE), M, D, D}; pg8::StaticOrder S; S.init(M, D, G, bx);
            pg8::EpiResid<1> E{XC, XN, ss_d, ss_c, PROJ};
            pg8::gemm_phase<pg8::EpiResid<1>, pg8::StaticOrder, true, true>(L + RING_OFF, g, S, E, wave);
        }
        SEAM(pb + 7);
    }
    if (IN(17)) {
        const int lane = LANE_ID();
        const float* ssf = (const float*)(ws + WS_SS + (size_t)6 * SS_SITE);
        const bf16* XF = (DEPTH & 1) ? XO : XB;
        const GAS f32x4* gr = (const GAS f32x4*)ARGP(final_g) + 2 * lane; const f32x4 g0 = gr[0], g1 = gr[1], g2 = gr[128], g3 = gr[129];
        for (int m = gw; m < M; m += NGW) {
            const float rs = pg8::rstd_of(ssf, m);
            const GAS v4u* xr = (const GAS v4u*)(XF + (size_t)m * D) + lane; GAS f32x4* orow = (GAS f32x4*)(a.out + (size_t)m * D) + 2 * lane;
            f32x4 a0, a1, b0, b1; pg8::unpack8(xr[0], a0, a1); pg8::unpack8(xr[64], b0, b1);
            orow[0] = a0 * rs * g0; orow[1] = a1 * rs * g1; orow[128] = b0 * rs * g2; orow[129] = b1 * rs * g3;
        }
    }
#undef IN
#undef SEAM
}

extern "C" void kernel_launch(void* const* d_in, const int* in_sizes, int n_in, void* d_out, int out_size, void* d_ws, size_t ws_size, hipStream_t stream) {
    static int grid = 0;
    if (grid == 0) {
        if (n_in != 19 || out_size != M * D || ws_size < WS_END) { fprintf(stderr, "kernel_launch: unexpected problem (n_in %d, out %d, ws %zu < %zu); nothing launched\n", n_in, out_size, ws_size, (size_t)WS_END); grid = -1; return; }
        int dev = 0, cus = 0;
        if (hipGetDevice(&dev) != hipSuccess || hipDeviceGetAttribute(&cus, hipDeviceAttributeMultiprocessorCount, dev) != hipSuccess) { grid = -1; return; }
        if (hipFuncSetAttribute((const void*)mk_fwd, hipFuncAttributeMaxDynamicSharedMemorySize, LDS_BYTES) != hipSuccess) { fprintf(stderr, "kernel_launch: hipFuncSetAttribute failed\n"); grid = -1; return; }
        int per_cu = 0;
        if (hipOccupancyMaxActiveBlocksPerMultiprocessor(&per_cu, (const void*)mk_fwd, NWAVES * 64, LDS_BYTES) != hipSuccess || per_cu < 1) fprintf(stderr, "kernel_launch: occupancy query says %d\n", per_cu);
        (void)hipGetLastError();
        if (cus < 256) fprintf(stderr, "kernel_launch: %d CUs < 256: the grid cannot be resident\n", cus);
        grid = 256;
    }
    if (grid < 0) return;
    (void)hipMemsetAsync((char*)d_ws + WS_CTL, 0, CTL_ZERO_BYTES, stream);
    Args a{};
    a.x = (const float*)d_in[0]; a.p = (const float*)d_in[1]; a.pos = (const int*)d_in[2]; a.norm_mix_g = (const float*)d_in[3]; a.w_in = (const float*)d_in[4]; a.dw_w = (const float*)d_in[5];
    a.dw_b = (const float*)d_in[6]; a.ln_g = (const float*)d_in[7]; a.ln_b = (const float*)d_in[8]; a.gn_g = (const float*)d_in[9]; a.gn_b = (const float*)d_in[10]; a.w_out = (const float*)d_in[11];
    a.norm_ffn_g = (const float*)d_in[12]; a.w_ff1 = (const float*)d_in[13]; a.w_ff2 = (const float*)d_in[14]; a.norm_ple_g = (const float*)d_in[15]; a.w_gate = (const float*)d_in[16];
    a.w_proj = (const float*)d_in[17]; a.final_g = (const float*)d_in[18]; a.out = (float*)d_out; a.ws = (unsigned char*)d_ws;
    a.ph_lo = 0; a.ph_hi = 18; a.li = 0;
    hipLaunchKernelGGL(mk_fwd, dim3(grid), dim3(NWAVES * 64), LDS_BYTES, stream, a);
}
```

```cpp
#include <hip/hip_runtime.h>
#include <cstdio>
#include <cstdint>
#include <cstddef>
namespace pg8 {
#define PG8_LAS __attribute__((address_space(3)))
typedef unsigned short bf16_t;
typedef short bf16x8 __attribute__((ext_vector_type(8)));
typedef float f32x4 __attribute__((ext_vector_type(4)));
typedef unsigned u32x4 __attribute__((ext_vector_type(4)));
typedef unsigned u32x2 __attribute__((ext_vector_type(2)));
constexpr int BM = 256, BK = 64, HALF = 128, HTB = HALF * BK * 2  , STAGE_BYTES = 8 * HTB, NXCD = 8, WGM = 8;

__host__ __device__ __forceinline__ int lds_byte(int r, int c) { const int st = (r >> 4) * 2 + (c >> 5), rr = r & 15, cc = c & 31, ob = rr * 64 + cc * 2; return st * 1024 + (ob ^ (((ob >> 9) & 1) << 5)); }
__host__ __device__ __forceinline__ void stage_rc(int b, int& R, int& C) { const int st = b / 1024, sb = b % 1024, swz = sb ^ (((sb >> 9) & 1) << 5); R = (st >> 1) * 16 + swz / 64; C = (st & 1) * 32 + (swz % 64) / 2; }
__host__ __device__ __forceinline__ int perm32(int rho) { const int n = rho >> 4, i = rho & 15; return 8 * (i >> 2) + 4 * n + (i & 3); }

struct Unit { int pm, pn; };
struct Gemm { const bf16_t* A; const bf16_t* Bt; int M, N, K; };

struct StaticOrder {
    int nM, nN, nwg, G, c;
    __host__ __device__ void init(int M, int N, int G_, int c_) { nM = M / BM; nN = N / BM; nwg = nM * nN; G = G_; c = c_; }
    __host__ __device__ bool next(int i, Unit& u) const {
        const long L = (long)i * G + c; if (L >= nwg) return false;
        int wgid = (int)L; { const int q = nwg / NXCD, r = nwg % NXCD, xcd = wgid % NXCD, off = wgid / NXCD; wgid = (xcd < r ? xcd * (q + 1) : r * (q + 1) + (xcd - r) * q) + off; }
        const int nig = WGM * nN, gid = wgid / nig, fm = gid * WGM, gsz = (nM - fm) < WGM ? (nM - fm) : WGM;
        u.pm = fm + ((wgid % nig) % gsz); u.pn = (wgid % nig) / gsz; return true;
    }
    __device__ __forceinline__ void a_ready(const Unit&) const {}
    __device__ __forceinline__ void done(const Unit&) const {}
};

__device__ __forceinline__ unsigned cvt_pk_bf16(float lo, float hi) { unsigned r; asm volatile("v_cvt_pk_bf16_f32 %0, %1, %2" : "=v"(r) : "v"(lo), "v"(hi)); return r; }
__device__ __forceinline__ u32x4 pack8(const f32x4 a, const f32x4 b) { u32x4 w; w.x = cvt_pk_bf16(a[0], a[1]); w.y = cvt_pk_bf16(a[2], a[3]); w.z = cvt_pk_bf16(b[0], b[1]); w.w = cvt_pk_bf16(b[2], b[3]); return w; }
__device__ __forceinline__ float fast_sigmoid(float x) { return __builtin_amdgcn_rcpf(1.0f + __builtin_amdgcn_exp2f(x * -1.4426950408889634f)); }
__device__ __forceinline__ f32x4 sig4(const f32x4 v) { return (f32x4){fast_sigmoid(v[0]), fast_sigmoid(v[1]), fast_sigmoid(v[2]), fast_sigmoid(v[3])}; }
constexpr int SSP = 4;
constexpr float RMS_EPS_ = 1e-6f;
__device__ __forceinline__ float rstd_from(const f32x4 s) { return rsqrtf(((s[0] + s[1]) + (s[2] + s[3])) * (1.0f / 1024.0f) + RMS_EPS_); }
__device__ __forceinline__ float rstd_of(const float* ss, int row) { return rstd_from(*(const f32x4*)(ss + (size_t)row * SSP)); }
__device__ __forceinline__ void rstd8(const float* ss, int row0, float (&rs)[2][4]) {
    f32x4 sp[2][4];
#pragma unroll
    for (int ai = 0; ai < 2; ++ai)
#pragma unroll
        for (int m = 0; m < 4; ++m) sp[ai][m] = *(const f32x4*)(ss + (size_t)(row0 + ai * HALF + m * 16) * SSP);
#pragma unroll
    for (int ai = 0; ai < 2; ++ai)
#pragma unroll
        for (int m = 0; m < 4; ++m) rs[ai][m] = rstd_from(sp[ai][m]);
}
typedef _Float16 f16x2 __attribute__((ext_vector_type(2)));

struct EpiInProj {
    static constexpr bool PERM = true, AFTER_DRAIN = false;
    bf16_t* ZB; const float* ss; const unsigned* rope;
    static constexpr int ZP = 2560;
    __device__ __forceinline__ void operator()(const f32x4 (&acc)[2][2][4][2], const Unit& u, int wr, int wc, int fr, int fq) const {
        const int row0 = u.pm * BM + wr * 64 + fr, pn = u.pn, lc = wc * 32 + 8 * fq;
        float rs[2][4]; rstd8(ss, row0, rs);
        if (pn < 4) {
#pragma unroll
            for (int ai = 0; ai < 2; ++ai)
#pragma unroll
                for (int m = 0; m < 4; ++m) { const int row = row0 + ai * HALF + m * 16; const float r = rs[ai][m];
                    const f32x4 h0 = (acc[ai][0][m][0] * r) * sig4(acc[ai][1][m][0] * r), h1 = (acc[ai][0][m][1] * r) * sig4(acc[ai][1][m][1] * r);
                    *(u32x4*)(ZB + (size_t)row * ZP + pn * 128 + lc) = pack8(h0, h1); }
        } else if (pn < 8) {
            const int head = 2 * (pn & 1) + (wc >> 1), d0 = lc & 63, colb = (pn < 6 ? 512 : 1024) + head * 128 + d0;
#pragma unroll
            for (int ai = 0; ai < 2; ++ai) {
                u32x4 r0[4], r1[4];
#pragma unroll
                for (int m = 0; m < 4; ++m) { const u32x4* rp = (const u32x4*)(rope + (size_t)(row0 + ai * HALF + m * 16) * 64 + d0); r0[m] = rp[0]; r1[m] = rp[1]; }
#pragma unroll
                for (int m = 0; m < 4; ++m) { const int row = row0 + ai * HALF + m * 16; const float r = rs[ai][m];
                    f32x4 o1[2], o2[2];
                    const unsigned rv[8] = {r0[m].x, r0[m].y, r0[m].z, r0[m].w, r1[m].x, r1[m].y, r1[m].z, r1[m].w};
#pragma unroll
                    for (int n = 0; n < 2; ++n) {
#pragma unroll
                        for (int i = 0; i < 4; ++i) { const f16x2 cs = __builtin_bit_cast(f16x2, rv[4 * n + i]); const float c = (float)cs[0], s = (float)cs[1];
                            const float t1 = acc[ai][0][m][n][i] * r, t2 = acc[ai][1][m][n][i] * r; o1[n][i] = t1 * c - t2 * s; o2[n][i] = t2 * c + t1 * s; } }
                    bf16_t* zp = ZB + (size_t)row * ZP + colb; *(u32x4*)zp = pack8(o1[0], o1[1]); *(u32x4*)(zp + 64) = pack8(o2[0], o2[1]); }
                asm volatile("" ::: "memory"); }
        } else {
            const int colb = 1536 + (pn - 8) * 256 + lc;
#pragma unroll
            for (int ai = 0; ai < 2; ++ai)
#pragma unroll
                for (int m = 0; m < 4; ++m) { const int row = row0 + ai * HALF + m * 16; const float r = rs[ai][m];
#pragma unroll
                    for (int bj = 0; bj < 2; ++bj) *(u32x4*)(ZB + (size_t)row * ZP + colb + bj * HALF) = pack8(acc[ai][bj][m][0] * r, acc[ai][bj][m][1] * r); }
        }
    }
};
__device__ __forceinline__ void unpack8(const u32x4 w, f32x4& a, f32x4& b) {
    a = (f32x4){__uint_as_float(w.x << 16), __uint_as_float(w.x & 0xffff0000u), __uint_as_float(w.y << 16), __uint_as_float(w.y & 0xffff0000u)};
    b = (f32x4){__uint_as_float(w.z << 16), __uint_as_float(w.z & 0xffff0000u), __uint_as_float(w.w << 16), __uint_as_float(w.w & 0xffff0000u)};
}
template <int MODE> struct EpiResid {
    static constexpr bool PERM = true, AFTER_DRAIN = false;
    const bf16_t* XI; bf16_t* XO; float* ss_out; const float* ss_in; const bf16_t* proj; PG8_LAS float* red;
    __device__ __forceinline__ void operator()(const f32x4 (&acc)[2][2][4][2], const Unit& u, int wr, int wc, int fr, int fq) const {
        const int row0 = u.pm * BM + wr * 64 + fr, col0 = u.pn * BM + wc * 32 + 8 * fq;
        float rs[2][4];
        if (MODE == 1) rstd8(ss_in, row0, rs);
        constexpr int NB = (MODE == 1) ? 2 : 4;
#pragma unroll
        for (int ai = 0; ai < 2; ++ai)
#pragma unroll
        for (int mb = 0; mb < 4; mb += NB) {
            u32x4 xb[NB][2], pb[NB][2];
#pragma unroll
            for (int mm = 0; mm < NB; ++mm)
#pragma unroll
                for (int bj = 0; bj < 2; ++bj) { const size_t off = (size_t)(row0 + ai * HALF + (mb + mm) * 16) * 1024 + col0 + bj * HALF; xb[mm][bj] = *(const u32x4*)(XI + off); if (MODE == 1) pb[mm][bj] = *(const u32x4*)(proj + off); }
#pragma unroll
            for (int mm = 0; mm < NB; ++mm) { const int m = mb + mm; const size_t off = (size_t)(row0 + ai * HALF + m * 16) * 1024 + col0; float q = 0.f;
#pragma unroll
                for (int bj = 0; bj < 2; ++bj) { f32x4 b0, b1; unpack8(xb[mm][bj], b0, b1);
                    f32x4 v0, v1;
                    if (MODE == 1) { f32x4 p0, p1; unpack8(pb[mm][bj], p0, p1); const float r = rs[ai][m];
                        v0 = b0 + sig4(acc[ai][bj][m][0] * r) * p0; v1 = b1 + sig4(acc[ai][bj][m][1] * r) * p1; }
                    else { v0 = b0 + acc[ai][bj][m][0]; v1 = b1 + acc[ai][bj][m][1]; }
                    *(u32x4*)(XO + off + bj * HALF) = pack8(v0, v1);
                    q += (v0[0] * v0[0] + v0[1] * v0[1]) + (v0[2] * v0[2] + v0[3] * v0[3]) + (v1[0] * v1[0] + v1[1] * v1[1]) + (v1[2] * v1[2] + v1[3] * v1[3]); }
                q += __shfl_xor(q, 16); q += __shfl_xor(q, 32);
                if (fq == 0) red[(ai * HALF + wr * 64 + m * 16 + fr) * 4 + wc] = q; }
            asm volatile("" ::: "memory"); }
        asm volatile("s_waitcnt lgkmcnt(0)" ::: "memory"); __builtin_amdgcn_s_barrier(); asm volatile("" ::: "memory");
        const int t = (wr * 4 + wc) * 64 + fq * 16 + fr;
        if (t < 256) { const f32x4 s4 = *(const PG8_LAS f32x4*)(red + t * 4); ss_out[(size_t)(u.pm * BM + t) * SSP + u.pn] = (s4[0] + s4[1]) + (s4[2] + s4[3]); }
    }
};
struct EpiFF1 {
    static constexpr bool PERM = true, AFTER_DRAIN = false;
    bf16_t* H; const float* ss;
    __device__ __forceinline__ void operator()(const f32x4 (&acc)[2][2][4][2], const Unit& u, int wr, int wc, int fr, int fq) const {
        const int row0 = u.pm * BM + wr * 64 + fr, col0 = u.pn * BM + wc * 32 + 8 * fq;
        float rs8[2][4]; rstd8(ss, row0, rs8);
#pragma unroll
        for (int ai = 0; ai < 2; ++ai)
#pragma unroll
            for (int m = 0; m < 4; ++m) { const int row = row0 + ai * HALF + m * 16; const float rs = rs8[ai][m];
#pragma unroll
                for (int bj = 0; bj < 2; ++bj) { f32x4 v0 = acc[ai][bj][m][0] * rs, v1 = acc[ai][bj][m][1] * rs;
                    v0 = __builtin_elementwise_max(v0, (f32x4){0.f, 0.f, 0.f, 0.f}); v1 = __builtin_elementwise_max(v1, (f32x4){0.f, 0.f, 0.f, 0.f}); v0 = v0 * v0; v1 = v1 * v1;
                    *(u32x4*)(H + (size_t)row * 4096 + col0 + bj * HALF) = pack8(v0, v1); } }
    }
};
struct EpiPlain {
    static constexpr bool PERM = true, AFTER_DRAIN = false;
    bf16_t* O;
    __device__ __forceinline__ void operator()(const f32x4 (&acc)[2][2][4][2], const Unit& u, int wr, int wc, int fr, int fq) const {
        const int row0 = u.pm * BM + wr * 64 + fr, col0 = u.pn * BM + wc * 32 + 8 * fq;
#pragma unroll
        for (int ai = 0; ai < 2; ++ai)
#pragma unroll
            for (int m = 0; m < 4; ++m) { const int row = row0 + ai * HALF + m * 16;
#pragma unroll
                for (int bj = 0; bj < 2; ++bj) *(u32x4*)(O + (size_t)row * 1024 + col0 + bj * HALF) = pack8(acc[ai][bj][m][0], acc[ai][bj][m][1]); }
    }
};

template <class Epi, class Sched, bool ALIGN_EPI = false, bool SP2 = false>
__device__ __forceinline__ void gemm_phase(PG8_LAS unsigned char* lds, const Gemm g, const Sched& S, const Epi& E, const int wave_id) {
    unsigned z_ = 0u; asm volatile("" : "+v"(z_)); const int tid_ = wave_id * 64 + (int)__builtin_amdgcn_mbcnt_hi(~0u, __builtin_amdgcn_mbcnt_lo(~0u, z_));
    const int tid = tid_, wid = wave_id, lane = tid & 63, wr = wid >> 2, wc = wid & 3, fr = lane & 15, fq = lane >> 4;
    const int K = g.K, nt = K / BK;
    unsigned voffA[2], voffB[2];
#pragma unroll
    for (int i = 0; i < 2; ++i) { int R, C; stage_rc(tid * 16 + i * 8192, R, C); const int Rb = Epi::PERM ? ((R & ~31) + perm32(R & 31)) : R;
        voffA[i] = (unsigned)(R * K + C) * 2u; voffB[i] = (unsigned)(Rb * K + C) * 2u; }
    const size_t kstep = (size_t)(BK * 2);
    const size_t hstep = (size_t)HALF * K * 2;
    const size_t tstep = 2 * hstep;
    const unsigned ldsw = (unsigned)wid * 1024u;
    const int aoff = lds_byte(wr * 64 + fr, fq * 8), boff = lds_byte(wc * 32 + fr, fq * 8);
#define PG8_SA(b, h) (((b) * 2 + (h)) * HTB)
#define PG8_SB(b, h) ((4 + (b) * 2 + (h)) * HTB)
#define PG8_STAGE(bufoff, gbase, voff) do { _Pragma("unroll") for (int _i = 0; _i < 2; ++_i) \
        __builtin_amdgcn_global_load_lds((const unsigned*)((const char*)(gbase) + (voff)[_i]), (PG8_LAS unsigned*)(lds + (bufoff) + ldsw + _i * 8192), 16, 0, 0); } while (0)
#define PG8_LDA(dst, b, h) do { _Pragma("unroll") for (int m = 0; m < 4; ++m) _Pragma("unroll") for (int k = 0; k < 2; ++k) dst[m][k] = *(const PG8_LAS bf16x8*)(lds + PG8_SA(b, h) + aoff + m * 2048 + k * 1024); } while (0)
#define PG8_LDB(dst, b, h) do { _Pragma("unroll") for (int n = 0; n < 2; ++n) _Pragma("unroll") for (int k = 0; k < 2; ++k) dst[n][k] = *(const PG8_LAS bf16x8*)(lds + PG8_SB(b, h) + boff + n * 2048 + k * 1024); } while (0)
#define PG8_MMA(ai, bj, At, Bt) do { __builtin_amdgcn_s_setprio(1); _Pragma("unroll") for (int m = 0; m < 4; ++m) _Pragma("unroll") for (int n = 0; n < 2; ++n) _Pragma("unroll") for (int k = 0; k < 2; ++k) \
        acc[ai][bj][m][n] = __builtin_amdgcn_mfma_f32_16x16x32_bf16(Bt[n][k], At[m][k], acc[ai][bj][m][n], 0, 0, 0); __builtin_amdgcn_s_setprio(0); } while (0)
#define PG8_WAIT_V(n) asm volatile("s_waitcnt vmcnt(" #n ")" ::: "memory")
#define PG8_WAIT_L(n) asm volatile("s_waitcnt lgkmcnt(" #n ")" ::: "memory")
#define PG8_BAR __builtin_amdgcn_s_barrier()
#define PG8_SCHED __builtin_amdgcn_sched_barrier(0)
    Unit cur, nxt; int ui = 0;
    if (!S.next(0, cur)) return;
    f32x4 acc[2][2][4][2];
#pragma unroll
    for (int a = 0; a < 2; ++a)
#pragma unroll
        for (int b = 0; b < 2; ++b)
#pragma unroll
            for (int m = 0; m < 4; ++m)
#pragma unroll
                for (int n = 0; n < 2; ++n) acc[a][b][m][n] = (f32x4){0.f, 0.f, 0.f, 0.f};
    bf16x8 At[4][2], B0[2][2], B1[2][2];
    const char* cA = (const char*)g.A + (size_t)cur.pm * tstep; const char* cB = (const char*)g.Bt + (size_t)cur.pn * tstep;
    S.a_ready(cur);
    if constexpr (SP2) {
        PG8_STAGE(PG8_SB(0, 0), cB, voffB); PG8_STAGE(PG8_SB(0, 1), cB + hstep, voffB); PG8_STAGE(PG8_SA(0, 0), cA, voffA); PG8_STAGE(PG8_SA(0, 1), cA + hstep, voffA);
        if (wr == 1) PG8_BAR;
        PG8_WAIT_V(2); PG8_BAR;
        PG8_STAGE(PG8_SB(1, 0), cB + kstep, voffB); PG8_STAGE(PG8_SA(1, 0), cA + kstep, voffA); PG8_STAGE(PG8_SB(1, 1), cB + hstep + kstep, voffB);
        PG8_WAIT_V(6); PG8_BAR;
    } else {
        PG8_STAGE(PG8_SB(0, 0), cB, voffB); PG8_STAGE(PG8_SA(0, 0), cA, voffA); PG8_STAGE(PG8_SB(0, 1), cB + hstep, voffB); PG8_STAGE(PG8_SA(0, 1), cA + hstep, voffA);
        if (wr == 1) PG8_BAR;
        PG8_WAIT_V(4); PG8_BAR;
        PG8_STAGE(PG8_SB(1, 0), cB + kstep, voffB); PG8_STAGE(PG8_SA(1, 0), cA + kstep, voffA); PG8_STAGE(PG8_SB(1, 1), cB + hstep + kstep, voffB);
        PG8_WAIT_V(6); PG8_BAR;
    }
    for (;;) {
        const bool has_next = S.next(ui + 1, nxt);
        const char* nA = has_next ? (const char*)g.A + (size_t)nxt.pm * tstep : cA; const char* nB = has_next ? (const char*)g.Bt + (size_t)nxt.pn * tstep : cB;
        for (int t = 0; t < nt; t += 2) {
            const bool last = (t == nt - 2);
            const char* a1 = cA + (size_t)(t + 1) * kstep;
            const char* a2 = last ? nA : cA + (size_t)(t + 2) * kstep; const char* b2 = last ? nB : cB + (size_t)(t + 2) * kstep;
            const char* a3 = a2 + kstep; const char* b3 = b2 + kstep;
            if (last && has_next) S.a_ready(nxt);
            if constexpr (SP2) {
            PG8_LDB(B0, 0, 0); PG8_LDB(B1, 0, 1); PG8_SCHED; PG8_LDA(At, 0, 0); PG8_STAGE(PG8_SA(1, 1), a1 + hstep, voffA);
            PG8_WAIT_V(8); PG8_WAIT_L(0); PG8_BAR; PG8_MMA(0, 0, At, B0); PG8_MMA(0, 1, At, B1); PG8_BAR; PG8_SCHED;
            PG8_LDA(At, 0, 1); PG8_STAGE(PG8_SB(0, 0), b2, voffB); PG8_STAGE(PG8_SB(0, 1), b2 + hstep, voffB); PG8_STAGE(PG8_SA(0, 0), a2, voffA);
            PG8_WAIT_V(8); PG8_WAIT_L(0); PG8_BAR; PG8_MMA(1, 0, At, B0); PG8_MMA(1, 1, At, B1); PG8_BAR; PG8_SCHED;
            PG8_LDB(B0, 1, 0); PG8_LDB(B1, 1, 1); PG8_SCHED; PG8_LDA(At, 1, 0); PG8_STAGE(PG8_SA(0, 1), a2 + hstep, voffA);
            PG8_WAIT_V(8); PG8_WAIT_L(0); PG8_BAR; PG8_MMA(0, 0, At, B0); PG8_MMA(0, 1, At, B1); PG8_BAR; PG8_SCHED;
            PG8_LDA(At, 1, 1); PG8_STAGE(PG8_SB(1, 0), b3, voffB); PG8_STAGE(PG8_SB(1, 1), b3 + hstep, voffB); PG8_STAGE(PG8_SA(1, 0), a3, voffA);
            PG8_WAIT_V(8); PG8_WAIT_L(0); PG8_BAR; PG8_MMA(1, 0, At, B0); PG8_MMA(1, 1, At, B1); PG8_BAR; PG8_SCHED;
            } else {
            PG8_LDB(B0, 0, 0); PG8_SCHED; PG8_LDA(At, 0, 0); PG8_STAGE(PG8_SA(1, 1), a1 + hstep, voffA);
            PG8_WAIT_L(8); PG8_BAR; PG8_WAIT_L(0); PG8_MMA(0, 0, At, B0); PG8_BAR; PG8_SCHED;
            PG8_LDB(B1, 0, 1); PG8_STAGE(PG8_SB(0, 0), b2, voffB);
            PG8_BAR; PG8_WAIT_L(0); PG8_MMA(0, 1, At, B1); PG8_BAR;
            PG8_LDA(At, 0, 1); PG8_STAGE(PG8_SA(0, 0), a2, voffA);
            PG8_BAR; PG8_WAIT_L(0); PG8_MMA(1, 0, At, B0); PG8_BAR; PG8_SCHED;
            PG8_STAGE(PG8_SB(0, 1), b2 + hstep, voffB);
            PG8_WAIT_V(6); PG8_BAR; PG8_MMA(1, 1, At, B1); PG8_BAR;
            PG8_LDB(B0, 1, 0); PG8_SCHED; PG8_LDA(At, 1, 0); PG8_STAGE(PG8_SA(0, 1), a2 + hstep, voffA);
            PG8_WAIT_L(8); PG8_BAR; PG8_WAIT_L(0); PG8_MMA(0, 0, At, B0); PG8_BAR; PG8_SCHED;
            PG8_LDB(B1, 1, 1); PG8_STAGE(PG8_SB(1, 0), b3, voffB);
            PG8_BAR; PG8_WAIT_L(0); PG8_MMA(0, 1, At, B1); PG8_BAR;
            PG8_LDA(At, 1, 1); PG8_STAGE(PG8_SA(1, 0), a3, voffA);
            PG8_BAR; PG8_WAIT_L(0); PG8_MMA(1, 0, At, B0); PG8_BAR; PG8_SCHED;
            PG8_STAGE(PG8_SB(1, 1), b3 + hstep, voffB);
            PG8_WAIT_V(6); PG8_BAR; PG8_MMA(1, 1, At, B1); PG8_BAR;
            }
        }
        if constexpr (ALIGN_EPI) { if (wr == 0) PG8_BAR; }
        if constexpr (!Epi::AFTER_DRAIN) { E(acc, cur, wr, wc, fr, fq); S.done(cur); }
        if (!has_next) break;
#pragma unroll
        for (int a = 0; a < 2; ++a)
#pragma unroll
            for (int b = 0; b < 2; ++b)
#pragma unroll
                for (int m = 0; m < 4; ++m)
#pragma unroll
                    for (int n = 0; n < 2; ++n) acc[a][b][m][n] = (f32x4){0.f, 0.f, 0.f, 0.f};
        cur = nxt; cA = nA; cB = nB; ++ui;
        if constexpr (ALIGN_EPI) { if (wr == 1) PG8_BAR; }
    }
    PG8_WAIT_V(0);
    if constexpr (!ALIGN_EPI) { if (wr == 0) PG8_BAR; }
    PG8_BAR;
    if constexpr (Epi::AFTER_DRAIN) { E.fused(acc, cur, wr, wc, fr, fq, lds, wid, lane); S.done(cur); }
#undef PG8_SA
#undef PG8_SB
#undef PG8_STAGE
#undef PG8_LDA
#undef PG8_LDB
#undef PG8_MMA
#undef PG8_WAIT_V
#undef PG8_WAIT_L
#undef PG8_BAR
#undef PG8_SCHED
}
}

constexpr int NWAVES = 8;
constexpr int NB = 8, SEQ = 8192, D = 1024, DEPTH = 2, CCH = 512, CONVW = 31, RH = 4, RD = 128, RW = 512, RC = 128, FF = 4096, PLE = 256, INC = 3072;
constexpr int M = NB * SEQ;
constexpr int ZP = 2560;
constexpr float LN_EPS = 1e-5f;
constexpr size_t MiB = 1u << 20;
constexpr size_t WS_CTL = 0, CTL_ZERO_BYTES = 1 * MiB;
constexpr size_t WS_W = 2 * MiB, W_LAYER = 27 * MiB;
constexpr size_t WO_IN = 0, WO_OUT = 6 * MiB, WO_FF1 = 8 * MiB, WO_FF2 = 16 * MiB, WO_GATE = 24 * MiB, WO_PROJ = 26 * MiB;
constexpr size_t WS_SS = 56 * MiB, SS_SITE = 4 * MiB;
constexpr size_t WS_ROPE = 84 * MiB;
constexpr size_t WS_XB = 100 * MiB;
constexpr size_t WS_PB = 228 * MiB;
constexpr size_t WS_PROJ = 292 * MiB;
constexpr size_t WS_ZB = 420 * MiB;
constexpr size_t WS_T = 740 * MiB;
constexpr size_t WS_MIX = 756 * MiB;
constexpr size_t WS_HID = 420 * MiB;
constexpr size_t WS_END = 932 * MiB;
constexpr size_t WS_U = WS_XB, WS_S = WS_PROJ;
constexpr int CW_TMO = 0, CW_BAR = 4096;
constexpr int LDS_BYTES = 163840, RING_OFF = 0, MISC_OFF = 163840 - 256, ARGS_OFF = 163840 - 512, RED_OFF = 131072;

#define GAS __attribute__((address_space(1)))
#define LAS __attribute__((address_space(3)))
typedef unsigned short bf16;
typedef unsigned v4u __attribute__((ext_vector_type(4)));
typedef float f32x4 __attribute__((ext_vector_type(4)));
typedef GAS unsigned gu32;
#define RLX_AGENT __ATOMIC_RELAXED, __HIP_MEMORY_SCOPE_AGENT
#define LDS_WAIT() asm volatile("s_waitcnt lgkmcnt(0)" ::: "memory")
__device__ __forceinline__ unsigned f2bf(float f) { unsigned u = __builtin_bit_cast(unsigned, f); return (u + 0x7fffu + ((u >> 16) & 1u)) >> 16; }
__device__ __forceinline__ unsigned pk2(float lo, float hi) { return f2bf(lo) | (f2bf(hi) << 16); }
__device__ __forceinline__ float bf2f(unsigned short b) { return __uint_as_float(((unsigned)b) << 16); }

__device__ __forceinline__ float wave_sum(float v) {
#pragma unroll
    for (int o = 1; o < 64; o <<= 1) v += __shfl_xor(v, o);
    return v;
}
#define XB_TMO      128
#define XB_XCNT(j)  (256  + 64 * (j))
#define XB_XSUB(j)  (1280 + 64 * (j))
#define XB_XGEN(j)  (2304 + 64 * (j))
#define XB_TOP      3328
#define XB_TOPGEN   3392
#define XCD_BAR_WORDS 3456
#define XB_SPIN_CAP (1u << 18)

__device__ __forceinline__ unsigned xb_ld(unsigned* p)              { return __hip_atomic_load(p, __ATOMIC_RELAXED, __HIP_MEMORY_SCOPE_AGENT); }
__device__ __forceinline__ unsigned xb_add(unsigned* p, unsigned v) { return __hip_atomic_fetch_add(p, v, __ATOMIC_RELAXED, __HIP_MEMORY_SCOPE_AGENT); }
__device__ __forceinline__ unsigned xb_xcc_id() { return (unsigned)__builtin_amdgcn_s_getreg((3 << 11) | 20) & 0xFu; }
#define XB_SPIN(cond, bar) do { unsigned _sp = 0; while (cond) { __builtin_amdgcn_s_sleep(1); \
    if ((++_sp & 255u) == 0u) { if (xb_ld(&(bar)[XB_TMO])) break; if (_sp > XB_SPIN_CAP) { atomicAdd(&(bar)[XB_TMO], 1u); break; } } } } while (0)

__device__ __forceinline__ int xb_fresh_lane() { unsigned z = 0u; asm volatile("" : "+v"(z)); return (int)__builtin_amdgcn_mbcnt_hi(~0u, __builtin_amdgcn_mbcnt_lo(~0u, z)); }
struct XcdBarrier {
    unsigned* bar; unsigned x; int wave;
    volatile LAS unsigned* st;
};

__device__ __forceinline__ XcdBarrier xcd_barrier_post(unsigned* bar, volatile LAS unsigned* st, int wave) {
    XcdBarrier b; b.bar = bar; b.x = xb_xcc_id(); b.st = st; b.wave = wave;
    if (wave == 0 && xb_fresh_lane() == 0) (void)xb_add(&bar[XB_XCNT(b.x)], 1u);
    return b;
}
__device__ __forceinline__ void xcd_barrier_complete(unsigned* bar, unsigned x, unsigned& nloc, unsigned& nx) {
    const unsigned G = gridDim.x * gridDim.y * gridDim.z;
    unsigned sum, cnt, mine, sp = 0u;
    for (;;) {
        sum = 0u; cnt = 0u; mine = 0u;
#pragma unroll
        for (unsigned j = 0; j < 16; ++j) { const unsigned c = xb_ld(&bar[XB_XCNT(j)]); sum += c; cnt += (c > 0u) ? 1u : 0u; mine = (j == x) ? c : mine; }
        if (sum == G) break;
        __builtin_amdgcn_s_sleep(1);
        if ((++sp & 255u) == 0u) { if (xb_ld(&bar[XB_TMO])) break; if (sp > XB_SPIN_CAP) { atomicAdd(&bar[XB_TMO], 1u); break; } }
    }
    nloc = mine > 0u ? mine : 1u; nx = cnt > 0u ? cnt : 1u;
}

__device__ __forceinline__ void xcd_barrier(const XcdBarrier& b) {
    asm volatile("s_waitcnt vmcnt(0)" ::: "memory");
    __syncthreads();
    if (b.wave == 0 && xb_fresh_lane() == 0) {
        unsigned* bar = b.bar;
        __builtin_amdgcn_s_waitcnt(0);
        unsigned nloc = b.st[0], nx = b.st[1];
        if (nloc == 0u) { xcd_barrier_complete(bar, b.x, nloc, nx); b.st[0] = nloc; b.st[1] = nx; }
        const unsigned old = xb_add(&bar[XB_XSUB(b.x)], 1u);
        const unsigned gen = old / nloc;
        if (old + 1u == (gen + 1u) * nloc) {
            __builtin_amdgcn_fence(__ATOMIC_RELEASE, "agent");
            asm volatile("s_waitcnt vmcnt(0)" ::: "memory");
            const unsigned og = xb_add(&bar[XB_TOP], 1u);
            const unsigned tg = og / nx;
            if (og + 1u == (tg + 1u) * nx) xb_add(&bar[XB_TOPGEN], 1u);
            else XB_SPIN(xb_ld(&bar[XB_TOPGEN]) == tg, bar);
            __builtin_amdgcn_fence(__ATOMIC_ACQUIRE, "agent");
            xb_add(&bar[XB_XGEN(b.x)], 1u);
            asm volatile("s_waitcnt vmcnt(0)" ::: "memory");
        } else {
            XB_SPIN(xb_ld(&bar[XB_XGEN(b.x)]) == gen, bar);
            __builtin_amdgcn_fence(__ATOMIC_ACQUIRE, "agent");
            asm volatile("s_waitcnt vmcnt(0)" ::: "memory");
        }
    }
    __syncthreads();
}

namespace mx {
typedef short s16x4 __attribute__((ext_vector_type(4)));
typedef short v4i16_t __attribute__((ext_vector_type(4)));
typedef short bf16x8 __attribute__((ext_vector_type(8)));
typedef float f32x2 __attribute__((ext_vector_type(2)));
typedef unsigned u32x2 __attribute__((ext_vector_type(2)));
constexpr int KI = 0, VI = 32768, QI = 65536, SI = 98304;

__device__ __forceinline__ unsigned off_a(unsigned row, unsigned ch) { return 2048u * (row >> 3) + 512u * (ch >> 2) + 64u * (row & 7u) + 16u * ((ch & 3u) ^ ((row >> 2) & 3u)); }
struct LaneAddr { unsigned tr[2][2], row, kap[2]; };
__device__ __forceinline__ void lane_addr(LaneAddr& A, unsigned lane) {
    const unsigned g = lane >> 4, li = lane & 15u, q = li >> 2, p = lane & 3u;
#pragma unroll
    for (unsigned cp = 0; cp < 2; ++cp)
#pragma unroll
        for (unsigned t = 0; t < 2; ++t) A.tr[cp][t] = 2048u * g + 64u * q + 32u * (cp ^ (g & 1u)) + 16u * ((p >> 1) ^ t) + 8u * (p & 1u);
    A.row = 2048u * (li >> 3) + 64u * (li & 7u) + 16u * (g ^ ((li >> 2) & 3u));
#pragma unroll
    for (unsigned t = 0; t < 2; ++t) A.kap[t] = 2048u * (li >> 2) + 64u * (li & 3u) + 16u * ((g ^ (2u * ((li >> 2) & 1u))) ^ t);
}
__device__ __forceinline__ bf16x8 tr_frag(LAS const unsigned char* img, const LaneAddr& A, int c, int ks) {
    const s16x4 lo = __builtin_bit_cast(s16x4, __builtin_amdgcn_ds_read_tr16_b64_v4i16((LAS v4i16_t*)(img + A.tr[c & 1][0] + (8192 * ks + 512 * (c >> 1)))));
    const s16x4 hi = __builtin_bit_cast(s16x4, __builtin_amdgcn_ds_read_tr16_b64_v4i16((LAS v4i16_t*)(img + A.tr[c & 1][1] + (8192 * ks + 512 * (c >> 1) + 256))));
    return __builtin_shufflevector(lo, hi, 0, 1, 2, 3, 4, 5, 6, 7);
}
__device__ __forceinline__ bf16x8 row_frag(LAS const unsigned char* img, const LaneAddr& A, int rb, int s) { return *(LAS const bf16x8*)(img + A.row + (4096 * rb + 512 * s)); }
__device__ __forceinline__ bf16x8 kap_frag(LAS const unsigned char* img, const LaneAddr& A, int kp, int t, int ks) { return *(LAS const bf16x8*)(img + A.kap[t] + (8192 * kp + 512 * ks + 256 * t)); }
__device__ __forceinline__ float gamma_log(int h) { return logf(1.0f - exp2f(-5.0f - (float)h)); }
__device__ __forceinline__ float to_sgpr(float v) { return __builtin_bit_cast(float, __builtin_amdgcn_readfirstlane(__builtin_bit_cast(int, v))); }
__device__ __forceinline__ int opaque_s(int v) { asm volatile("" : "+s"(v)); return v; }

__device__ __forceinline__ void tile_load(v4u (&v)[4], const bf16* src, int tid) {
    const GAS v4u* g = (const GAS v4u*)(src + (size_t)(tid >> 2) * ZP + (tid & 3) * 32);
#pragma unroll
    for (int c = 0; c < 4; ++c) v[c] = g[c];
}
template <bool SCALE> __device__ __forceinline__ void tile_store(LAS unsigned char* img, const v4u (&v)[4], float rowscale, int tid) {
    const unsigned row = (unsigned)tid >> 2, sb = 2048u * (row >> 3) + 512u * ((unsigned)tid & 3u) + 64u * (row & 7u), r2 = (row >> 2) & 3u;
#pragma unroll
    for (int c = 0; c < 4; ++c) {
        v4u o = v[c];
        if (SCALE) {
            const unsigned w[4] = {o.x, o.y, o.z, o.w}; unsigned r[4];
#pragma unroll
            for (int i = 0; i < 4; ++i) r[i] = pg8::cvt_pk_bf16(__uint_as_float(w[i] << 16) * rowscale, __uint_as_float(w[i] & 0xffff0000u) * rowscale);
            o.x = r[0]; o.y = r[1]; o.z = r[2]; o.w = r[3];
        }
        *(LAS v4u*)(img + sb + 16u * ((unsigned)c ^ r2)) = o;
    }
}
#define MX_MFMA(a, b, c) __builtin_amdgcn_mfma_f32_16x16x32_bf16((a), (b), (c), 0, 0, 0)

__device__ __forceinline__ void conv_phase(LAS unsigned char* L, const bf16* ZB, bf16* MIXB, const float* dw_w, const float* dw_b, const float* ln_g, const float* ln_b, int bx, int wave) {
    const int lane0 = xb_fresh_lane(), cp0 = (wave * 64 + lane0) & 255, half = wave >> 2;
    f32x2 w2[CONVW];
#pragma unroll
    for (int j = 0; j < CONVW; ++j) w2[j] = *(const GAS f32x2*)(dw_w + j * CCH + 2 * cp0);
    const f32x2 b2 = *(const GAS f32x2*)(dw_b + 2 * cp0);
    LAS float* CT = (LAS float*)L;
    for (int tile = 0; tile < 4; ++tile) {
        int lane = lane0; asm volatile("" : "+v"(lane));
        const int cp = (wave * 64 + lane) & 255;
        const int mt = bx * 256 + tile * 64, t0 = (mt % SEQ) + 32 * half;
        const bf16* src = ZB + ((long)(mt + 32 * half) - (CONVW - 1)) * ZP + 2 * cp;
        f32x2 acc[32];
#pragma unroll
        for (int t = 0; t < 32; ++t) acc[t] = b2;
#pragma unroll
        for (int r = 0; r < 32 + CONVW - 1; ++r) {
            unsigned u = 0u; if (t0 - (CONVW - 1) + r >= 0) u = *(const GAS unsigned*)(src + (long)r * ZP);
            const f32x2 h2 = {__uint_as_float(u << 16), __uint_as_float(u & 0xffff0000u)};
#pragma unroll
            for (int t = (r - (CONVW - 1) > 0 ? r - (CONVW - 1) : 0); t <= (r < 31 ? r : 31); ++t) acc[t] = w2[r - t] * h2 + acc[t];
        }
#pragma unroll
        for (int t = 0; t < 32; ++t) *(LAS f32x2*)(CT + (32 * half + t) * CCH + 2 * cp) = acc[t];
        __syncthreads();
        {
            const f32x4 g0 = *(const GAS f32x4*)(ln_g + 8 * lane), g1 = *(const GAS f32x4*)(ln_g + 8 * lane + 4), be0 = *(const GAS f32x4*)(ln_b + 8 * lane), be1 = *(const GAS f32x4*)(ln_b + 8 * lane + 4);
#pragma unroll 2
            for (int i = 0; i < 8; ++i) {
                const int tok = 8 * wave + i;
                f32x4 v0 = *(LAS f32x4*)(CT + tok * CCH + 8 * lane), v1 = *(LAS f32x4*)(CT + tok * CCH + 8 * lane + 4);
                const float mean = wave_sum((v0[0] + v0[1]) + (v0[2] + v0[3]) + (v1[0] + v1[1]) + (v1[2] + v1[3])) * (1.0f / CCH);
                v0 = v0 - mean; v1 = v1 - mean;
                const float rstd = rsqrtf(wave_sum((v0[0] * v0[0] + v0[1] * v0[1]) + (v0[2] * v0[2] + v0[3] * v0[3]) + (v1[0] * v1[0] + v1[1] * v1[1]) + (v1[2] * v1[2] + v1[3] * v1[3])) * (1.0f / CCH) + LN_EPS);
                v0 = v0 * rstd * g0 + be0; v1 = v1 * rstd * g1 + be1;
                v0 = v0 * pg8::sig4(v0); v1 = v1 * pg8::sig4(v1);
                *(GAS v4u*)(MIXB + (size_t)(mt + tok) * D + 8 * lane) = pg8::pack8(v0, v1);
            }
        }
        __syncthreads();
    }
}

__device__ __forceinline__ void state_mfma(f32x4 (&sacc)[8], LAS const unsigned char* Kimg, LAS const unsigned char* Vimg, const LaneAddr& A, int wave) {
    LAS const unsigned char* Kw = Kimg + 512 * (wave >> 1);
#pragma unroll
    for (int kp = 0; kp < 4; ++kp) {
        const bf16x8 kf = (wave & 1) ? tr_frag(Kw, A, 1, kp) : tr_frag(Kw, A, 0, kp);
#pragma unroll
        for (int eb = 0; eb < 8; ++eb) { const bf16x8 vf = tr_frag(Vimg, A, eb, kp); sacc[eb] = MX_MFMA(kf, vf, sacc[eb]); }
    }
}
__device__ __forceinline__ void ret_state_phase(LAS unsigned char* L, const bf16* ZB, float* Tf, int bx, int wave) {
    const int lane0 = xb_fresh_lane(), bh = bx >> 3, cg = bx & 7, b = bh >> 2, h = opaque_s(bh & 3);
    const float lg = to_sgpr(gamma_log(h)), kscale = expf(-(float)((wave * 64 + lane0) >> 2) * lg), g1 = to_sgpr(expf(lg)), g127 = to_sgpr(expf(127.0f * lg));
    f32x4 sacc[8];
#pragma unroll
    for (int eb = 0; eb < 8; ++eb) sacc[eb] = (f32x4){0.f, 0.f, 0.f, 0.f};
    v4u kr[4], vr[4];
    { const size_t m0 = (size_t)b * SEQ + (size_t)(cg * 8) * RC; const int tid0 = wave * 64 + lane0; tile_load(kr, ZB + m0 * ZP + 1024 + h * RD, tid0); tile_load(vr, ZB + m0 * ZP + 1536 + h * RD, tid0); }
    for (int j = 0; j < 8; ++j) {
        int lane = lane0; asm volatile("" : "+v"(lane));
        const int tid = wave * 64 + lane;
        tile_store<true>(L + KI, kr, kscale, tid); tile_store<false>(L + VI, vr, 1.0f, tid);
        __syncthreads();
        if (j < 7) { const size_t m1 = (size_t)b * SEQ + (size_t)(cg * 8 + j + 1) * RC; tile_load(kr, ZB + m1 * ZP + 1024 + h * RD, tid); tile_load(vr, ZB + m1 * ZP + 1536 + h * RD, tid); }
#pragma unroll
        for (int eb = 0; eb < 8; ++eb) sacc[eb] = sacc[eb] * g1;
        LaneAddr A; lane_addr(A, (unsigned)lane);
        state_mfma(sacc, L + KI, L + VI, A, wave);
#pragma unroll
        for (int eb = 0; eb < 8; ++eb) sacc[eb] = sacc[eb] * g127;
        __syncthreads();
    }
    GAS f32x4* dst = (GAS f32x4*)Tf + (size_t)(bx * 8 + wave) * 8 * 64 + lane0;
#pragma unroll
    for (int eb = 0; eb < 8; ++eb) dst[eb * 64] = sacc[eb];
}
template <int ABL> __device__ __forceinline__ void ret_out_phase(LAS unsigned char* L, const bf16* ZB, bf16* MIXB, const float* Tf, const float* gn_g, const float* gn_b, int bx, int wave) {
    const int lane0 = xb_fresh_lane(), bh = bx >> 3, cg = bx & 7, b = bh >> 2, h = opaque_s(bh & 3);
    const float lg = to_sgpr(gamma_log(h)), kscale = expf(-(float)((wave * 64 + lane0) >> 2) * lg), qscale = expf((float)((wave * 64 + lane0) >> 2) * lg), g1 = to_sgpr(expf(lg)), g127 = to_sgpr(expf(127.0f * lg)), cd8 = to_sgpr(expf(1024.0f * lg));
    f32x4 sacc[8];
#pragma unroll
    for (int eb = 0; eb < 8; ++eb) sacc[eb] = (f32x4){0.f, 0.f, 0.f, 0.f};
    { float coef = 1.0f;
      for (int g2 = cg - 1; g2 >= 0; --g2) { const GAS f32x4* src = (const GAS f32x4*)Tf + (size_t)((bh * 8 + g2) * 8 + wave) * 8 * 64 + lane0;
#pragma unroll
          for (int eb = 0; eb < 8; ++eb) sacc[eb] = sacc[eb] + src[eb * 64] * coef;
          coef *= cd8; } }
    v4u kr[4], vr[4], qr[4];
    { const size_t m0 = (size_t)b * SEQ + (size_t)(cg * 8) * RC; const int tid0 = wave * 64 + lane0;
      if (!(ABL & 1)) { tile_load(kr, ZB + m0 * ZP + 1024 + h * RD, tid0); tile_load(vr, ZB + m0 * ZP + 1536 + h * RD, tid0); tile_load(qr, ZB + m0 * ZP + 512 + h * RD, tid0); }
      else { for (int c = 0; c < 4; ++c) { kr[c] = (v4u){0u, 0u, 0u, 0u}; vr[c] = kr[c]; qr[c] = kr[c]; } } }
    for (int j = 0; j < 8; ++j) {
        int lane = lane0; asm volatile("" : "+v"(lane));
        const int tid = wave * 64 + lane, g = lane >> 4, li = lane & 15;
        const size_t m0 = (size_t)b * SEQ + (size_t)(cg * 8 + j) * RC;
        if (!(ABL & 2)) { tile_store<true>(L + KI, kr, kscale, tid); tile_store<false>(L + VI, vr, 1.0f, tid); tile_store<true>(L + QI, qr, qscale, tid); }
        LaneAddr A; lane_addr(A, (unsigned)lane);
        { const unsigned stb = 2048u * ((unsigned)li >> 3) + 512u * ((unsigned)wave >> 1) + 64u * ((unsigned)li & 7u) + 16u * ((2u * ((unsigned)wave & 1u) + ((unsigned)g >> 1)) ^ (((unsigned)li >> 2) & 3u)) + 8u * ((unsigned)g & 1u);
#pragma unroll
          for (int eb = 0; eb < 8; ++eb) { const f32x4 sv = sacc[eb] * g1; u32x2 w; w.x = pg8::cvt_pk_bf16(sv[0], sv[1]); w.y = pg8::cvt_pk_bf16(sv[2], sv[3]);
              *(LAS u32x2*)(L + SI + stb + 4096 * eb) = w; } }
        __syncthreads();
        if (j < 7 && !(ABL & 1)) { const size_t m1 = m0 + RC; tile_load(kr, ZB + m1 * ZP + 1024 + h * RD, tid); tile_load(vr, ZB + m1 * ZP + 1536 + h * RD, tid); tile_load(qr, ZB + m1 * ZP + 512 + h * RD, tid); }
        const size_t mrow = m0 + 16 * wave + li;
        u32x2 gw[8];
#pragma unroll
        for (int eb = 0; eb < 8; ++eb) gw[eb] = (ABL & 1) ? (u32x2){0u, 0u} : *(const GAS u32x2*)(ZB + mrow * ZP + 2048 + h * RD + 16 * eb + 4 * g);
        f32x4 o[8];
#pragma unroll
        for (int eb = 0; eb < 8; ++eb) o[eb] = (f32x4){0.f, 0.f, 0.f, 0.f};
        if (!(ABL & 4)) {
        bf16x8 qf[4];
#pragma unroll
        for (int ks = 0; ks < 4; ++ks) qf[ks] = row_frag(L + QI + 4096 * wave, A, 0, ks);
        bf16x8 pf[4];
#pragma unroll
        for (int kp = 0; kp < 4; ++kp) {
            unsigned pw[4] = {0u, 0u, 0u, 0u};
            if (kp <= (wave >> 1)) {
#pragma unroll
                for (int t = 0; t < 2; ++t) {
                    f32x4 x = (f32x4){0.f, 0.f, 0.f, 0.f};
#pragma unroll
                    for (int ks = 0; ks < 4; ++ks) x = MX_MFMA(kap_frag(L + KI, A, kp, t, ks), qf[ks], x);
                    { const int key0 = 32 * kp + 8 * g + 4 * t, ql = 16 * wave + li;
#pragma unroll
                        for (int r = 0; r < 4; ++r) x[r] = (key0 + r <= ql) ? x[r] : 0.f; }
                    pw[2 * t] = pg8::cvt_pk_bf16(x[0], x[1]); pw[2 * t + 1] = pg8::cvt_pk_bf16(x[2], x[3]);
                }
            }
            pf[kp] = __builtin_bit_cast(bf16x8, (v4u){pw[0], pw[1], pw[2], pw[3]});
        }
#pragma unroll
        for (int eb = 0; eb < 8; ++eb) {
#pragma unroll
            for (int ks = 0; ks < 4; ++ks) o[eb] = MX_MFMA(row_frag(L + SI, A, eb, ks), qf[ks], o[eb]);
            }
#pragma unroll
        for (int eb = 0; eb < 8; ++eb) sacc[eb] = sacc[eb] * g1;
#pragma unroll
        for (int kp = 0; kp < 4; ++kp) {
            const bf16x8 kf = (wave & 1) ? tr_frag(L + KI + 512 * (wave >> 1), A, 1, kp) : tr_frag(L + KI + 512 * (wave >> 1), A, 0, kp);
#pragma unroll
            for (int eb = 0; eb < 8; ++eb) { const bf16x8 vf = tr_frag(L + VI, A, eb, kp);
                o[eb] = MX_MFMA(vf, pf[kp], o[eb]);
                sacc[eb] = MX_MFMA(kf, vf, sacc[eb]); }
        }
#pragma unroll
        for (int eb = 0; eb < 8; ++eb) sacc[eb] = sacc[eb] * g127;
        }
        if (!(ABL & 8)) {
        float s1 = 0.f;
#pragma unroll
        for (int eb = 0; eb < 8; ++eb) s1 += (o[eb][0] + o[eb][1]) + (o[eb][2] + o[eb][3]);
        s1 += __shfl_xor(s1, 16); s1 += __shfl_xor(s1, 32);
        const float mean = s1 * (1.0f / RD); float s2 = 0.f;
#pragma unroll
        for (int eb = 0; eb < 8; ++eb) { o[eb] = o[eb] - mean; s2 += (o[eb][0] * o[eb][0] + o[eb][1] * o[eb][1]) + (o[eb][2] * o[eb][2] + o[eb][3] * o[eb][3]); }
        s2 += __shfl_xor(s2, 16); s2 += __shfl_xor(s2, 32);
        const float rstd = rsqrtf(s2 * (1.0f / RD) + LN_EPS);
#pragma unroll
        for (int eb = 0; eb < 8; ++eb) { const int e0 = h * RD + 16 * eb + 4 * g;
            const f32x4 gg = *(const GAS f32x4*)(gn_g + e0), gb = *(const GAS f32x4*)(gn_b + e0);
            const f32x4 gt = (f32x4){__uint_as_float(gw[eb].x << 16), __uint_as_float(gw[eb].x & 0xffff0000u), __uint_as_float(gw[eb].y << 16), __uint_as_float(gw[eb].y & 0xffff0000u)};
            const f32x4 y = (o[eb] * rstd * gg + gb) * (gt * pg8::sig4(gt));
            u32x2 w; w.x = pg8::cvt_pk_bf16(y[0], y[1]); w.y = pg8::cvt_pk_bf16(y[2], y[3]);
            *(GAS u32x2*)(MIXB + mrow * D + CCH + e0) = w; }
        }
        __syncthreads();
    }
}
#undef MX_MFMA
}

struct Args {
    const float* x; const float* p; const int* pos; const float* norm_mix_g; const float* w_in; const float* dw_w; const float* dw_b; const float* ln_g; const float* ln_b;
    const float* gn_g; const float* gn_b; const float* w_out; const float* norm_ffn_g; const float* w_ff1; const float* w_ff2; const float* norm_ple_g; const float* w_gate; const float* w_proj;
    const float* final_g; float* out; unsigned char* ws; int ph_lo, ph_hi, li, pad;
};
__device__ __forceinline__ int inmap(int s) {
    if (s < 512) return 256 * (s >> 7) + (s & 127);
    if (s < 1024) { const int ch = s - 512; return 256 * (ch >> 7) + 128 + (ch & 127); }
    if (s < 2048) { const int k = s >= 1536, r = s - (k ? 1536 : 1024), hq = r >> 7, dd = r & 127; return 256 * ((k ? 6 : 4) + (hq >> 1)) + 128 * (dd >> 6) + 64 * (hq & 1) + (dd & 63); }
    return s;
}
template <bool INMAP> __device__ __forceinline__ void tr_item(const float* W, int K, int N, const float* gain, bf16* WT, LAS float* scr, int item, int lane) {
    const int nblk = N / 32, kb = item / nblk, nb = item % nblk, k0 = 64 * kb, n0 = 32 * nb;
#pragma unroll 8
    for (int i = 0; i < 32; ++i) { const int kk = 2 * i + (lane >> 5); scr[kk * 33 + (lane & 31)] = W[(size_t)(k0 + kk) * N + n0 + (lane & 31)] * (gain ? gain[k0 + kk] : 1.0f); }
    LDS_WAIT(); asm volatile("" ::: "memory");
    const int c = lane & 7;
#pragma unroll
    for (int j = 0; j < 4; ++j) { const int n = (lane >> 3) + 8 * j; const LAS float* s = scr + (8 * c) * 33 + n;
        const int src = n0 + n; const int r = INMAP ? inmap(src) : src; const float cs = (INMAP && src >= 1536 && src < 2048) ? 0.088388347648318447f : 1.0f;
        v4u o; o.x = pk2(s[0 * 33] * cs, s[1 * 33] * cs); o.y = pk2(s[2 * 33] * cs, s[3 * 33] * cs); o.z = pk2(s[4 * 33] * cs, s[5 * 33] * cs); o.w = pk2(s[6 * 33] * cs, s[7 * 33] * cs);
        *(GAS v4u*)(WT + (size_t)r * K + k0 + 8 * c) = o; }
    LDS_WAIT(); asm volatile("" ::: "memory");
}

__device__ __forceinline__ const void* lds_ptr(LAS unsigned char* p) {
    const unsigned lo = __builtin_amdgcn_readfirstlane(((volatile LAS unsigned*)p)[0]), hi = __builtin_amdgcn_readfirstlane(((volatile LAS unsigned*)p)[1]);
    return (const void*)(((unsigned long long)hi << 32) | lo);
}
#ifndef PROBE_DUP
#define PROBE_DUP (-1)
#endif
#ifndef PROBE_ABL
#define PROBE_ABL 0
#endif
#define DUPN(k) ((PROBE_DUP == (k)) ? 2 : 1)
__global__ void __launch_bounds__(NWAVES * 64, 2) mk_fwd(Args a) {
    extern __shared__ __attribute__((aligned(16))) unsigned char lds[];
    LAS unsigned char* const L = (LAS unsigned char*)lds;
    volatile LAS unsigned* MISC = (volatile LAS unsigned*)(L + MISC_OFF);
    const int wave = __builtin_amdgcn_readfirstlane(threadIdx.x >> 6);
#define LANE_ID() xb_fresh_lane()
    const int G = gridDim.x, bx = blockIdx.x;
    unsigned char* ws = a.ws;
    gu32* ctl = (gu32*)(ws + WS_CTL);
    if (threadIdx.x < 64) MISC[threadIdx.x] = 0u;
    if (threadIdx.x < sizeof(Args) / 4) ((volatile LAS unsigned*)(L + ARGS_OFF))[threadIdx.x] = ((const unsigned*)&a)[threadIdx.x];
    __syncthreads();
#define ARGP(field) ((decltype(a.field))lds_ptr(L + ARGS_OFF + offsetof(Args, field)))
    XcdBarrier bar = xcd_barrier_post((unsigned*)(ctl + CW_BAR) + a.li * XCD_BAR_WORDS, MISC + 8, wave);
    const int lo = a.ph_lo, hi = a.ph_hi;
#define IN(k) (lo <= (k) && (k) < hi)
#define SEAM(k) do { if (IN(k) && IN((k) + 1)) xcd_barrier(bar); } while (0)
    const int gw = bx * NWAVES + wave, NGW = G * NWAVES;
    const size_t NGT = (size_t)G * NWAVES * 64;
    bf16* const XB = (bf16*)(ws + WS_XB); bf16* const ZB = (bf16*)(ws + WS_ZB); bf16* const MIXB = (bf16*)(ws + WS_MIX); bf16* const HID = (bf16*)(ws + WS_HID);
    bf16* const XO = (bf16*)a.out;
    float* const TF = (float*)(ws + WS_T);
    LAS float* const RED = (LAS float*)(L + RED_OFF);
    bf16* const PROJ = (bf16*)(ws + WS_PROJ); bf16* const PB = (bf16*)(ws + WS_PB); unsigned* const ROPE = (unsigned*)(ws + WS_ROPE);

    if (IN(0))
#pragma clang loop unroll(full)
    for (int rep = 0; rep < DUPN(0); ++rep) {
        const int lane = LANE_ID(); const size_t gt = (size_t)bx * (NWAVES * 64) + wave * 64 + lane;
        LAS float* scr = (LAS float*)(L + RING_OFF + wave * 16384);
        constexpr int I_IN = (D / 64) * (INC / 32), I_OUT = (D / 64) * (D / 32), I_F1 = (D / 64) * (FF / 32), I_F2 = (FF / 64) * (D / 32), I_G = I_OUT, I_P = (PLE / 64) * (D / 32);
        constexpr int I_LAYER = I_IN + I_OUT + I_F1 + I_F2 + I_G + I_P;
        for (int it = gw; it < DEPTH * I_LAYER; it += NGW) {
            const int l = it / I_LAYER; int r = it % I_LAYER; unsigned char* wl = ws + WS_W + (size_t)l * W_LAYER;
            if (r < I_IN) { tr_item<true>(a.w_in + (size_t)l * D * INC, D, INC, a.norm_mix_g + l * D, (bf16*)(wl + WO_IN), scr, r, lane); continue; } r -= I_IN;
            if (r < I_OUT) { tr_item<false>(a.w_out + (size_t)l * D * D, D, D, nullptr, (bf16*)(wl + WO_OUT), scr, r, lane); continue; } r -= I_OUT;
            if (r < I_F1) { tr_item<false>(a.w_ff1 + (size_t)l * D * FF, D, FF, a.norm_ffn_g + l * D, (bf16*)(wl + WO_FF1), scr, r, lane); continue; } r -= I_F1;
            if (r < I_F2) { tr_item<false>(a.w_ff2 + (size_t)l * FF * D, FF, D, nullptr, (bf16*)(wl + WO_FF2), scr, r, lane); continue; } r -= I_F2;
            if (r < I_G) { tr_item<false>(a.w_gate + (size_t)l * D * D, D, D, a.norm_ple_g + l * D, (bf16*)(wl + WO_GATE), scr, r, lane); continue; } r -= I_G;
            tr_item<false>(a.w_proj + (size_t)l * PLE * D, PLE, D, nullptr, (bf16*)(wl + WO_PROJ), scr, r, lane);
        }
        float* ss0 = (float*)(ws + WS_SS);
        for (int m = gw; m < M; m += NGW) {
            const GAS f32x4* xr = (const GAS f32x4*)(a.x + (size_t)m * D) + lane; f32x4 v[4]; float s = 0.f;
#pragma unroll
            for (int j = 0; j < 4; ++j) { v[j] = xr[64 * j]; s += (v[j].x * v[j].x + v[j].y * v[j].y) + (v[j].z * v[j].z + v[j].w * v[j].w); }
            s = wave_sum(s);
            GAS unsigned long long* o8 = (GAS unsigned long long*)(XB + (size_t)m * D) + lane;
#pragma unroll
            for (int j = 0; j < 4; ++j) o8[64 * j] = (unsigned long long)pk2(v[j].x, v[j].y) | ((unsigned long long)pk2(v[j].z, v[j].w) << 32);
            if (lane < 4) ss0[(size_t)m * 4 + lane] = lane == 0 ? s : 0.f;
        }
        for (size_t i = gt; i < (size_t)DEPTH * M * PLE / 8; i += NGT) {
            const f32x4 p0 = *(const GAS f32x4*)(a.p + i * 8), p1 = *(const GAS f32x4*)(a.p + i * 8 + 4);
            v4u o; o.x = pk2(p0.x, p0.y); o.y = pk2(p0.z, p0.w); o.z = pk2(p1.x, p1.y); o.w = pk2(p1.z, p1.w);
            *(GAS v4u*)(PB + i * 8) = o;
        }
        for (size_t i = gt; i < (size_t)M * 64; i += NGT) {
            const int d = (int)(i & 63); const size_t m = i >> 6;
            const float inv_freq = 1.0f / powf(10000.0f, (float)d * (2.0f / RD)), ang = (float)a.pos[m] * inv_freq;
            const pg8::f16x2 cs = {(_Float16)cosf(ang), (_Float16)sinf(ang)};
            ROPE[i] = __builtin_bit_cast(unsigned, cs);
        }
    }
    SEAM(0);
#pragma clang loop unroll(full)
    for (int l = 0; l < DEPTH; ++l) {
        const int pb = 1 + 8 * l;
        bf16* const XC = (l & 1) ? XO : XB; bf16* const XN = (l & 1) ? XB : XO;
        unsigned char* wl = ws + WS_W + (size_t)l * W_LAYER;
        float* const ss_a = (float*)(ws + WS_SS + (size_t)(3 * l + 0) * SS_SITE);
        float* const ss_b = (float*)(ws + WS_SS + (size_t)(3 * l + 1) * SS_SITE);
        float* const ss_c = (float*)(ws + WS_SS + (size_t)(3 * l + 2) * SS_SITE);
        float* const ss_d = (float*)(ws + WS_SS + (size_t)(3 * l + 3) * SS_SITE);
        if (IN(pb + 0))
#pragma clang loop unroll(full)
        for (int rep = 0; rep < DUPN(pb + 0); ++rep) {
            pg8::Gemm g{XC, (const bf16*)(wl + WO_IN), M, INC, D}; pg8::StaticOrder S; S.init(M, INC, G, bx);
            pg8::EpiInProj E{ZB, ss_a, ROPE};
            pg8::gemm_phase<pg8::EpiInProj, pg8::StaticOrder, true, true>(L + RING_OFF, g, S, E, wave);
        }
        SEAM(pb + 0);
        if (IN(pb + 1))
#pragma clang loop unroll(full)
        for (int rep = 0; rep < DUPN(pb + 1); ++rep) {
            if (!(DUPN(pb + 1) == 2 && rep == 0 && (PROBE_ABL & 1))) mx::conv_phase(L, ZB, MIXB, ARGP(dw_w) + l * CONVW * CCH, ARGP(dw_b) + l * CCH, ARGP(ln_g) + l * CCH, ARGP(ln_b) + l * CCH, bx, wave);
            if (!(DUPN(pb + 1) == 2 && rep == 0 && (PROBE_ABL & 2))) mx::ret_state_phase(L, ZB, TF, bx, wave);
        }
        SEAM(pb + 1);
        if (IN(pb + 2))
#pragma clang loop unroll(full)
        for (int rep = 0; rep < DUPN(pb + 2); ++rep) {
            if (DUPN(pb + 2) == 2 && rep == 0) mx::ret_out_phase<PROBE_ABL>(L, ZB, MIXB, TF, ARGP(gn_g) + l * RW, ARGP(gn_b) + l * RW, bx, wave);
            else mx::ret_out_phase<0>(L, ZB, MIXB, TF, ARGP(gn_g) + l * RW, ARGP(gn_b) + l * RW, bx, wave);
        }
        SEAM(pb + 2);
        if (IN(pb + 3))
#pragma clang loop unroll(full)
        for (int rep = 0; rep < 1; ++rep) {
            pg8::Gemm g{MIXB, (const bf16*)(wl + WO_OUT), M, D, D}; pg8::StaticOrder S; S.init(M, D, G, bx);
            pg8::EpiResid<0> E{XC, XC, ss_b, nullptr, nullptr, RED};
            pg8::gemm_phase<pg8::EpiResid<0>, pg8::StaticOrder, true, true>(L + RING_OFF, g, S, E, wave);
        }
        SEAM(pb + 3);
        if (IN(pb + 4))
#pragma clang loop unroll(full)
        for (int rep = 0; rep < DUPN(pb + 4); ++rep) {
            pg8::Gemm g{XC, (const bf16*)(wl + WO_FF1), M, FF, D}; pg8::StaticOrder S; S.init(M, FF, G, bx);
            pg8::EpiFF1 E{HID, ss_b};
            pg8::gemm_phase<pg8::EpiFF1, pg8::StaticOrder, true, true>(L + RING_OFF, g, S, E, wave);
        }
        SEAM(pb + 4);
        if (IN(pb + 5))
#pragma clang loop unroll(full)
        for (int rep = 0; rep < DUPN(pb + 5); ++rep) {
            const bool dummy = (DUPN(pb + 5) == 2 && rep == 0);
            pg8::Gemm g{HID, (const bf16*)(wl + WO_FF2), M, D, FF}; pg8::StaticOrder S; S.init(M, D, G, bx);
            pg8::EpiResid<0> E{XC, dummy ? PROJ : XC, dummy ? (float*)(ws + WS_SS + (size_t)6 * SS_SITE) : ss_c, nullptr, nullptr, RED};
            pg8::gemm_phase<pg8::EpiResid<0>, pg8::StaticOrder, true, true>(L + RING_OFF, g, S, E, wave);
        }
        SEAM(pb + 5);
        if (IN(pb + 6))
#pragma clang loop unroll(full)
        for (int rep = 0; rep < DUPN(pb + 6); ++rep) {
            pg8::Gemm g{PB + (size_t)l * M * PLE, (const bf16*)(wl + WO_PROJ), M, D, PLE}; pg8::StaticOrder S; S.init(M, D, G, bx);
            pg8::EpiPlain E{PROJ};
            pg8::gemm_phase<pg8::EpiPlain, pg8::StaticOrder, true, true>(L + RING_OFF, g, S, E, wave);
        }
        SEAM(pb + 6);
        if (IN(pb + 7)) {
            pg8::Gemm g{XC, (const bf16*)(wl + WO_GATE), M, D, D}; pg8::StaticOrder S; S.init(M, D, G, bx);
            pg8::EpiResid<1> E{XC, XN, ss_d, ss_c, PROJ, RED};
            pg8::gemm_phase<pg8::EpiResid<1>, pg8::StaticOrder, true, true>(L + RING_OFF, g, S, E, wave);
        }
        SEAM(pb + 7);
    }
    if (IN(17)) {
        const int lane = LANE_ID();
        const float* ssf = (const float*)(ws + WS_SS + (size_t)6 * SS_SITE);
        const bf16* XF = (DEPTH & 1) ? XO : XB;
        const GAS f32x4* gr = (const GAS f32x4*)ARGP(final_g) + 2 * lane; const f32x4 g0 = gr[0], g1 = gr[1], g2 = gr[128], g3 = gr[129];
        for (int m = gw; m < M; m += NGW) {
            const float rs = pg8::rstd_of(ssf, m);
            const GAS v4u* xr = (const GAS v4u*)(XF + (size_t)m * D) + lane; GAS f32x4* orow = (GAS f32x4*)(a.out + (size_t)m * D) + 2 * lane;
            f32x4 a0, a1, b0, b1; pg8::unpack8(xr[0], a0, a1); pg8::unpack8(xr[64], b0, b1);
            orow[0] = a0 * rs * g0; orow[1] = a1 * rs * g1; orow[128] = b0 * rs * g2; orow[129] = b1 * rs * g3;
        }
    }
#undef IN
#undef SEAM
}

extern "C" void kernel_launch(void* const* d_in, const int* in_sizes, int n_in, void* d_out, int out_size, void* d_ws, size_t ws_size, hipStream_t stream) {
    static int grid = 0;
    if (grid == 0) {
        if (n_in != 19 || out_size != M * D || ws_size < WS_END) { fprintf(stderr, "kernel_launch: unexpected problem (n_in %d, out %d, ws %zu < %zu); nothing launched\n", n_in, out_size, ws_size, (size_t)WS_END); grid = -1; return; }
        int dev = 0, cus = 0;
        if (hipGetDevice(&dev) != hipSuccess || hipDeviceGetAttribute(&cus, hipDeviceAttributeMultiprocessorCount, dev) != hipSuccess) { grid = -1; return; }
        if (hipFuncSetAttribute((const void*)mk_fwd, hipFuncAttributeMaxDynamicSharedMemorySize, LDS_BYTES) != hipSuccess) { fprintf(stderr, "kernel_launch: hipFuncSetAttribute failed\n"); grid = -1; return; }
        int per_cu = 0;
        if (hipOccupancyMaxActiveBlocksPerMultiprocessor(&per_cu, (const void*)mk_fwd, NWAVES * 64, LDS_BYTES) != hipSuccess || per_cu < 1) fprintf(stderr, "kernel_launch: occupancy query says %d\n", per_cu);
        (void)hipGetLastError();
        if (cus < 256) fprintf(stderr, "kernel_launch: %d CUs < 256: the grid cannot be resident\n", cus);
        grid = 256;
    }
    if (grid < 0) return;
    (void)hipMemsetAsync((char*)d_ws + WS_CTL, 0, CTL_ZERO_BYTES, stream);
    Args a{};
    a.x = (const float*)d_in[0]; a.p = (const float*)d_in[1]; a.pos = (const int*)d_in[2]; a.norm_mix_g = (const float*)d_in[3]; a.w_in = (const float*)d_in[4]; a.dw_w = (const float*)d_in[5];
    a.dw_b = (const float*)d_in[6]; a.ln_g = (const float*)d_in[7]; a.ln_b = (const float*)d_in[8]; a.gn_g = (const float*)d_in[9]; a.gn_b = (const float*)d_in[10]; a.w_out = (const float*)d_in[11];
    a.norm_ffn_g = (const float*)d_in[12]; a.w_ff1 = (const float*)d_in[13]; a.w_ff2 = (const float*)d_in[14]; a.norm_ple_g = (const float*)d_in[15]; a.w_gate = (const float*)d_in[16];
    a.w_proj = (const float*)d_in[17]; a.final_g = (const float*)d_in[18]; a.out = (float*)d_out; a.ws = (unsigned char*)d_ws;
    a.ph_lo = 0; a.ph_hi = 18; a.li = 0;
    hipLaunchKernelGGL(mk_fwd, dim3(grid), dim3(NWAVES * 64), LDS_BYTES, stream, a);
}
```

```cpp
#include <hip/hip_runtime.h>
#include <cstdio>
#include <cstdint>
#include <cstddef>
namespace pg8 {
#define PG8_LAS __attribute__((address_space(3)))
typedef unsigned short bf16_t;
typedef short bf16x8 __attribute__((ext_vector_type(8)));
typedef float f32x4 __attribute__((ext_vector_type(4)));
typedef unsigned u32x4 __attribute__((ext_vector_type(4)));
typedef unsigned u32x2 __attribute__((ext_vector_type(2)));
constexpr int BM = 256, BK = 64, HALF = 128, HTB = HALF * BK * 2  , STAGE_BYTES = 8 * HTB, NXCD = 8, WGM = 8;

__host__ __device__ __forceinline__ int lds_byte(int r, int c) { const int st = (r >> 4) * 2 + (c >> 5), rr = r & 15, cc = c & 31, ob = rr * 64 + cc * 2; return st * 1024 + (ob ^ (((ob >> 9) & 1) << 5)); }
__host__ __device__ __forceinline__ void stage_rc(int b, int& R, int& C) { const int st = b / 1024, sb = b % 1024, swz = sb ^ (((sb >> 9) & 1) << 5); R = (st >> 1) * 16 + swz / 64; C = (st & 1) * 32 + (swz % 64) / 2; }
__host__ __device__ __forceinline__ int perm32(int rho) { const int n = rho >> 4, i = rho & 15; return 8 * (i >> 2) + 4 * n + (i & 3); }

struct Unit { int pm, pn; };
struct Gemm { const bf16_t* A; const bf16_t* Bt; int M, N, K; };

struct StaticOrder {
    int nM, nN, nwg, G, c;
    __host__ __device__ void init(int M, int N, int G_, int c_) { nM = M / BM; nN = N / BM; nwg = nM * nN; G = G_; c = c_; }
    __host__ __device__ bool next(int i, Unit& u) const {
        const long L = (long)i * G + c; if (L >= nwg) return false;
        int wgid = (int)L; { const int q = nwg / NXCD, r = nwg % NXCD, xcd = wgid % NXCD, off = wgid / NXCD; wgid = (xcd < r ? xcd * (q + 1) : r * (q + 1) + (xcd - r) * q) + off; }
        const int nig = WGM * nN, gid = wgid / nig, fm = gid * WGM, gsz = (nM - fm) < WGM ? (nM - fm) : WGM;
        u.pm = fm + ((wgid % nig) % gsz); u.pn = (wgid % nig) / gsz; return true;
    }
    __device__ __forceinline__ void a_ready(const Unit&) const {}
    __device__ __forceinline__ void done(const Unit&) const {}
};

__device__ __forceinline__ unsigned cvt_pk_bf16(float lo, float hi) { unsigned r; asm volatile("v_cvt_pk_bf16_f32 %0, %1, %2" : "=v"(r) : "v"(lo), "v"(hi)); return r; }
__device__ __forceinline__ u32x4 pack8(const f32x4 a, const f32x4 b) { u32x4 w; w.x = cvt_pk_bf16(a[0], a[1]); w.y = cvt_pk_bf16(a[2], a[3]); w.z = cvt_pk_bf16(b[0], b[1]); w.w = cvt_pk_bf16(b[2], b[3]); return w; }
__device__ __forceinline__ float fast_sigmoid(float x) { return __builtin_amdgcn_rcpf(1.0f + __builtin_amdgcn_exp2f(x * -1.4426950408889634f)); }
__device__ __forceinline__ f32x4 sig4(const f32x4 v) { return (f32x4){fast_sigmoid(v[0]), fast_sigmoid(v[1]), fast_sigmoid(v[2]), fast_sigmoid(v[3])}; }
constexpr int SSP = 4;
constexpr float RMS_EPS_ = 1e-6f;
__device__ __forceinline__ float rstd_from(const f32x4 s) { return rsqrtf(((s[0] + s[1]) + (s[2] + s[3])) * (1.0f / 1024.0f) + RMS_EPS_); }
__device__ __forceinline__ float rstd_of(const float* ss, int row) { return rstd_from(*(const f32x4*)(ss + (size_t)row * SSP)); }
__device__ __forceinline__ void rstd8(const float* ss, int row0, float (&rs)[2][4]) {
    f32x4 sp[2][4];
#pragma unroll
    for (int ai = 0; ai < 2; ++ai)
#pragma unroll
        for (int m = 0; m < 4; ++m) sp[ai][m] = *(const f32x4*)(ss + (size_t)(row0 + ai * HALF + m * 16) * SSP);
#pragma unroll
    for (int ai = 0; ai < 2; ++ai)
#pragma unroll
        for (int m = 0; m < 4; ++m) rs[ai][m] = rstd_from(sp[ai][m]);
}
typedef _Float16 f16x2 __attribute__((ext_vector_type(2)));
__device__ __forceinline__ void ss_prefetch(const float* ss, PG8_LAS float* ssl, const Unit& u, int wid, int lane) {
    if (wid < 4) __builtin_amdgcn_global_load_lds((const unsigned*)(ss + ((size_t)u.pm * BM + wid * 64 + lane) * SSP), (PG8_LAS unsigned*)(ssl + wid * 256), 16, 0, 0);
}
__device__ __forceinline__ void rstd8_lds(const PG8_LAS float* ssl, int rl0, float (&rs)[2][4]) {
#pragma unroll
    for (int ai = 0; ai < 2; ++ai)
#pragma unroll
        for (int m = 0; m < 4; ++m) rs[ai][m] = rstd_from(*(const PG8_LAS f32x4*)(ssl + (rl0 + ai * HALF + m * 16) * SSP));
}

struct EpiInProj {
    static constexpr bool PERM = true, AFTER_DRAIN = false;
    bf16_t* ZB; const float* ss; const unsigned* rope; PG8_LAS float* ssl;
    __device__ __forceinline__ void prefetch(const Unit& u, int wid, int lane) const { ss_prefetch(ss, ssl, u, wid, lane); }
    static constexpr int ZP = 2560;
    __device__ __forceinline__ int nstores(const Unit& u) const { return u.pn < 8 ? 8 : 16; }
    __device__ __forceinline__ void operator()(const f32x4 (&acc)[2][2][4][2], const Unit& u, int wr, int wc, int fr, int fq) const {
        const int row0 = u.pm * BM + wr * 64 + fr, pn = u.pn, lc = wc * 32 + 8 * fq;
        float rs[2][4]; rstd8_lds(ssl, wr * 64 + fr, rs);
        if (pn < 4) {
#pragma unroll
            for (int ai = 0; ai < 2; ++ai)
#pragma unroll
                for (int m = 0; m < 4; ++m) { const int row = row0 + ai * HALF + m * 16; const float r = rs[ai][m];
                    const f32x4 h0 = (acc[ai][0][m][0] * r) * sig4(acc[ai][1][m][0] * r), h1 = (acc[ai][0][m][1] * r) * sig4(acc[ai][1][m][1] * r);
                    *(u32x4*)(ZB + (size_t)row * ZP + pn * 128 + lc) = pack8(h0, h1); }
        } else if (pn < 8) {
            const int head = 2 * (pn & 1) + (wc >> 1), d0 = lc & 63, colb = 512 + 512 * head + (pn < 6 ? 0 : 128) + d0;
#pragma unroll
            for (int ai = 0; ai < 2; ++ai) {
                u32x4 r0[4], r1[4];
#pragma unroll
                for (int m = 0; m < 4; ++m) { const u32x4* rp = (const u32x4*)(rope + (size_t)(row0 + ai * HALF + m * 16) * 64 + d0); r0[m] = rp[0]; r1[m] = rp[1]; }
#pragma unroll
                for (int m = 0; m < 4; ++m) { const int row = row0 + ai * HALF + m * 16; const float r = rs[ai][m];
                    f32x4 o1[2], o2[2];
                    const unsigned rv[8] = {r0[m].x, r0[m].y, r0[m].z, r0[m].w, r1[m].x, r1[m].y, r1[m].z, r1[m].w};
#pragma unroll
                    for (int n = 0; n < 2; ++n) {
#pragma unroll
                        for (int i = 0; i < 4; ++i) { const f16x2 cs = __builtin_bit_cast(f16x2, rv[4 * n + i]); const float c = (float)cs[0], s = (float)cs[1];
                            const float t1 = acc[ai][0][m][n][i] * r, t2 = acc[ai][1][m][n][i] * r; o1[n][i] = t1 * c - t2 * s; o2[n][i] = t2 * c + t1 * s; } }
                    bf16_t* zp = ZB + (size_t)row * ZP + colb; *(u32x4*)zp = pack8(o1[0], o1[1]); *(u32x4*)(zp + 64) = pack8(o2[0], o2[1]); }
                asm volatile("" ::: "memory"); }
        } else {
            const int colb = 512 + 1024 * (pn & 1) + (pn < 10 ? 256 : 384) + lc;
#pragma unroll
            for (int ai = 0; ai < 2; ++ai)
#pragma unroll
                for (int m = 0; m < 4; ++m) { const int row = row0 + ai * HALF + m * 16; const float r = rs[ai][m];
#pragma unroll
                    for (int bj = 0; bj < 2; ++bj) *(u32x4*)(ZB + (size_t)row * ZP + colb + bj * 512) = pack8(acc[ai][bj][m][0] * r, acc[ai][bj][m][1] * r); }
        }
    }
};
__device__ __forceinline__ void unpack8(const u32x4 w, f32x4& a, f32x4& b) {
    a = (f32x4){__uint_as_float(w.x << 16), __uint_as_float(w.x & 0xffff0000u), __uint_as_float(w.y << 16), __uint_as_float(w.y & 0xffff0000u)};
    b = (f32x4){__uint_as_float(w.z << 16), __uint_as_float(w.z & 0xffff0000u), __uint_as_float(w.w << 16), __uint_as_float(w.w & 0xffff0000u)};
}
template <int MODE> struct EpiResid {
    static constexpr bool PERM = true, AFTER_DRAIN = false;
    const bf16_t* XI; bf16_t* XO; float* ss_out; const float* ss_in; const bf16_t* proj; PG8_LAS float* red; PG8_LAS float* ssl;
    __device__ __forceinline__ void prefetch(const Unit& u, int wid, int lane) const { if (MODE == 1) ss_prefetch(ss_in, ssl, u, wid, lane); }
    __device__ __forceinline__ int nstores(const Unit&) const { return MODE == 1 ? 4 : 16; }
    __device__ __forceinline__ void operator()(const f32x4 (&acc)[2][2][4][2], const Unit& u, int wr, int wc, int fr, int fq) const {
        const int row0 = u.pm * BM + wr * 64 + fr, col0 = u.pn * BM + wc * 32 + 8 * fq;
        float rs[2][4];
        if (MODE == 1) rstd8_lds(ssl, wr * 64 + fr, rs);
        constexpr int NB = (MODE == 1) ? 2 : 8;
#pragma unroll
        for (int gb = 0; gb < 8; gb += NB) {
            u32x4 xb[NB][2], pb[NB][2];
#pragma unroll
            for (int mm = 0; mm < NB; ++mm)
#pragma unroll
                for (int bj = 0; bj < 2; ++bj) { const int ai = (gb + mm) >> 2, m = (gb + mm) & 3; const size_t off = (size_t)(row0 + ai * HALF + m * 16) * 1024 + col0 + bj * HALF; xb[mm][bj] = *(const u32x4*)(XI + off); if (MODE == 1) pb[mm][bj] = *(const u32x4*)(proj + off); }
#pragma unroll
            for (int mm = 0; mm < NB; ++mm) { const int ai = (gb + mm) >> 2, m = (gb + mm) & 3; const size_t off = (size_t)(row0 + ai * HALF + m * 16) * 1024 + col0; float q = 0.f;
#pragma unroll
                for (int bj = 0; bj < 2; ++bj) { f32x4 b0, b1; unpack8(xb[mm][bj], b0, b1);
                    f32x4 v0, v1;
                    if (MODE == 1) { f32x4 p0, p1; unpack8(pb[mm][bj], p0, p1); const float r = rs[ai][m];
                        v0 = b0 + sig4(acc[ai][bj][m][0] * r) * p0; v1 = b1 + sig4(acc[ai][bj][m][1] * r) * p1; }
                    else { v0 = b0 + acc[ai][bj][m][0]; v1 = b1 + acc[ai][bj][m][1]; }
                    *(u32x4*)(XO + off + bj * HALF) = pack8(v0, v1);
                    q += (v0[0] * v0[0] + v0[1] * v0[1]) + (v0[2] * v0[2] + v0[3] * v0[3]) + (v1[0] * v1[0] + v1[1] * v1[1]) + (v1[2] * v1[2] + v1[3] * v1[3]); }
                q += __shfl_xor(q, 16); q += __shfl_xor(q, 32);
                if (fq == 0) red[(ai * HALF + wr * 64 + m * 16 + fr) * 4 + wc] = q; }
            asm volatile("" ::: "memory"); }
        asm volatile("s_waitcnt lgkmcnt(0)" ::: "memory"); __builtin_amdgcn_s_barrier(); asm volatile("" ::: "memory");
        const int t = (wr * 4 + wc) * 64 + fq * 16 + fr;
        if (t < 256) { const f32x4 s4 = *(const PG8_LAS f32x4*)(red + t * 4); ss_out[(size_t)(u.pm * BM + t) * SSP + u.pn] = (s4[0] + s4[1]) + (s4[2] + s4[3]); }
    }
};
struct EpiFF1 {
    static constexpr bool PERM = true, AFTER_DRAIN = false;
    bf16_t* H; const float* ss; int probe; PG8_LAS float* ssl;
    __device__ __forceinline__ void prefetch(const Unit& u, int wid, int lane) const { ss_prefetch(ss, ssl, u, wid, lane); }
    __device__ __forceinline__ int nstores(const Unit&) const { return (probe & 1) ? 0 : 16; }
    __device__ __forceinline__ void operator()(const f32x4 (&acc)[2][2][4][2], const Unit& u, int wr, int wc, int fr, int fq) const {
        const int row0 = u.pm * BM + wr * 64 + fr, col0 = u.pn * BM + wc * 32 + 8 * fq;
        float rs8[2][4];
        if (probe & 2) { for (int ai = 0; ai < 2; ++ai) for (int m = 0; m < 4; ++m) rs8[ai][m] = 1.0f; } else rstd8_lds(ssl, wr * 64 + fr, rs8);
#pragma unroll
        for (int ai = 0; ai < 2; ++ai)
#pragma unroll
            for (int m = 0; m < 4; ++m) { const int row = row0 + ai * HALF + m * 16; const float rs = rs8[ai][m];
#pragma unroll
                for (int bj = 0; bj < 2; ++bj) { f32x4 v0 = acc[ai][bj][m][0] * rs, v1 = acc[ai][bj][m][1] * rs;
                    v0 = __builtin_elementwise_max(v0, (f32x4){0.f, 0.f, 0.f, 0.f}); v1 = __builtin_elementwise_max(v1, (f32x4){0.f, 0.f, 0.f, 0.f}); v0 = v0 * v0; v1 = v1 * v1;
                    const u32x4 w = pack8(v0, v1);
                    if (probe & 1) asm volatile("" :: "v"(w));
                    else if (probe & 4) *(u32x4*)(H + (size_t)(u.pm * 16 + u.pn) * 65536 + (size_t)((wr * 4 + wc) * 16 + (ai * 4 + m) * 2 + bj) * 512 + (fq * 16 + fr) * 8) = w;
                    else *(u32x4*)(H + (size_t)row * 4096 + col0 + bj * HALF) = w; } }
    }
};
struct EpiPlain {
    static constexpr bool PERM = true, AFTER_DRAIN = false;
    bf16_t* O;
    __device__ __forceinline__ int nstores(const Unit&) const { return 16; }
    __device__ __forceinline__ void prefetch(const Unit&, int, int) const {}
    __device__ __forceinline__ void operator()(const f32x4 (&acc)[2][2][4][2], const Unit& u, int wr, int wc, int fr, int fq) const {
        const int row0 = u.pm * BM + wr * 64 + fr, col0 = u.pn * BM + wc * 32 + 8 * fq;
        asm volatile("s_nop 15\n\ts_nop 15" ::: "memory");
#pragma unroll
        for (int ai = 0; ai < 2; ++ai)
#pragma unroll
            for (int m = 0; m < 4; ++m) { const int row = row0 + ai * HALF + m * 16;
#pragma unroll
                for (int bj = 0; bj < 2; ++bj) *(u32x4*)(O + (size_t)row * 1024 + col0 + bj * HALF) = pack8(acc[ai][bj][m][0], acc[ai][bj][m][1]); }
    }
};

template <class Epi, class Sched, bool ALIGN_EPI = false, bool SP2 = false>
__device__ __forceinline__ void gemm_phase(PG8_LAS unsigned char* lds, const Gemm g, const Sched& S, const Epi& E, const int wave_id) {
    unsigned z_ = 0u; asm volatile("" : "+v"(z_)); const int tid_ = wave_id * 64 + (int)__builtin_amdgcn_mbcnt_hi(~0u, __builtin_amdgcn_mbcnt_lo(~0u, z_));
    const int tid = tid_, wid = wave_id, lane = tid & 63, wr = wid >> 2, wc = wid & 3, fr = lane & 15, fq = lane >> 4;
    const int K = g.K, nt = K / BK;
    static_assert(SP2 && ALIGN_EPI, "this copy of the body is only maintained for the SP2 + ALIGN_EPI configuration (the store-slack logic lives in that path)");
    unsigned voffA[2], voffB[2];
#pragma unroll
    for (int i = 0; i < 2; ++i) { int R, C; stage_rc(tid * 16 + i * 8192, R, C); const int Rb = Epi::PERM ? ((R & ~31) + perm32(R & 31)) : R;
        voffA[i] = (unsigned)(R * K + C) * 2u; voffB[i] = (unsigned)(Rb * K + C) * 2u; }
    const size_t kstep = (size_t)(BK * 2);
    const size_t hstep = (size_t)HALF * K * 2;
    const size_t tstep = 2 * hstep;
    const unsigned ldsw = (unsigned)wid * 1024u;
    const int aoff = lds_byte(wr * 64 + fr, fq * 8), boff = lds_byte(wc * 32 + fr, fq * 8);
#define PG8_SA(b, h) (((b) * 2 + (h)) * HTB)
#define PG8_SB(b, h) ((4 + (b) * 2 + (h)) * HTB)
#define PG8_STAGE(bufoff, gbase, voff) do { _Pragma("unroll") for (int _i = 0; _i < 2; ++_i) \
        __builtin_amdgcn_global_load_lds((const unsigned*)((const char*)(gbase) + (voff)[_i]), (PG8_LAS unsigned*)(lds + (bufoff) + ldsw + _i * 8192), 16, 0, 0); } while (0)
#define PG8_LDA(dst, b, h) do { _Pragma("unroll") for (int m = 0; m < 4; ++m) _Pragma("unroll") for (int k = 0; k < 2; ++k) dst[m][k] = *(const PG8_LAS bf16x8*)(lds + PG8_SA(b, h) + aoff + m * 2048 + k * 1024); } while (0)
#define PG8_LDB(dst, b, h) do { _Pragma("unroll") for (int n = 0; n < 2; ++n) _Pragma("unroll") for (int k = 0; k < 2; ++k) dst[n][k] = *(const PG8_LAS bf16x8*)(lds + PG8_SB(b, h) + boff + n * 2048 + k * 1024); } while (0)
#define PG8_MMA(ai, bj, At, Bt) do { __builtin_amdgcn_s_setprio(1); _Pragma("unroll") for (int m = 0; m < 4; ++m) _Pragma("unroll") for (int n = 0; n < 2; ++n) _Pragma("unroll") for (int k = 0; k < 2; ++k) \
        acc[ai][bj][m][n] = __builtin_amdgcn_mfma_f32_16x16x32_bf16(Bt[n][k], At[m][k], acc[ai][bj][m][n], 0, 0, 0); __builtin_amdgcn_s_setprio(0); } while (0)
#define PG8_WAIT_V(n) asm volatile("s_waitcnt vmcnt(" #n ")" ::: "memory")
#define PG8_WAIT_VS(sp) do { if ((sp) == 16) PG8_WAIT_V(24); else if ((sp) == 8) PG8_WAIT_V(16); else if ((sp) == 4) PG8_WAIT_V(12); else PG8_WAIT_V(8); } while (0)
#define PG8_WAIT_L(n) asm volatile("s_waitcnt lgkmcnt(" #n ")" ::: "memory")
#define PG8_BAR __builtin_amdgcn_s_barrier()
#define PG8_SCHED __builtin_amdgcn_sched_barrier(0)
    Unit cur, nxt; int ui = 0, pst = 0;
    if (!S.next(0, cur)) return;
    f32x4 acc[2][2][4][2];
#pragma unroll
    for (int a = 0; a < 2; ++a)
#pragma unroll
        for (int b = 0; b < 2; ++b)
#pragma unroll
            for (int m = 0; m < 4; ++m)
#pragma unroll
                for (int n = 0; n < 2; ++n) { acc[a][b][m][n] = (f32x4){0.f, 0.f, 0.f, 0.f}; asm volatile("" : "+v"(acc[a][b][m][n])); }
    bf16x8 At[4][2], B0[2][2], B1[2][2];
    const char* cA = (const char*)g.A + (size_t)cur.pm * tstep; const char* cB = (const char*)g.Bt + (size_t)cur.pn * tstep;
    S.a_ready(cur);
    PG8_STAGE(PG8_SB(0, 0), cB, voffB); PG8_STAGE(PG8_SB(0, 1), cB + hstep, voffB); PG8_STAGE(PG8_SA(0, 0), cA, voffA); PG8_STAGE(PG8_SA(0, 1), cA + hstep, voffA);
    if (wr == 1) PG8_BAR;
    PG8_WAIT_V(2); PG8_BAR;
    PG8_STAGE(PG8_SB(1, 0), cB + kstep, voffB); PG8_STAGE(PG8_SA(1, 0), cA + kstep, voffA); PG8_STAGE(PG8_SB(1, 1), cB + hstep + kstep, voffB);
    PG8_WAIT_V(6); PG8_BAR;
    PG8_STAGE(PG8_SA(1, 1), cA + hstep + kstep, voffA);
    for (;;) {
        const bool has_next = S.next(ui + 1, nxt);
        const char* nA = has_next ? (const char*)g.A + (size_t)nxt.pm * tstep : cA; const char* nB = has_next ? (const char*)g.Bt + (size_t)nxt.pn * tstep : cB;
        {
            const char* a2 = cA + (size_t)2 * kstep; const char* b2 = cB + (size_t)2 * kstep; const char* a3 = a2 + kstep; const char* b3 = b2 + kstep;
            PG8_LDB(B0, 0, 0); PG8_LDB(B1, 0, 1); PG8_SCHED; PG8_LDA(At, 0, 0);
            PG8_WAIT_VS(pst); PG8_WAIT_L(0); PG8_BAR; PG8_MMA(0, 0, At, B0); PG8_MMA(0, 1, At, B1); PG8_BAR; PG8_SCHED;
            PG8_LDA(At, 0, 1); PG8_STAGE(PG8_SB(0, 0), b2, voffB); PG8_STAGE(PG8_SB(0, 1), b2 + hstep, voffB); PG8_STAGE(PG8_SA(0, 0), a2, voffA);
            PG8_WAIT_VS(pst); PG8_WAIT_L(0); PG8_BAR; PG8_MMA(1, 0, At, B0); PG8_MMA(1, 1, At, B1); PG8_BAR; PG8_SCHED;
            PG8_LDB(B0, 1, 0); PG8_LDB(B1, 1, 1); PG8_SCHED; PG8_LDA(At, 1, 0); PG8_STAGE(PG8_SA(0, 1), a2 + hstep, voffA);
            PG8_WAIT_VS(pst); PG8_WAIT_L(0); PG8_BAR; PG8_MMA(0, 0, At, B0); PG8_MMA(0, 1, At, B1); PG8_BAR; PG8_SCHED;
            PG8_LDA(At, 1, 1); PG8_STAGE(PG8_SB(1, 0), b3, voffB); PG8_STAGE(PG8_SB(1, 1), b3 + hstep, voffB); PG8_STAGE(PG8_SA(1, 0), a3, voffA);
            PG8_WAIT_V(8); PG8_WAIT_L(0); PG8_BAR; PG8_MMA(1, 0, At, B0); PG8_MMA(1, 1, At, B1); PG8_BAR; PG8_SCHED;
        }
        for (int t = 2; t < nt; t += 2) {
            const bool last = (t == nt - 2);
            const char* a1 = cA + (size_t)(t + 1) * kstep;
            const char* a2 = last ? nA : cA + (size_t)(t + 2) * kstep; const char* b2 = last ? nB : cB + (size_t)(t + 2) * kstep;
            const char* a3 = a2 + kstep; const char* b3 = b2 + kstep;
            if (last && has_next) S.a_ready(nxt);
            if (last) { unsigned zp_ = 0u; asm volatile("" : "+v"(zp_)); E.prefetch(cur, wid, (int)__builtin_amdgcn_mbcnt_hi(~0u, __builtin_amdgcn_mbcnt_lo(~0u, zp_))); }
            PG8_LDB(B0, 0, 0); PG8_LDB(B1, 0, 1); PG8_SCHED; PG8_LDA(At, 0, 0); PG8_STAGE(PG8_SA(1, 1), a1 + hstep, voffA);
            PG8_WAIT_V(8); PG8_WAIT_L(0); PG8_BAR; PG8_MMA(0, 0, At, B0); PG8_MMA(0, 1, At, B1); PG8_BAR; PG8_SCHED;
            PG8_LDA(At, 0, 1); PG8_STAGE(PG8_SB(0, 0), b2, voffB); PG8_STAGE(PG8_SB(0, 1), b2 + hstep, voffB); PG8_STAGE(PG8_SA(0, 0), a2, voffA);
            PG8_WAIT_V(8); PG8_WAIT_L(0); PG8_BAR; PG8_MMA(1, 0, At, B0); PG8_MMA(1, 1, At, B1); PG8_BAR; PG8_SCHED;
            PG8_LDB(B0, 1, 0); PG8_LDB(B1, 1, 1); PG8_SCHED; PG8_LDA(At, 1, 0); PG8_STAGE(PG8_SA(0, 1), a2 + hstep, voffA);
            PG8_WAIT_V(8); PG8_WAIT_L(0); PG8_BAR; PG8_MMA(0, 0, At, B0); PG8_MMA(0, 1, At, B1); PG8_BAR; PG8_SCHED;
            PG8_LDA(At, 1, 1); PG8_STAGE(PG8_SB(1, 0), b3, voffB); PG8_STAGE(PG8_SB(1, 1), b3 + hstep, voffB); PG8_STAGE(PG8_SA(1, 0), a3, voffA);
            PG8_WAIT_V(8); PG8_WAIT_L(0); PG8_BAR; PG8_MMA(1, 0, At, B0); PG8_MMA(1, 1, At, B1); PG8_BAR; PG8_SCHED;
            if (last) PG8_STAGE(PG8_SA(1, 1), a3 + hstep, voffA);
        }
        if constexpr (ALIGN_EPI) { if (wr == 0) PG8_BAR; }
        if constexpr (!Epi::AFTER_DRAIN) { unsigned ze_ = 0u; asm volatile("" : "+v"(ze_)); const int lane_e = (int)__builtin_amdgcn_mbcnt_hi(~0u, __builtin_amdgcn_mbcnt_lo(~0u, ze_)), fr_e = lane_e & 15, fq_e = lane_e >> 4;
            E(acc, cur, wr, wc, fr_e, fq_e); S.done(cur); pst = E.nstores(cur); }
        if (!has_next) break;
#pragma unroll
        for (int a = 0; a < 2; ++a)
#pragma unroll
            for (int b = 0; b < 2; ++b)
#pragma unroll
                for (int m = 0; m < 4; ++m)
#pragma unroll
                    for (int n = 0; n < 2; ++n) { acc[a][b][m][n] = (f32x4){0.f, 0.f, 0.f, 0.f}; asm volatile("" : "+v"(acc[a][b][m][n])); }
        cur = nxt; cA = nA; cB = nB; ++ui;
        if constexpr (ALIGN_EPI) { if (wr == 1) PG8_BAR; }
    }
    PG8_WAIT_V(0);
    if constexpr (!ALIGN_EPI) { if (wr == 0) PG8_BAR; }
    PG8_BAR;
    if constexpr (Epi::AFTER_DRAIN) { E.fused(acc, cur, wr, wc, fr, fq, lds, wid, lane); S.done(cur); }
#undef PG8_SA
#undef PG8_SB
#undef PG8_STAGE
#undef PG8_LDA
#undef PG8_LDB
#undef PG8_MMA
#undef PG8_WAIT_V
#undef PG8_WAIT_VS
#undef PG8_WAIT_L
#undef PG8_BAR
#undef PG8_SCHED
}
}

constexpr int NWAVES = 8;
constexpr int NB = 8, SEQ = 8192, D = 1024, DEPTH = 2, CCH = 512, CONVW = 31, RH = 4, RD = 128, RW = 512, RC = 128, FF = 4096, PLE = 256, INC = 3072;
constexpr int M = NB * SEQ;
constexpr int ZP = 2560;
constexpr float LN_EPS = 1e-5f;
constexpr size_t MiB = 1u << 20;
constexpr size_t WS_CTL = 0, CTL_ZERO_BYTES = 1 * MiB;
constexpr size_t WS_W = 2 * MiB, W_LAYER = 27 * MiB;
constexpr size_t WO_IN = 0, WO_OUT = 6 * MiB, WO_FF1 = 8 * MiB, WO_FF2 = 16 * MiB, WO_GATE = 24 * MiB, WO_PROJ = 26 * MiB;
constexpr size_t WS_SS = 56 * MiB, SS_SITE = 4 * MiB;
constexpr size_t WS_ROPE = 84 * MiB;
constexpr size_t WS_XB = 100 * MiB;
constexpr size_t WS_PB = 228 * MiB;
constexpr size_t WS_PROJ = 292 * MiB;
constexpr size_t WS_ZB = 420 * MiB;
constexpr size_t WS_T = 740 * MiB;
constexpr size_t WS_MIX = 756 * MiB;
constexpr size_t WS_HID = 420 * MiB;
constexpr size_t WS_END = 932 * MiB;
constexpr size_t WS_U = WS_XB, WS_S = WS_PROJ;
constexpr int CW_TMO = 0, CW_BAR = 4096;
constexpr int LDS_BYTES = 163840, RING_OFF = 0, MISC_OFF = 163840 - 256, ARGS_OFF = 163840 - 512, RED_OFF = 131072;

#define GAS __attribute__((address_space(1)))
#define LAS __attribute__((address_space(3)))
typedef unsigned short bf16;
typedef unsigned v4u __attribute__((ext_vector_type(4)));
typedef float f32x4 __attribute__((ext_vector_type(4)));
typedef GAS unsigned gu32;
#define RLX_AGENT __ATOMIC_RELAXED, __HIP_MEMORY_SCOPE_AGENT
#define LDS_WAIT() asm volatile("s_waitcnt lgkmcnt(0)" ::: "memory")
__device__ __forceinline__ unsigned f2bf(float f) { unsigned u = __builtin_bit_cast(unsigned, f); return (u + 0x7fffu + ((u >> 16) & 1u)) >> 16; }
__device__ __forceinline__ unsigned pk2(float lo, float hi) { return f2bf(lo) | (f2bf(hi) << 16); }
__device__ __forceinline__ float bf2f(unsigned short b) { return __uint_as_float(((unsigned)b) << 16); }

__device__ __forceinline__ float wave_sum(float v) {
#pragma unroll
    for (int o = 1; o < 64; o <<= 1) v += __shfl_xor(v, o);
    return v;
}
#define XB_TMO      128
#define XB_XCNT(j)  (256  + 64 * (j))
#define XB_XSUB(j)  (1280 + 64 * (j))
#define XB_XGEN(j)  (2304 + 64 * (j))
#define XB_TOP      3328
#define XB_TOPGEN   3392
#define XCD_BAR_WORDS 3456
#define XB_SPIN_CAP (1u << 18)

__device__ __forceinline__ unsigned xb_ld(unsigned* p)              { return __hip_atomic_load(p, __ATOMIC_RELAXED, __HIP_MEMORY_SCOPE_AGENT); }
__device__ __forceinline__ unsigned xb_add(unsigned* p, unsigned v) { return __hip_atomic_fetch_add(p, v, __ATOMIC_RELAXED, __HIP_MEMORY_SCOPE_AGENT); }
__device__ __forceinline__ unsigned xb_xcc_id() { return (unsigned)__builtin_amdgcn_s_getreg((3 << 11) | 20) & 0xFu; }
#define XB_SPIN(cond, bar) do { unsigned _sp = 0; while (cond) { __builtin_amdgcn_s_sleep(1); \
    if ((++_sp & 255u) == 0u) { if (xb_ld(&(bar)[XB_TMO])) break; if (_sp > XB_SPIN_CAP) { atomicAdd(&(bar)[XB_TMO], 1u); break; } } } } while (0)

__device__ __forceinline__ int xb_fresh_lane() { unsigned z = 0u; asm volatile("" : "+v"(z)); return (int)__builtin_amdgcn_mbcnt_hi(~0u, __builtin_amdgcn_mbcnt_lo(~0u, z)); }
struct XcdBarrier {
    unsigned* bar; unsigned x; int wave;
    volatile LAS unsigned* st;
};

__device__ __forceinline__ XcdBarrier xcd_barrier_post(unsigned* bar, volatile LAS unsigned* st, int wave) {
    XcdBarrier b; b.bar = bar; b.x = xb_xcc_id(); b.st = st; b.wave = wave;
    if (wave == 0 && xb_fresh_lane() == 0) (void)xb_add(&bar[XB_XCNT(b.x)], 1u);
    return b;
}
__device__ __forceinline__ void xcd_barrier_complete(unsigned* bar, unsigned x, unsigned& nloc, unsigned& nx) {
    const unsigned G = gridDim.x * gridDim.y * gridDim.z;
    unsigned sum, cnt, mine, sp = 0u;
    for (;;) {
        sum = 0u; cnt = 0u; mine = 0u;
#pragma unroll
        for (unsigned j = 0; j < 16; ++j) { const unsigned c = xb_ld(&bar[XB_XCNT(j)]); sum += c; cnt += (c > 0u) ? 1u : 0u; mine = (j == x) ? c : mine; }
        if (sum == G) break;
        __builtin_amdgcn_s_sleep(1);
        if ((++sp & 255u) == 0u) { if (xb_ld(&bar[XB_TMO])) break; if (sp > XB_SPIN_CAP) { atomicAdd(&bar[XB_TMO], 1u); break; } }
    }
    nloc = mine > 0u ? mine : 1u; nx = cnt > 0u ? cnt : 1u;
}

__device__ __forceinline__ void xcd_barrier(const XcdBarrier& b) {
    asm volatile("s_waitcnt vmcnt(0)" ::: "memory");
    __syncthreads();
    if (b.wave == 0 && xb_fresh_lane() == 0) {
        unsigned* bar = b.bar;
        __builtin_amdgcn_s_waitcnt(0);
        unsigned nloc = b.st[0], nx = b.st[1];
        if (nloc == 0u) { xcd_barrier_complete(bar, b.x, nloc, nx); b.st[0] = nloc; b.st[1] = nx; }
        const unsigned old = xb_add(&bar[XB_XSUB(b.x)], 1u);
        const unsigned gen = old / nloc;
        if (old + 1u == (gen + 1u) * nloc) {
            __builtin_amdgcn_fence(__ATOMIC_RELEASE, "agent");
            asm volatile("s_waitcnt vmcnt(0)" ::: "memory");
            const unsigned og = xb_add(&bar[XB_TOP], 1u);
            const unsigned tg = og / nx;
            if (og + 1u == (tg + 1u) * nx) xb_add(&bar[XB_TOPGEN], 1u);
            else XB_SPIN(xb_ld(&bar[XB_TOPGEN]) == tg, bar);
            __builtin_amdgcn_fence(__ATOMIC_ACQUIRE, "agent");
            xb_add(&bar[XB_XGEN(b.x)], 1u);
            asm volatile("s_waitcnt vmcnt(0)" ::: "memory");
        } else {
            XB_SPIN(xb_ld(&bar[XB_XGEN(b.x)]) == gen, bar);
            __builtin_amdgcn_fence(__ATOMIC_ACQUIRE, "agent");
            asm volatile("s_waitcnt vmcnt(0)" ::: "memory");
        }
    }
    __syncthreads();
}

namespace mx {
typedef short s16x4 __attribute__((ext_vector_type(4)));
typedef short v4i16_t __attribute__((ext_vector_type(4)));
typedef short bf16x8 __attribute__((ext_vector_type(8)));
typedef float f32x2 __attribute__((ext_vector_type(2)));
typedef unsigned u32x2 __attribute__((ext_vector_type(2)));
constexpr int KI = 0, VI = 32768, QI = 65536, SI = 98304, GNL = 131072;

__device__ __forceinline__ unsigned off_a(unsigned row, unsigned ch) { return 2048u * (row >> 3) + 512u * (ch >> 2) + 64u * (row & 7u) + 16u * ((ch & 3u) ^ ((row >> 2) & 3u)); }
struct LaneAddr { unsigned tr[2][2], row, kap[2]; };
__device__ __forceinline__ void lane_addr(LaneAddr& A, unsigned lane) {
    const unsigned g = lane >> 4, li = lane & 15u, q = li >> 2, p = lane & 3u;
#pragma unroll
    for (unsigned cp = 0; cp < 2; ++cp)
#pragma unroll
        for (unsigned t = 0; t < 2; ++t) A.tr[cp][t] = 2048u * g + 64u * q + 32u * (cp ^ (g & 1u)) + 16u * ((p >> 1) ^ t) + 8u * (p & 1u);
    A.row = 2048u * (li >> 3) + 64u * (li & 7u) + 16u * (g ^ ((li >> 2) & 3u));
#pragma unroll
    for (unsigned t = 0; t < 2; ++t) A.kap[t] = 2048u * (li >> 2) + 64u * (li & 3u) + 16u * ((g ^ (2u * ((li >> 2) & 1u))) ^ t);
}
__device__ __forceinline__ bf16x8 tr_frag(LAS const unsigned char* img, const LaneAddr& A, int c, int ks) {
    const s16x4 lo = __builtin_bit_cast(s16x4, __builtin_amdgcn_ds_read_tr16_b64_v4i16((LAS v4i16_t*)(img + A.tr[c & 1][0] + (8192 * ks + 512 * (c >> 1)))));
    const s16x4 hi = __builtin_bit_cast(s16x4, __builtin_amdgcn_ds_read_tr16_b64_v4i16((LAS v4i16_t*)(img + A.tr[c & 1][1] + (8192 * ks + 512 * (c >> 1) + 256))));
    return __builtin_shufflevector(lo, hi, 0, 1, 2, 3, 4, 5, 6, 7);
}
__device__ __forceinline__ bf16x8 row_frag(LAS const unsigned char* img, const LaneAddr& A, int rb, int s) { return *(LAS const bf16x8*)(img + A.row + (4096 * rb + 512 * s)); }
__device__ __forceinline__ bf16x8 kap_frag(LAS const unsigned char* img, const LaneAddr& A, int kp, int t, int ks) { return *(LAS const bf16x8*)(img + A.kap[t] + (8192 * kp + 512 * ks + 256 * t)); }
__device__ __forceinline__ float gamma_log(int h) { return logf(1.0f - exp2f(-5.0f - (float)h)); }
__device__ __forceinline__ float to_sgpr(float v) { return __builtin_bit_cast(float, __builtin_amdgcn_readfirstlane(__builtin_bit_cast(int, v))); }
__device__ __forceinline__ int opaque_s(int v) { asm volatile("" : "+s"(v)); return v; }

__device__ __forceinline__ void tile_load(v4u (&v)[4], const bf16* src, int tid) {
    const GAS v4u* g = (const GAS v4u*)(src + (size_t)(tid >> 2) * ZP + (tid & 3) * 32);
#pragma unroll
    for (int c = 0; c < 4; ++c) v[c] = g[(c + tid) & 3];
}
template <bool SCALE> __device__ __forceinline__ void tile_store(LAS unsigned char* img, const v4u (&v)[4], float rowscale, int tid) {
    const unsigned row = (unsigned)tid >> 2, sb = 2048u * (row >> 3) + 512u * ((unsigned)tid & 3u) + 64u * (row & 7u), r2 = (row >> 2) & 3u;
#pragma unroll
    for (int c = 0; c < 4; ++c) {
        v4u o = v[c];
        if (SCALE) {
            const unsigned w[4] = {o.x, o.y, o.z, o.w}; unsigned r[4];
#pragma unroll
            for (int i = 0; i < 4; ++i) r[i] = pg8::cvt_pk_bf16(__uint_as_float(w[i] << 16) * rowscale, __uint_as_float(w[i] & 0xffff0000u) * rowscale);
            o.x = r[0]; o.y = r[1]; o.z = r[2]; o.w = r[3];
        }
        *(LAS v4u*)(img + sb + 16u * ((((unsigned)c + (unsigned)tid) & 3u) ^ r2)) = o;
    }
}
#define MX_MFMA(a, b, c) __builtin_amdgcn_mfma_f32_16x16x32_bf16((a), (b), (c), 0, 0, 0)

__device__ __forceinline__ void conv_phase(LAS unsigned char* L, const bf16* ZB, bf16* MIXB, const float* dw_w, const float* dw_b, const float* ln_g, const float* ln_b, int bx, int wave) {
    const int lane0 = xb_fresh_lane(), cp0 = (wave * 64 + lane0) & 255, half = wave >> 2;
    f32x2 w2[CONVW];
#pragma unroll
    for (int j = 0; j < CONVW; ++j) w2[j] = *(const GAS f32x2*)(dw_w + j * CCH + 2 * cp0);
    const f32x2 b2 = *(const GAS f32x2*)(dw_b + 2 * cp0);
    LAS float* CT = (LAS float*)L;
    unsigned u[32 + CONVW - 1];
#define CONV_LOAD(tl) do { const int mt_ = bx * 256 + (tl) * 64, rmin_ = (CONVW - 1) - ((mt_ % SEQ) + 32 * half);     \
        const GAS unsigned* rb_ = (const GAS unsigned*)(ZB + ((long)(mt_ + 32 * half) - (CONVW - 1)) * ZP);                                   \
        if (rmin_ <= 0) { _Pragma("unroll") for (int r = 0; r < 32 + CONVW - 1; ++r) u[r] = rb_[r * (ZP / 2) + cpl]; } \
        else { _Pragma("unroll") for (int r = 0; r < 32 + CONVW - 1; ++r) { const unsigned v_ = rb_[(r < rmin_ ? rmin_ : r) * (ZP / 2) + cpl]; u[r] = r < rmin_ ? 0u : v_; } } } while (0)
    { const int cpl = cp0; CONV_LOAD(0); }
    for (int tile = 0; tile < 4; ++tile) {
        int lane = lane0; asm volatile("" : "+v"(lane));
        const int cp = (wave * 64 + lane) & 255;
        const int mt = bx * 256 + tile * 64;
        f32x2 acc[32];
#pragma unroll
        for (int t = 0; t < 32; ++t) acc[t] = b2;
        __builtin_amdgcn_sched_barrier(0);
#pragma unroll
        for (int r = 0; r < 32 + CONVW - 1; ++r) {
            const f32x2 h2 = {__uint_as_float(u[r] << 16), __uint_as_float(u[r] & 0xffff0000u)};
#pragma unroll
            for (int t = (r - (CONVW - 1) > 0 ? r - (CONVW - 1) : 0); t <= (r < 31 ? r : 31); ++t) acc[t] = w2[r - t] * h2 + acc[t];
            __builtin_amdgcn_sched_barrier(0);
        }
#pragma unroll
        for (int t = 0; t < 32; ++t) *(LAS f32x2*)(CT + (32 * half + t) * CCH + 2 * cp) = acc[t];
        if (tile < 3) { const int cpl = cp; CONV_LOAD(tile + 1); }
        __builtin_amdgcn_sched_barrier(0);
        asm volatile("s_waitcnt lgkmcnt(0)" ::: "memory"); __builtin_amdgcn_s_barrier(); asm volatile("" ::: "memory");
        {
            const f32x4 g0 = *(const GAS f32x4*)(ln_g + 8 * lane), g1 = *(const GAS f32x4*)(ln_g + 8 * lane + 4), be0 = *(const GAS f32x4*)(ln_b + 8 * lane), be1 = *(const GAS f32x4*)(ln_b + 8 * lane + 4);
#pragma unroll
            for (int hb = 0; hb < 2; ++hb) {
                f32x4 v0[4], v1[4]; float sm[4];
#pragma unroll
                for (int i = 0; i < 4; ++i) { v0[i] = *(LAS f32x4*)(CT + (8 * wave + 4 * hb + i) * CCH + 8 * lane); v1[i] = *(LAS f32x4*)(CT + (8 * wave + 4 * hb + i) * CCH + 8 * lane + 4);
                    sm[i] = (v0[i][0] + v0[i][1]) + (v0[i][2] + v0[i][3]) + (v1[i][0] + v1[i][1]) + (v1[i][2] + v1[i][3]); }
#pragma unroll
                for (int o = 1; o < 64; o <<= 1) {
#pragma unroll
                    for (int i = 0; i < 4; ++i) sm[i] += __shfl_xor(sm[i], o); }
#pragma unroll
                for (int i = 0; i < 4; ++i) { const float mean = sm[i] * (1.0f / CCH); v0[i] = v0[i] - mean; v1[i] = v1[i] - mean;
                    sm[i] = (v0[i][0] * v0[i][0] + v0[i][1] * v0[i][1]) + (v0[i][2] * v0[i][2] + v0[i][3] * v0[i][3]) + (v1[i][0] * v1[i][0] + v1[i][1] * v1[i][1]) + (v1[i][2] * v1[i][2] + v1[i][3] * v1[i][3]); }
#pragma unroll
                for (int o = 1; o < 64; o <<= 1) {
#pragma unroll
                    for (int i = 0; i < 4; ++i) sm[i] += __shfl_xor(sm[i], o); }
#pragma unroll
                for (int i = 0; i < 4; ++i) { const float rstd = rsqrtf(sm[i] * (1.0f / CCH) + LN_EPS);
                    f32x4 y0 = v0[i] * rstd * g0 + be0, y1 = v1[i] * rstd * g1 + be1;
                    y0 = y0 * pg8::sig4(y0); y1 = y1 * pg8::sig4(y1);
                    *(GAS v4u*)(MIXB + (size_t)(mt + 8 * wave + 4 * hb + i) * D + 8 * lane) = pg8::pack8(y0, y1); }
                __builtin_amdgcn_sched_barrier(0);
            }
        }
        asm volatile("s_waitcnt lgkmcnt(0)" ::: "memory"); __builtin_amdgcn_s_barrier(); asm volatile("" ::: "memory");
    }
#undef CONV_LOAD
}

__device__ __forceinline__ void state_mfma(f32x4 (&sacc)[8], LAS const unsigned char* Kimg, LAS const unsigned char* Vimg, const LaneAddr& A, int wave) {
    LAS const unsigned char* Kw = Kimg + 512 * (wave >> 1);
#pragma unroll
    for (int kp = 0; kp < 4; ++kp) {
        const bf16x8 kf = (wave & 1) ? tr_frag(Kw, A, 1, kp) : tr_frag(Kw, A, 0, kp);
        bf16x8 vf[8];
#pragma unroll
        for (int eb = 0; eb < 8; ++eb) vf[eb] = tr_frag(Vimg, A, eb, kp);
#pragma unroll
        for (int eb = 0; eb < 8; ++eb) sacc[eb] = MX_MFMA(kf, vf[eb], sacc[eb]);
    }
}
__device__ __forceinline__ void ret_state_phase(LAS unsigned char* L, const bf16* ZB, float* Tf, int bx, int wave) {
    const int lane0 = xb_fresh_lane(), bh = bx >> 3, cg = bx & 7, b = bh >> 2, h = opaque_s(bh & 3);
    const float lg = to_sgpr(gamma_log(h)), kscale = expf(-(float)((wave * 64 + lane0) >> 2) * lg), g128 = to_sgpr(expf(128.0f * lg));
    f32x4 sacc[8];
#pragma unroll
    for (int eb = 0; eb < 8; ++eb) sacc[eb] = (f32x4){0.f, 0.f, 0.f, 0.f};
    v4u kr[4], vr[4];
    { const size_t m0 = (size_t)b * SEQ + (size_t)(cg * 8) * RC; const int tid0 = wave * 64 + lane0; tile_load(kr, ZB + m0 * ZP + 512 + 512 * h + 128, tid0); tile_load(vr, ZB + m0 * ZP + 512 + 512 * h + 256, tid0); }
    for (int j = 0; j < 8; ++j) {
        int lane = lane0; asm volatile("" : "+v"(lane));
        const int tid = wave * 64 + lane;
        tile_store<true>(L + KI, kr, kscale, tid); tile_store<false>(L + VI, vr, 1.0f, tid);
        __syncthreads();
        if (j < 7) { const size_t m1 = (size_t)b * SEQ + (size_t)(cg * 8 + j + 1) * RC; tile_load(kr, ZB + m1 * ZP + 512 + 512 * h + 128, tid); tile_load(vr, ZB + m1 * ZP + 512 + 512 * h + 256, tid); }
#pragma unroll
        for (int eb = 0; eb < 8; ++eb) sacc[eb] = sacc[eb] * g128;
        LaneAddr A; lane_addr(A, (unsigned)lane);
        state_mfma(sacc, L + KI, L + VI, A, wave);
        __syncthreads();
    }
    GAS f32x4* dst = (GAS f32x4*)Tf + (size_t)(bx * 8 + wave) * 8 * 64 + lane0;
#pragma unroll
    for (int eb = 0; eb < 8; ++eb) dst[eb * 64] = sacc[eb];
}
template <int ABL> __device__ __forceinline__ void ret_out_phase(LAS unsigned char* L, const bf16* ZB, bf16* MIXB, const float* Tf, const float* gn_g, const float* gn_b, int bx, int wave) {
    const int lane0 = xb_fresh_lane(), bh = bx >> 3, cg = bx & 7, b = bh >> 2, h = opaque_s(bh & 3);
    const float lg = to_sgpr(gamma_log(h)), kscale = expf(-(float)((wave * 64 + lane0) >> 2) * lg), qscale = expf((float)((wave * 64 + lane0) >> 2) * lg), g128 = to_sgpr(expf(128.0f * lg)), cd8 = to_sgpr(expf(1024.0f * lg));
    if (wave < 4) { const int t_ = wave * 64 + lane0, c_ = t_ & 127; ((LAS float*)(L + GNL))[t_] = (t_ < 128 ? gn_g : gn_b)[h * RD + c_]; }
    f32x4 sacc[8];
#pragma unroll
    for (int eb = 0; eb < 8; ++eb) sacc[eb] = (f32x4){0.f, 0.f, 0.f, 0.f};
    v4u kr[4], vr[4], qr[4];
    { const size_t m0 = (size_t)b * SEQ + (size_t)(cg * 8) * RC; const int tid0 = wave * 64 + lane0;
      if (!(ABL & 1)) { tile_load(kr, ZB + m0 * ZP + 512 + 512 * h + 128, tid0); tile_load(vr, ZB + m0 * ZP + 512 + 512 * h + 256, tid0); tile_load(qr, ZB + m0 * ZP + 512 + 512 * h, tid0); }
      else { for (int c = 0; c < 4; ++c) { kr[c] = (v4u){0u, 0u, 0u, 0u}; vr[c] = kr[c]; qr[c] = kr[c]; } } }
    { float coef = 1.0f;
      for (int g2 = cg - 1; g2 >= 0; g2 -= 4) {
          f32x4 tv[4][8]; float cf[4];
#pragma unroll
          for (int u = 0; u < 4; ++u) { const int gi = g2 - u, gc = gi < 0 ? 0 : gi; cf[u] = gi < 0 ? 0.f : coef; coef *= cd8;
              const GAS f32x4* src = (const GAS f32x4*)Tf + (size_t)((bh * 8 + gc) * 8 + wave) * 8 * 64 + lane0;
#pragma unroll
              for (int eb = 0; eb < 8; ++eb) tv[u][eb] = src[eb * 64]; }
#pragma unroll
          for (int u = 0; u < 4; ++u)
#pragma unroll
              for (int eb = 0; eb < 8; ++eb) sacc[eb] = sacc[eb] + tv[u][eb] * cf[u]; } }
    for (int j = 0; j < 8; ++j) {
        int lane = lane0; asm volatile("" : "+v"(lane));
        const int tid = wave * 64 + lane, g = lane >> 4, li = lane & 15;
        const int qb = wave < 4 ? wave : 11 - wave;
        const size_t m0 = (size_t)b * SEQ + (size_t)(cg * 8 + j) * RC;
        if (!(ABL & 2)) { tile_store<true>(L + KI, kr, kscale, tid); tile_store<false>(L + VI, vr, 1.0f, tid); tile_store<true>(L + QI, qr, qscale, tid); }
        LaneAddr A; lane_addr(A, (unsigned)lane);
        { const unsigned stb = 2048u * ((unsigned)li >> 3) + 512u * ((unsigned)wave >> 1) + 64u * ((unsigned)li & 7u) + 16u * ((2u * ((unsigned)wave & 1u) + ((unsigned)g >> 1)) ^ (((unsigned)li >> 2) & 3u)) + 8u * ((unsigned)g & 1u);
#pragma unroll
          for (int eb = 0; eb < 8; ++eb) { sacc[eb] = sacc[eb] * g128; const f32x4 sv = sacc[eb]; u32x2 w;     w.x = pg8::cvt_pk_bf16(sv[0], sv[1]); w.y = pg8::cvt_pk_bf16(sv[2], sv[3]);
              *(LAS u32x2*)(L + SI + stb + 4096 * eb) = w; } }
        asm volatile("s_waitcnt lgkmcnt(0)" ::: "memory"); __builtin_amdgcn_s_barrier(); asm volatile("" ::: "memory");
        const size_t m1 = m0 + RC; const bool pfn = (j < 7) && !(ABL & 1);
        const size_t mrow = m0 + 16 * qb + li;
        u32x2 gw[8];
#pragma unroll
        for (int eb = 0; eb < 8; ++eb) gw[eb] = (ABL & 1) ? (u32x2){0u, 0u} : *(const GAS u32x2*)(ZB + mrow * ZP + 512 + 512 * h + 384 + 16 * eb + 4 * g);
        if (pfn) tile_load(kr, ZB + m1 * ZP + 512 + 512 * h + 128, tid);
        __builtin_amdgcn_sched_barrier(0);
        f32x4 o[8];
#pragma unroll
        for (int eb = 0; eb < 8; ++eb) o[eb] = (f32x4){0.f, 0.f, 0.f, 0.f};
        if (!(ABL & 4)) {
        bf16x8 qf[4];
#pragma unroll
        for (int ks = 0; ks < 4; ++ks) qf[ks] = row_frag(L + QI + 4096 * qb, A, 0, ks);
        bf16x8 pf[4];
#pragma unroll
        for (int kp = 0; kp < 4; ++kp) {
            unsigned pw[4] = {0u, 0u, 0u, 0u};
            if (kp <= (qb >> 1)) {
#pragma unroll
                for (int t = 0; t < 2; ++t) {
                    f32x4 x = (f32x4){0.f, 0.f, 0.f, 0.f};
#pragma unroll
                    for (int ks = 0; ks < 4; ++ks) x = MX_MFMA(kap_frag(L + KI, A, kp, t, ks), qf[ks], x);
                    { const int key0 = 32 * kp + 8 * g + 4 * t, ql = 16 * qb + li;
#pragma unroll
                        for (int r = 0; r < 4; ++r) x[r] = (key0 + r <= ql) ? x[r] : 0.f; }
                    pw[2 * t] = pg8::cvt_pk_bf16(x[0], x[1]); pw[2 * t + 1] = pg8::cvt_pk_bf16(x[2], x[3]);
                }
            }
            pf[kp] = __builtin_bit_cast(bf16x8, (v4u){pw[0], pw[1], pw[2], pw[3]});
        }
        __builtin_amdgcn_sched_barrier(0); if (pfn) tile_load(vr, ZB + m1 * ZP + 512 + 512 * h + 256, tid); __builtin_amdgcn_sched_barrier(0);
#pragma unroll
        for (int eb = 0; eb < 8; ++eb) {
#pragma unroll
            for (int ks = 0; ks < 4; ++ks) o[eb] = MX_MFMA(row_frag(L + SI, A, eb, ks), qf[ks], o[eb]);
        }
        __builtin_amdgcn_sched_barrier(0); if (pfn) tile_load(qr, ZB + m1 * ZP + 512 + 512 * h, tid); __builtin_amdgcn_sched_barrier(0);
#pragma unroll
        for (int kp = 0; kp < 4; ++kp) {
            const bf16x8 kf = (wave & 1) ? tr_frag(L + KI + 512 * (wave >> 1), A, 1, kp) : tr_frag(L + KI + 512 * (wave >> 1), A, 0, kp);
            bf16x8 vf[8];
#pragma unroll
            for (int eb = 0; eb < 8; ++eb) vf[eb] = tr_frag(L + VI, A, eb, kp);
#pragma unroll
            for (int eb = 0; eb < 8; ++eb) {
                o[eb] = MX_MFMA(vf[eb], pf[kp], o[eb]);
                sacc[eb] = MX_MFMA(kf, vf[eb], sacc[eb]); }
        }
        }
        if (!(ABL & 8)) {
        float s1 = 0.f;
#pragma unroll
        for (int eb = 0; eb < 8; ++eb) s1 += (o[eb][0] + o[eb][1]) + (o[eb][2] + o[eb][3]);
        s1 += __shfl_xor(s1, 16); s1 += __shfl_xor(s1, 32);
        const float mean = s1 * (1.0f / RD); float s2 = 0.f;
#pragma unroll
        for (int eb = 0; eb < 8; ++eb) { o[eb] = o[eb] - mean; s2 += (o[eb][0] * o[eb][0] + o[eb][1] * o[eb][1]) + (o[eb][2] * o[eb][2] + o[eb][3] * o[eb][3]); }
        s2 += __shfl_xor(s2, 16); s2 += __shfl_xor(s2, 32);
        const float rstd = rsqrtf(s2 * (1.0f / RD) + LN_EPS);
#pragma unroll
        for (int eb = 0; eb < 8; ++eb) { const int e0 = h * RD + 16 * eb + 4 * g;
            const f32x4 gg = *(const LAS f32x4*)(L + GNL + 4 * (16 * eb + 4 * g)), gb = *(const LAS f32x4*)(L + GNL + 512 + 4 * (16 * eb + 4 * g));
            const f32x4 gt = (f32x4){__uint_as_float(gw[eb].x << 16), __uint_as_float(gw[eb].x & 0xffff0000u), __uint_as_float(gw[eb].y << 16), __uint_as_float(gw[eb].y & 0xffff0000u)};
            const f32x4 y = (o[eb] * rstd * gg + gb) * (gt * pg8::sig4(gt));
            u32x2 w; w.x = pg8::cvt_pk_bf16(y[0], y[1]); w.y = pg8::cvt_pk_bf16(y[2], y[3]);
            *(GAS u32x2*)(MIXB + mrow * D + CCH + e0) = w; }
        }
        asm volatile("s_waitcnt lgkmcnt(0)" ::: "memory"); __builtin_amdgcn_s_barrier(); asm volatile("" ::: "memory");
    }
}
#undef MX_MFMA
}

struct Args {
    const float* x; const float* p; const int* pos; const float* norm_mix_g; const float* w_in; const float* dw_w; const float* dw_b; const float* ln_g; const float* ln_b;
    const float* gn_g; const float* gn_b; const float* w_out; const float* norm_ffn_g; const float* w_ff1; const float* w_ff2; const float* norm_ple_g; const float* w_gate; const float* w_proj;
    const float* final_g; float* out; unsigned char* ws; int ph_lo, ph_hi, li, pad;
};
__device__ __forceinline__ int inmap(int s) {
    if (s < 512) return 256 * (s >> 7) + (s & 127);
    if (s < 1024) { const int ch = s - 512; return 256 * (ch >> 7) + 128 + (ch & 127); }
    if (s < 2048) { const int k = s >= 1536, r = s - (k ? 1536 : 1024), hq = r >> 7, dd = r & 127; return 256 * ((k ? 6 : 4) + (hq >> 1)) + 128 * (dd >> 6) + 64 * (hq & 1) + (dd & 63); }
    return s;
}
template <bool INMAP> __device__ __forceinline__ void tr_item(const float* W, int K, int N, const float* gain, bf16* WT, LAS float* scr, int item, int lane) {
    const int nblk = N / 32, kb = item / nblk, nb = item % nblk, k0 = 64 * kb, n0 = 32 * nb;
    float wv[32];
#pragma unroll
    for (int i = 0; i < 32; ++i) wv[i] = W[(size_t)(k0 + 2 * i + (lane >> 5)) * N + n0 + (lane & 31)];
#pragma unroll
    for (int i = 0; i < 32; ++i) { const int kk = 2 * i + (lane >> 5); scr[kk * 33 + (lane & 31)] = wv[i] * (gain ? gain[k0 + kk] : 1.0f); }
    LDS_WAIT(); asm volatile("" ::: "memory");
    const int c = lane & 7;
#pragma unroll
    for (int j = 0; j < 4; ++j) { const int n = (lane >> 3) + 8 * j; const LAS float* s = scr + (8 * c) * 33 + n;
        const int src = n0 + n; const int r = INMAP ? inmap(src) : src; const float cs = (INMAP && src >= 1536 && src < 2048) ? 0.088388347648318447f : 1.0f;
        v4u o; o.x = pk2(s[0 * 33] * cs, s[1 * 33] * cs); o.y = pk2(s[2 * 33] * cs, s[3 * 33] * cs); o.z = pk2(s[4 * 33] * cs, s[5 * 33] * cs); o.w = pk2(s[6 * 33] * cs, s[7 * 33] * cs);
        *(GAS v4u*)(WT + (size_t)r * K + k0 + 8 * c) = o; }
    LDS_WAIT(); asm volatile("" ::: "memory");
}

__device__ __forceinline__ const void* lds_ptr(LAS unsigned char* p) {
    const unsigned lo = __builtin_amdgcn_readfirstlane(((volatile LAS unsigned*)p)[0]), hi = __builtin_amdgcn_readfirstlane(((volatile LAS unsigned*)p)[1]);
    return (const void*)(((unsigned long long)hi << 32) | lo);
}
__device__ __forceinline__ void stagger_start(int bx, unsigned quarter_ticks) {
    const unsigned g = ((unsigned)bx >> 6) & 3u; if (g == 0u) return;
    const unsigned long long t0 = __builtin_amdgcn_s_memrealtime(), dt = (unsigned long long)g * quarter_ticks;
    while (__builtin_amdgcn_s_memrealtime() - t0 < dt) __builtin_amdgcn_s_sleep(32);
}
#ifndef STAGGER_TICKS
#define STAGGER_TICKS 0
#endif
#ifndef PROBE_DUP
#define PROBE_DUP (-1)
#endif
#ifndef PROBE_ABL
#define PROBE_ABL 0
#endif
#define DUPN(k) ((PROBE_DUP == (k)) ? 2 : 1)
__global__ void __launch_bounds__(NWAVES * 64, 2) mk_fwd(Args a) {
    extern __shared__ __attribute__((aligned(16))) unsigned char lds[];
    LAS unsigned char* const L = (LAS unsigned char*)lds;
    volatile LAS unsigned* MISC = (volatile LAS unsigned*)(L + MISC_OFF);
    const int wave = __builtin_amdgcn_readfirstlane(threadIdx.x >> 6);
#define LANE_ID() xb_fresh_lane()
    const int G = gridDim.x, bx = blockIdx.x;
    unsigned char* ws = a.ws;
    gu32* ctl = (gu32*)(ws + WS_CTL);
    if (threadIdx.x < 64) MISC[threadIdx.x] = 0u;
    if (threadIdx.x < sizeof(Args) / 4) ((volatile LAS unsigned*)(L + ARGS_OFF))[threadIdx.x] = ((const unsigned*)&a)[threadIdx.x];
    __syncthreads();
#define ARGP(field) ((decltype(a.field))lds_ptr(L + ARGS_OFF + offsetof(Args, field)))
    XcdBarrier bar = xcd_barrier_post((unsigned*)(ctl + CW_BAR) + a.li * XCD_BAR_WORDS, MISC + 8, wave);
#ifdef PROBE_SUB
    const int sub = a.pad;
#else
    constexpr int sub = 0;
#endif
    const int lo = a.ph_lo, hi = a.ph_hi;
#define IN(k) (lo <= (k) && (k) < hi)
#define SEAM(k) do { if (IN(k) && IN((k) + 1)) xcd_barrier(bar); } while (0)
    const int gw = bx * NWAVES + wave, NGW = G * NWAVES;
    const size_t NGT = (size_t)G * NWAVES * 64;
    bf16* const XB = (bf16*)(ws + WS_XB); bf16* const ZB = (bf16*)(ws + WS_ZB); bf16* const MIXB = (bf16*)(ws + WS_MIX); bf16* const HID = (bf16*)(ws + WS_HID);
    bf16* const XO = (bf16*)a.out;
    float* const TF = (float*)(ws + WS_T);
    LAS float* const RED = (LAS float*)(L + RED_OFF);
    LAS float* const SSL = (LAS float*)(L + RED_OFF + 4096);
    bf16* const PROJ = (bf16*)(ws + WS_PROJ); bf16* const PB = (bf16*)(ws + WS_PB); unsigned* const ROPE = (unsigned*)(ws + WS_ROPE);

    if (IN(0))
#pragma clang loop unroll(full)
    for (int rep = 0; rep < DUPN(0); ++rep) {
        const int lane = LANE_ID(); const size_t gt = (size_t)bx * (NWAVES * 64) + wave * 64 + lane;
        LAS float* scr = (LAS float*)(L + RING_OFF + wave * 16384);
        constexpr int I_IN = (D / 64) * (INC / 32), I_OUT = (D / 64) * (D / 32), I_F1 = (D / 64) * (FF / 32), I_F2 = (FF / 64) * (D / 32), I_G = I_OUT, I_P = (PLE / 64) * (D / 32);
        constexpr int I_LAYER = I_IN + I_OUT + I_F1 + I_F2 + I_G + I_P;
        if (!(sub & 1)) for (int it = gw; it < DEPTH * I_LAYER; it += NGW) {
            const int l = it / I_LAYER; int r = it % I_LAYER; unsigned char* wl = ws + WS_W + (size_t)l * W_LAYER;
            if (r < I_IN) { tr_item<true>(a.w_in + (size_t)l * D * INC, D, INC, a.norm_mix_g + l * D, (bf16*)(wl + WO_IN), scr, r, lane); continue; } r -= I_IN;
            if (r < I_OUT) { tr_item<false>(a.w_out + (size_t)l * D * D, D, D, nullptr, (bf16*)(wl + WO_OUT), scr, r, lane); continue; } r -= I_OUT;
            if (r < I_F1) { tr_item<false>(a.w_ff1 + (size_t)l * D * FF, D, FF, a.norm_ffn_g + l * D, (bf16*)(wl + WO_FF1), scr, r, lane); continue; } r -= I_F1;
            if (r < I_F2) { tr_item<false>(a.w_ff2 + (size_t)l * FF * D, FF, D, nullptr, (bf16*)(wl + WO_FF2), scr, r, lane); continue; } r -= I_F2;
            if (r < I_G) { tr_item<false>(a.w_gate + (size_t)l * D * D, D, D, a.norm_ple_g + l * D, (bf16*)(wl + WO_GATE), scr, r, lane); continue; } r -= I_G;
            tr_item<false>(a.w_proj + (size_t)l * PLE * D, PLE, D, nullptr, (bf16*)(wl + WO_PROJ), scr, r, lane);
        }
        float* ss0 = (float*)(ws + WS_SS);
        if (!(sub & 2)) for (int m = gw; m < M; m += 4 * NGW) {
            f32x4 v[4][4]; float s[4];
#pragma unroll
            for (int r = 0; r < 4; ++r) { const GAS f32x4* xr = (const GAS f32x4*)(a.x + (size_t)(m + r * NGW) * D) + lane;
#pragma unroll
                for (int j = 0; j < 4; ++j) v[r][j] = xr[64 * j]; }
#pragma unroll
            for (int r = 0; r < 4; ++r) { float t = 0.f;
#pragma unroll
                for (int j = 0; j < 4; ++j) t += (v[r][j].x * v[r][j].x + v[r][j].y * v[r][j].y) + (v[r][j].z * v[r][j].z + v[r][j].w * v[r][j].w);
                s[r] = t; }
#pragma unroll
            for (int o = 1; o < 64; o <<= 1) {
#pragma unroll
                for (int r = 0; r < 4; ++r) s[r] += __shfl_xor(s[r], o); }
#pragma unroll
            for (int r = 0; r < 4; ++r) { const size_t mr = (size_t)(m + r * NGW);
                GAS unsigned long long* o8 = (GAS unsigned long long*)(XB + mr * D) + lane;
#pragma unroll
                for (int j = 0; j < 4; ++j) o8[64 * j] = (unsigned long long)pk2(v[r][j].x, v[r][j].y) | ((unsigned long long)pk2(v[r][j].z, v[r][j].w) << 32);
                if (lane < 4) ss0[mr * 4 + lane] = lane == 0 ? s[r] : 0.f; }
        }
        if (!(sub & 4))
#pragma unroll 4
        for (size_t i = gt; i < (size_t)DEPTH * M * PLE / 8; i += NGT) {
            const f32x4 p0 = *(const GAS f32x4*)(a.p + i * 8), p1 = *(const GAS f32x4*)(a.p + i * 8 + 4);
            v4u o; o.x = pk2(p0.x, p0.y); o.y = pk2(p0.z, p0.w); o.z = pk2(p1.x, p1.y); o.w = pk2(p1.z, p1.w);
            *(GAS v4u*)(PB + i * 8) = o;
        }
        if (!(sub & 8))
#pragma unroll 2
        for (size_t i = gt; i < (size_t)M * 64; i += NGT) {
            const int d = (int)(i & 63); const size_t m = i >> 6;
            const float inv_freq = 1.0f / powf(10000.0f, (float)d * (2.0f / RD)), ang = (float)a.pos[m] * inv_freq;
            const pg8::f16x2 cs = {(_Float16)cosf(ang), (_Float16)sinf(ang)};
            ROPE[i] = __builtin_bit_cast(unsigned, cs);
        }
    }
    SEAM(0);
#pragma clang loop unroll(full)
    for (int l = 0; l < DEPTH; ++l) {
        const int pb = 1 + 8 * l;
        bf16* const XC = (l & 1) ? XO : XB; bf16* const XN = (l & 1) ? XB : XO;
        unsigned char* wl = ws + WS_W + (size_t)l * W_LAYER;
        float* const ss_a = (float*)(ws + WS_SS + (size_t)(3 * l + 0) * SS_SITE);
        float* const ss_b = (float*)(ws + WS_SS + (size_t)(3 * l + 1) * SS_SITE);
        float* const ss_c = (float*)(ws + WS_SS + (size_t)(3 * l + 2) * SS_SITE);
        float* const ss_d = (float*)(ws + WS_SS + (size_t)(3 * l + 3) * SS_SITE);
        if (IN(pb + 0))
#pragma clang loop unroll(full)
        for (int rep = 0; rep < DUPN(pb + 0); ++rep) {
            pg8::Gemm g{XC, (const bf16*)(wl + WO_IN), M, INC, D}; pg8::StaticOrder S; S.init(M, INC, G, bx);
            pg8::EpiInProj E{ZB, ss_a, ROPE, SSL};
            pg8::gemm_phase<pg8::EpiInProj, pg8::StaticOrder, true, true>(L + RING_OFF, g, S, E, wave);
        }
        SEAM(pb + 0);
        if (IN(pb + 1))
#pragma clang loop unroll(full)
        for (int rep = 0; rep < DUPN(pb + 1); ++rep) {
            if (!(DUPN(pb + 1) == 2 && rep == 0 && (PROBE_ABL & 1)) && sub != 2) mx::conv_phase(L, ZB, MIXB, ARGP(dw_w) + l * CONVW * CCH, ARGP(dw_b) + l * CCH, ARGP(ln_g) + l * CCH, ARGP(ln_b) + l * CCH, bx, wave);
            if (!(DUPN(pb + 1) == 2 && rep == 0 && (PROBE_ABL & 2)) && sub != 1) mx::ret_state_phase(L, ZB, TF, bx, wave);
            if (sub == 0) {
                pg8::Gemm g{PB + (size_t)l * M * PLE, (const bf16*)(wl + WO_PROJ), M, D, PLE}; pg8::StaticOrder S; S.init(M, D, G, bx);
                pg8::EpiPlain E{PROJ};
                pg8::gemm_phase<pg8::EpiPlain, pg8::StaticOrder, true, true>(L + RING_OFF, g, S, E, wave);
            }
        }
        SEAM(pb + 1);
        if (IN(pb + 2))
#pragma clang loop unroll(full)
        for (int rep = 0; rep < DUPN(pb + 2); ++rep) {
            if ((DUPN(pb + 2) == 2 && rep == 0) || sub != 0) mx::ret_out_phase<PROBE_ABL>(L, ZB, MIXB, TF, ARGP(gn_g) + l * RW, ARGP(gn_b) + l * RW, bx, wave);
            else mx::ret_out_phase<0>(L, ZB, MIXB, TF, ARGP(gn_g) + l * RW, ARGP(gn_b) + l * RW, bx, wave);
        }
        SEAM(pb + 2);
        if (IN(pb + 3))
#pragma clang loop unroll(full)
        for (int rep = 0; rep < 1; ++rep) {
            pg8::Gemm g{MIXB, (const bf16*)(wl + WO_OUT), M, D, D}; pg8::StaticOrder S; S.init(M, D, G, bx);
            pg8::EpiResid<0> E{XC, XC, ss_b, nullptr, nullptr, RED, SSL};
            pg8::gemm_phase<pg8::EpiResid<0>, pg8::StaticOrder, true, true>(L + RING_OFF, g, S, E, wave);
        }
        SEAM(pb + 3);
        if (IN(pb + 4))
#pragma clang loop unroll(full)
        for (int rep = 0; rep < DUPN(pb + 4); ++rep) {
            pg8::Gemm g{XC, (const bf16*)(wl + WO_FF1), M, FF, D}; pg8::StaticOrder S; S.init(M, FF, G, bx);
            pg8::EpiFF1 E{HID, ss_b, sub, SSL};
            pg8::gemm_phase<pg8::EpiFF1, pg8::StaticOrder, true, true>(L + RING_OFF, g, S, E, wave);
        }
        SEAM(pb + 4);
        if (IN(pb + 5))
#pragma clang loop unroll(full)
        for (int rep = 0; rep < DUPN(pb + 5); ++rep) {
            const bool dummy = (DUPN(pb + 5) == 2 && rep == 0);
            pg8::Gemm g{HID, (const bf16*)(wl + WO_FF2), M, D, FF}; pg8::StaticOrder S; S.init(M, D, G, bx);
            pg8::EpiResid<0> E{XC, dummy ? PROJ : XC, dummy ? (float*)(ws + WS_SS + (size_t)6 * SS_SITE) : ss_c, nullptr, nullptr, RED, SSL};
            pg8::gemm_phase<pg8::EpiResid<0>, pg8::StaticOrder, true, true>(L + RING_OFF, g, S, E, wave);
        }
        SEAM(pb + 5);
        if (IN(pb + 7)) {
            pg8::Gemm g{XC, (const bf16*)(wl + WO_GATE), M, D, D}; pg8::StaticOrder S; S.init(M, D, G, bx);
            pg8::EpiResid<1> E{XC, XN, ss_d, ss_c, PROJ, RED, SSL};
            pg8::gemm_phase<pg8::EpiResid<1>, pg8::StaticOrder, true, true>(L + RING_OFF, g, S, E, wave);
        }
        SEAM(pb + 7);
    }
    if (IN(17)) {
        const int lane = LANE_ID();
        const float* ssf = (const float*)(ws + WS_SS + (size_t)6 * SS_SITE);
        const bf16* XF = (DEPTH & 1) ? XO : XB;
        const GAS f32x4* gr = (const GAS f32x4*)ARGP(final_g) + 2 * lane; const f32x4 g0 = gr[0], g1 = gr[1], g2 = gr[128], g3 = gr[129];
        for (int m = gw; m < M; m += 4 * NGW) {
            f32x4 sp[4]; v4u xa[4], xb[4];
#pragma unroll
            for (int r = 0; r < 4; ++r) { const size_t mr = (size_t)(m + r * NGW); sp[r] = *(const GAS f32x4*)(ssf + mr * 4); const GAS v4u* xr = (const GAS v4u*)(XF + mr * D) + lane; xa[r] = xr[0]; xb[r] = xr[64]; }
#pragma unroll
            for (int r = 0; r < 4; ++r) { const float rs = pg8::rstd_from(sp[r]); GAS f32x4* orow = (GAS f32x4*)(a.out + (size_t)(m + r * NGW) * D) + 2 * lane;
                f32x4 a0, a1, b0, b1; pg8::unpack8(xa[r], a0, a1); pg8::unpack8(xb[r], b0, b1);
                orow[0] = a0 * rs * g0; orow[1] = a1 * rs * g1; orow[128] = b0 * rs * g2; orow[129] = b1 * rs * g3; }
        }
    }
#undef IN
#undef SEAM
}

extern "C" void kernel_launch(void* const* d_in, const int* in_sizes, int n_in, void* d_out, int out_size, void* d_ws, size_t ws_size, hipStream_t stream) {
    static int grid = 0;
    if (grid == 0) {
        if (n_in != 19 || out_size != M * D || ws_size < WS_END) { fprintf(stderr, "kernel_launch: unexpected problem (n_in %d, out %d, ws %zu < %zu); nothing launched\n", n_in, out_size, ws_size, (size_t)WS_END); grid = -1; return; }
        int dev = 0, cus = 0;
        if (hipGetDevice(&dev) != hipSuccess || hipDeviceGetAttribute(&cus, hipDeviceAttributeMultiprocessorCount, dev) != hipSuccess) { grid = -1; return; }
        if (hipFuncSetAttribute((const void*)mk_fwd, hipFuncAttributeMaxDynamicSharedMemorySize, LDS_BYTES) != hipSuccess) { fprintf(stderr, "kernel_launch: hipFuncSetAttribute failed\n"); grid = -1; return; }
        int per_cu = 0;
        if (hipOccupancyMaxActiveBlocksPerMultiprocessor(&per_cu, (const void*)mk_fwd, NWAVES * 64, LDS_BYTES) != hipSuccess || per_cu < 1) fprintf(stderr, "kernel_launch: occupancy query says %d\n", per_cu);
        (void)hipGetLastError();
        if (cus < 256) fprintf(stderr, "kernel_launch: %d CUs < 256: the grid cannot be resident\n", cus);
        grid = 256;
    }
    if (grid < 0) return;
    (void)hipMemsetAsync((char*)d_ws + WS_CTL, 0, CTL_ZERO_BYTES, stream);
    Args a{};
    a.x = (const float*)d_in[0]; a.p = (const float*)d_in[1]; a.pos = (const int*)d_in[2]; a.norm_mix_g = (const float*)d_in[3]; a.w_in = (const float*)d_in[4]; a.dw_w = (const float*)d_in[5];
    a.dw_b = (const float*)d_in[6]; a.ln_g = (const float*)d_in[7]; a.ln_b = (const float*)d_in[8]; a.gn_g = (const float*)d_in[9]; a.gn_b = (const float*)d_in[10]; a.w_out = (const float*)d_in[11];
    a.norm_ffn_g = (const float*)d_in[12]; a.w_ff1 = (const float*)d_in[13]; a.w_ff2 = (const float*)d_in[14]; a.norm_ple_g = (const float*)d_in[15]; a.w_gate = (const float*)d_in[16];
    a.w_proj = (const float*)d_in[17]; a.final_g = (const float*)d_in[18]; a.out = (float*)d_out; a.ws = (unsigned char*)d_ws;
    a.ph_lo = 0; a.ph_hi = 18; a.li = 0;
    hipLaunchKernelGGL(mk_fwd, dim3(grid), dim3(NWAVES * 64), LDS_BYTES, stream, a);
}
```

```cpp
#include <hip/hip_runtime.h>
#include <cstdio>
#include <cstdint>
#include <cstddef>
namespace pg8 {
#define PG8_LAS __attribute__((address_space(3)))
typedef unsigned short bf16_t;
typedef short bf16x8 __attribute__((ext_vector_type(8)));
typedef float f32x4 __attribute__((ext_vector_type(4)));
typedef unsigned u32x4 __attribute__((ext_vector_type(4)));
typedef unsigned u32x2 __attribute__((ext_vector_type(2)));
constexpr int BM = 256, BK = 64, HALF = 128, HTB = HALF * BK * 2  , STAGE_BYTES = 8 * HTB, NXCD = 8, WGM = 8;

__host__ __device__ __forceinline__ int lds_byte(int r, int c) { const int st = (r >> 4) * 2 + (c >> 5), rr = r & 15, cc = c & 31, ob = rr * 64 + cc * 2; return st * 1024 + (ob ^ (((ob >> 9) & 1) << 5)); }
__host__ __device__ __forceinline__ void stage_rc(int b, int& R, int& C) { const int st = b / 1024, sb = b % 1024, swz = sb ^ (((sb >> 9) & 1) << 5); R = (st >> 1) * 16 + swz / 64; C = (st & 1) * 32 + (swz % 64) / 2; }
__host__ __device__ __forceinline__ int perm32(int rho) { const int n = rho >> 4, i = rho & 15; return 8 * (i >> 2) + 4 * n + (i & 3); }

struct Unit { int pm, pn; };
struct Gemm { const bf16_t* A; const bf16_t* Bt; int M, N, K; };

struct StaticOrder {
    int nM, nN, nwg, G, c;
    __host__ __device__ void init(int M, int N, int G_, int c_) { nM = M / BM; nN = N / BM; nwg = nM * nN; G = G_; c = c_; }
    __host__ __device__ bool next(int i, Unit& u) const {
        const long L = (long)i * G + c; if (L >= nwg) return false;
        int wgid = (int)L; { const int q = nwg / NXCD, r = nwg % NXCD, xcd = wgid % NXCD, off = wgid / NXCD; wgid = (xcd < r ? xcd * (q + 1) : r * (q + 1) + (xcd - r) * q) + off; }
        const int nig = WGM * nN, gid = wgid / nig, fm = gid * WGM, gsz = (nM - fm) < WGM ? (nM - fm) : WGM;
        u.pm = fm + ((wgid % nig) % gsz); u.pn = (wgid % nig) / gsz; return true;
    }
    __device__ __forceinline__ void a_ready(const Unit&) const {}
    __device__ __forceinline__ void done(const Unit&) const {}
};
struct RangeOrder : StaticOrder {
    int i0, n;
    __host__ __device__ bool next(int i, Unit& u) const { if (i >= n) return false; return StaticOrder::next(i0 + i, u); }
};

__device__ __forceinline__ unsigned cvt_pk_bf16(float lo, float hi) { unsigned r; asm volatile("v_cvt_pk_bf16_f32 %0, %1, %2" : "=v"(r) : "v"(lo), "v"(hi)); return r; }
__device__ __forceinline__ u32x4 pack8(const f32x4 a, const f32x4 b) { u32x4 w; w.x = cvt_pk_bf16(a[0], a[1]); w.y = cvt_pk_bf16(a[2], a[3]); w.z = cvt_pk_bf16(b[0], b[1]); w.w = cvt_pk_bf16(b[2], b[3]); return w; }
__device__ __forceinline__ float fast_sigmoid(float x) { return __builtin_amdgcn_rcpf(1.0f + __builtin_amdgcn_exp2f(x * -1.4426950408889634f)); }
__device__ __forceinline__ f32x4 sig4(const f32x4 v) { return (f32x4){fast_sigmoid(v[0]), fast_sigmoid(v[1]), fast_sigmoid(v[2]), fast_sigmoid(v[3])}; }
constexpr int SSP = 4;
constexpr float RMS_EPS_ = 1e-6f;
__device__ __forceinline__ float rstd_from(const f32x4 s) { return rsqrtf(((s[0] + s[1]) + (s[2] + s[3])) * (1.0f / 1024.0f) + RMS_EPS_); }
__device__ __forceinline__ float rstd_of(const float* ss, int row) { return rstd_from(*(const f32x4*)(ss + (size_t)row * SSP)); }
__device__ __forceinline__ void rstd8(const float* ss, int row0, float (&rs)[2][4]) {
    f32x4 sp[2][4];
#pragma unroll
    for (int ai = 0; ai < 2; ++ai)
#pragma unroll
        for (int m = 0; m < 4; ++m) sp[ai][m] = *(const f32x4*)(ss + (size_t)(row0 + ai * HALF + m * 16) * SSP);
#pragma unroll
    for (int ai = 0; ai < 2; ++ai)
#pragma unroll
        for (int m = 0; m < 4; ++m) rs[ai][m] = rstd_from(sp[ai][m]);
}
typedef _Float16 f16x2 __attribute__((ext_vector_type(2)));
__device__ __forceinline__ void ss_prefetch(const float* ss, PG8_LAS float* ssl, const Unit& u, int wid, int lane) {
    if (wid < 4) __builtin_amdgcn_global_load_lds((const unsigned*)(ss + ((size_t)u.pm * BM + wid * 64 + lane) * SSP), (PG8_LAS unsigned*)(ssl + wid * 256), 16, 0, 0);
}
__device__ __forceinline__ void rstd8_lds(const PG8_LAS float* ssl, int rl0, float (&rs)[2][4]) {
#pragma unroll
    for (int ai = 0; ai < 2; ++ai)
#pragma unroll
        for (int m = 0; m < 4; ++m) rs[ai][m] = rstd_from(*(const PG8_LAS f32x4*)(ssl + (rl0 + ai * HALF + m * 16) * SSP));
}

struct EpiInProj {
    static constexpr bool PERM = true, AFTER_DRAIN = false;
    bf16_t* ZB0; const float* ss; const unsigned* rope; PG8_LAS float* ssl;
    static constexpr size_t BATCH_PAD = 12582912;
    __device__ __forceinline__ void prefetch(const Unit& u, int wid, int lane) const { ss_prefetch(ss, ssl, u, wid, lane); }
    static constexpr int ZP = 2560;
    __device__ __forceinline__ int nstores(const Unit& u) const { return u.pn < 8 ? 8 : 16; }
    __device__ __forceinline__ void operator()(const f32x4 (&acc)[2][2][4][2], const Unit& u, int wr, int wc, int fr, int fq) const {
        const int row0 = u.pm * BM + wr * 64 + fr, pn = u.pn, lc = wc * 32 + 8 * fq;
        bf16_t* const ZB = ZB0 + (size_t)(u.pm >> 5) * BATCH_PAD;
        float rs[2][4]; rstd8_lds(ssl, wr * 64 + fr, rs);
        if (pn < 4) {
#pragma unroll
            for (int ai = 0; ai < 2; ++ai)
#pragma unroll
                for (int m = 0; m < 4; ++m) { const int row = row0 + ai * HALF + m * 16; const float r = rs[ai][m];
                    const f32x4 h0 = (acc[ai][0][m][0] * r) * sig4(acc[ai][1][m][0] * r), h1 = (acc[ai][0][m][1] * r) * sig4(acc[ai][1][m][1] * r);
                    *(u32x4*)(ZB + (size_t)row * ZP + pn * 128 + lc) = pack8(h0, h1); }
        } else if (pn < 8) {
            const int head = 2 * (pn & 1) + (wc >> 1), d0 = lc & 63, colb = 512 + 512 * head + (pn < 6 ? 0 : 128) + d0;
#pragma unroll
            for (int ai = 0; ai < 2; ++ai) {
                u32x4 r0[4], r1[4];
#pragma unroll
                for (int m = 0; m < 4; ++m) { const u32x4* rp = (const u32x4*)(rope + (size_t)(row0 + ai * HALF + m * 16) * 64 + d0); r0[m] = rp[0]; r1[m] = rp[1]; }
#pragma unroll
                for (int m = 0; m < 4; ++m) { const int row = row0 + ai * HALF + m * 16; const float r = rs[ai][m];
                    f32x4 o1[2], o2[2];
                    const unsigned rv[8] = {r0[m].x, r0[m].y, r0[m].z, r0[m].w, r1[m].x, r1[m].y, r1[m].z, r1[m].w};
#pragma unroll
                    for (int n = 0; n < 2; ++n) {
#pragma unroll
                        for (int i = 0; i < 4; ++i) { const f16x2 cs = __builtin_bit_cast(f16x2, rv[4 * n + i]); const float c = (float)cs[0], s = (float)cs[1];
                            const float t1 = acc[ai][0][m][n][i] * r, t2 = acc[ai][1][m][n][i] * r; o1[n][i] = t1 * c - t2 * s; o2[n][i] = t2 * c + t1 * s; } }
                    bf16_t* zp = ZB + (size_t)row * ZP + colb; *(u32x4*)zp = pack8(o1[0], o1[1]); *(u32x4*)(zp + 64) = pack8(o2[0], o2[1]); }
                asm volatile("" ::: "memory"); }
        } else {
            const int colb = 512 + 1024 * (pn & 1) + (pn < 10 ? 256 : 384) + lc;
#pragma unroll
            for (int ai = 0; ai < 2; ++ai)
#pragma unroll
                for (int m = 0; m < 4; ++m) { const int row = row0 + ai * HALF + m * 16; const float r = rs[ai][m];
#pragma unroll
                    for (int bj = 0; bj < 2; ++bj) *(u32x4*)(ZB + (size_t)row * ZP + colb + bj * 512) = pack8(acc[ai][bj][m][0] * r, acc[ai][bj][m][1] * r); }
        }
    }
};
__device__ __forceinline__ void unpack8(const u32x4 w, f32x4& a, f32x4& b) {
    a = (f32x4){__uint_as_float(w.x << 16), __uint_as_float(w.x & 0xffff0000u), __uint_as_float(w.y << 16), __uint_as_float(w.y & 0xffff0000u)};
    b = (f32x4){__uint_as_float(w.z << 16), __uint_as_float(w.z & 0xffff0000u), __uint_as_float(w.w << 16), __uint_as_float(w.w & 0xffff0000u)};
}
template <int MODE> struct EpiResid {
    static constexpr bool PERM = true, AFTER_DRAIN = false;
    const bf16_t* XI; bf16_t* XO; float* ss_out; const float* ss_in; const bf16_t* proj; PG8_LAS float* red; PG8_LAS float* ssl;
    __device__ __forceinline__ void prefetch(const Unit& u, int wid, int lane) const { if (MODE == 1) ss_prefetch(ss_in, ssl, u, wid, lane); }
    __device__ __forceinline__ int nstores(const Unit&) const { return MODE == 1 ? 4 : 16; }
    __device__ __forceinline__ void operator()(const f32x4 (&acc)[2][2][4][2], const Unit& u, int wr, int wc, int fr, int fq) const {
        const int row0 = u.pm * BM + wr * 64 + fr, col0 = u.pn * BM + wc * 32 + 8 * fq;
        constexpr int NB = (MODE == 1) ? 2 : 8;
#pragma unroll
        for (int gb = 0; gb < 8; gb += NB) {
            u32x4 xb[NB][2], pb[NB][2];
#pragma unroll
            for (int mm = 0; mm < NB; ++mm)
#pragma unroll
                for (int bj = 0; bj < 2; ++bj) { const int ai = (gb + mm) >> 2, m = (gb + mm) & 3; const size_t off = (size_t)(row0 + ai * HALF + m * 16) * 1024 + col0 + bj * HALF; xb[mm][bj] = *(const u32x4*)(XI + off); if (MODE == 1) pb[mm][bj] = *(const u32x4*)(proj + off); }
            float rsb[NB];
#pragma unroll
            for (int mm = 0; mm < NB; ++mm) { const int ai = (gb + mm) >> 2, m = (gb + mm) & 3; rsb[mm] = (MODE == 1) ? rstd_from(*(const PG8_LAS f32x4*)(ssl + (wr * 64 + fr + ai * HALF + m * 16) * SSP)) : 1.0f; }
#pragma unroll
            for (int mm = 0; mm < NB; ++mm) { const int ai = (gb + mm) >> 2, m = (gb + mm) & 3; const size_t off = (size_t)(row0 + ai * HALF + m * 16) * 1024 + col0; float q = 0.f;
#pragma unroll
                for (int bj = 0; bj < 2; ++bj) { f32x4 b0, b1; unpack8(xb[mm][bj], b0, b1);
                    f32x4 v0, v1;
                    if (MODE == 1) { f32x4 p0, p1; unpack8(pb[mm][bj], p0, p1); const float r = rsb[mm];
                        v0 = b0 + sig4(acc[ai][bj][m][0] * r) * p0; v1 = b1 + sig4(acc[ai][bj][m][1] * r) * p1; }
                    else { v0 = b0 + acc[ai][bj][m][0]; v1 = b1 + acc[ai][bj][m][1]; }
                    *(u32x4*)(XO + off + bj * HALF) = pack8(v0, v1);
                    q += (v0[0] * v0[0] + v0[1] * v0[1]) + (v0[2] * v0[2] + v0[3] * v0[3]) + (v1[0] * v1[0] + v1[1] * v1[1]) + (v1[2] * v1[2] + v1[3] * v1[3]); }
                q += __builtin_bit_cast(float, __builtin_amdgcn_ds_swizzle(__builtin_bit_cast(int, q), 0x401F));
                if ((fq & 1) == 0) red[(fq >> 1) * 2048 + (ai * HALF + wr * 64 + m * 16 + fr) * 4 + wc] = q; }
            asm volatile("" ::: "memory"); }
        asm volatile("s_waitcnt lgkmcnt(0)" ::: "memory"); __builtin_amdgcn_s_barrier(); asm volatile("" ::: "memory");
        const int t = (wr * 4 + wc) * 64 + fq * 16 + fr;
        if (t < 256) { const f32x4 s4 = *(const PG8_LAS f32x4*)(red + t * 4) + *(const PG8_LAS f32x4*)(red + 2048 + t * 4); ss_out[(size_t)(u.pm * BM + t) * SSP + u.pn] = (s4[0] + s4[1]) + (s4[2] + s4[3]); }
    }
};
struct EpiFF1 {
    static constexpr bool PERM = true, AFTER_DRAIN = false;
    bf16_t* H; const float* ss; int probe; PG8_LAS float* ssl;
    __device__ __forceinline__ void prefetch(const Unit& u, int wid, int lane) const { ss_prefetch(ss, ssl, u, wid, lane); }
    __device__ __forceinline__ int nstores(const Unit&) const { return (probe & 1) ? 0 : 16; }
    __device__ __forceinline__ void operator()(const f32x4 (&acc)[2][2][4][2], const Unit& u, int wr, int wc, int fr, int fq) const {
        const int row0 = u.pm * BM + wr * 64 + fr, col0 = u.pn * BM + wc * 32 + 8 * fq;
        float rs8[2][4];
        if (probe & 2) { for (int ai = 0; ai < 2; ++ai) for (int m = 0; m < 4; ++m) rs8[ai][m] = 1.0f; } else rstd8_lds(ssl, wr * 64 + fr, rs8);
#pragma unroll
        for (int ai = 0; ai < 2; ++ai)
#pragma unroll
            for (int m = 0; m < 4; ++m) { const int row = row0 + ai * HALF + m * 16; const float rs = rs8[ai][m];
#pragma unroll
                for (int bj = 0; bj < 2; ++bj) { f32x4 v0 = acc[ai][bj][m][0] * rs, v1 = acc[ai][bj][m][1] * rs;
                    v0 = __builtin_elementwise_max(v0, (f32x4){0.f, 0.f, 0.f, 0.f}); v1 = __builtin_elementwise_max(v1, (f32x4){0.f, 0.f, 0.f, 0.f}); v0 = v0 * v0; v1 = v1 * v1;
                    const u32x4 w = pack8(v0, v1);
                    if (probe & 1) asm volatile("" :: "v"(w));
                    else if (probe & 4) *(u32x4*)(H + (size_t)(u.pm * 16 + u.pn) * 65536 + (size_t)((wr * 4 + wc) * 16 + (ai * 4 + m) * 2 + bj) * 512 + (fq * 16 + fr) * 8) = w;
                    else *(u32x4*)(H + (size_t)row * 4096 + col0 + bj * HALF) = w; } }
    }
};
struct EpiPlain {
    static constexpr bool PERM = true, AFTER_DRAIN = false;
    bf16_t* O;
    __device__ __forceinline__ int nstores(const Unit&) const { return 16; }
    __device__ __forceinline__ void prefetch(const Unit&, int, int) const {}
    __device__ __forceinline__ void operator()(const f32x4 (&acc)[2][2][4][2], const Unit& u, int wr, int wc, int fr, int fq) const {
        const int row0 = u.pm * BM + wr * 64 + fr, col0 = u.pn * BM + wc * 32 + 8 * fq;
        asm volatile("s_nop 15\n\ts_nop 15" ::: "memory");
#pragma unroll
        for (int ai = 0; ai < 2; ++ai)
#pragma unroll
            for (int m = 0; m < 4; ++m) { const int row = row0 + ai * HALF + m * 16;
#pragma unroll
                for (int bj = 0; bj < 2; ++bj) *(u32x4*)(O + (size_t)row * 1024 + col0 + bj * HALF) = pack8(acc[ai][bj][m][0], acc[ai][bj][m][1]); }
    }
};

template <class Epi, class Sched, bool ALIGN_EPI = false, bool SP2 = false>
__device__ __forceinline__ void gemm_phase(PG8_LAS unsigned char* lds, const Gemm g, const Sched& S, const Epi& E, const int wave_id) {
    unsigned z_ = 0u; asm volatile("" : "+v"(z_)); const int tid_ = wave_id * 64 + (int)__builtin_amdgcn_mbcnt_hi(~0u, __builtin_amdgcn_mbcnt_lo(~0u, z_));
    const int tid = tid_, wid = wave_id, lane = tid & 63, wr = wid >> 2, wc = wid & 3, fr = lane & 15, fq = lane >> 4;
    const int K = g.K, nt = K / BK;
    static_assert(SP2 && ALIGN_EPI, "this copy of the body is only maintained for the SP2 + ALIGN_EPI configuration (the store-slack logic lives in that path)");
    unsigned voffA[2], voffB[2];
#pragma unroll
    for (int i = 0; i < 2; ++i) { int R, C; stage_rc(tid * 16 + i * 8192, R, C); const int Rb = Epi::PERM ? ((R & ~31) + perm32(R & 31)) : R;
        voffA[i] = (unsigned)(R * K + C) * 2u; voffB[i] = (unsigned)(Rb * K + C) * 2u; }
    const size_t kstep = (size_t)(BK * 2);
    const size_t hstep = (size_t)HALF * K * 2;
    const size_t tstep = 2 * hstep;
    const unsigned ldsw = (unsigned)wid * 1024u;
    const int aoff = lds_byte(wr * 64 + fr, fq * 8), boff = lds_byte(wc * 32 + fr, fq * 8);
#define PG8_SA(b, h) (((b) * 2 + (h)) * HTB)
#define PG8_SB(b, h) ((4 + (b) * 2 + (h)) * HTB)
#define PG8_STAGE(bufoff, gbase, voff) do { _Pragma("unroll") for (int _i = 0; _i < 2; ++_i) \
        __builtin_amdgcn_global_load_lds((const unsigned*)((const char*)(gbase) + (voff)[_i]), (PG8_LAS unsigned*)(lds + (bufoff) + ldsw + _i * 8192), 16, 0, 0); } while (0)
#define PG8_LDA(dst, b, h) do { _Pragma("unroll") for (int m = 0; m < 4; ++m) _Pragma("unroll") for (int k = 0; k < 2; ++k) dst[m][k] = *(const PG8_LAS bf16x8*)(lds + PG8_SA(b, h) + aoff + m * 2048 + k * 1024); } while (0)
#define PG8_LDB(dst, b, h) do { _Pragma("unroll") for (int n = 0; n < 2; ++n) _Pragma("unroll") for (int k = 0; k < 2; ++k) dst[n][k] = *(const PG8_LAS bf16x8*)(lds + PG8_SB(b, h) + boff + n * 2048 + k * 1024); } while (0)
#define PG8_MMA(ai, bj, At, Bt) do { __builtin_amdgcn_s_setprio(1); _Pragma("unroll") for (int m = 0; m < 4; ++m) _Pragma("unroll") for (int n = 0; n < 2; ++n) _Pragma("unroll") for (int k = 0; k < 2; ++k) \
        acc[ai][bj][m][n] = __builtin_amdgcn_mfma_f32_16x16x32_bf16(Bt[n][k], At[m][k], acc[ai][bj][m][n], 0, 0, 0); __builtin_amdgcn_s_setprio(0); } while (0)
#define PG8_WAIT_V(n) asm volatile("s_waitcnt vmcnt(" #n ")" ::: "memory")
#define PG8_WAIT_VS(sp) do { if ((sp) == 16) PG8_WAIT_V(24); else if ((sp) == 8) PG8_WAIT_V(16); else if ((sp) == 4) PG8_WAIT_V(12); else PG8_WAIT_V(8); } while (0)
#define PG8_WAIT_L(n) asm volatile("s_waitcnt lgkmcnt(" #n ")" ::: "memory")
#define PG8_BAR __builtin_amdgcn_s_barrier()
#define PG8_SCHED __builtin_amdgcn_sched_barrier(0)
    Unit cur, nxt; int ui = 0, pst = 0;
    if (!S.next(0, cur)) return;
    f32x4 acc[2][2][4][2];
#pragma unroll
    for (int a = 0; a < 2; ++a)
#pragma unroll
        for (int b = 0; b < 2; ++b)
#pragma unroll
            for (int m = 0; m < 4; ++m)
#pragma unroll
                for (int n = 0; n < 2; ++n) { acc[a][b][m][n] = (f32x4){0.f, 0.f, 0.f, 0.f}; asm volatile("" : "+v"(acc[a][b][m][n])); }
    bf16x8 At[4][2], B0[2][2], B1[2][2];
    const char* cA = (const char*)g.A + (size_t)cur.pm * tstep; const char* cB = (const char*)g.Bt + (size_t)cur.pn * tstep;
    S.a_ready(cur);
    PG8_STAGE(PG8_SB(0, 0), cB, voffB); PG8_STAGE(PG8_SB(0, 1), cB + hstep, voffB); PG8_STAGE(PG8_SA(0, 0), cA, voffA); PG8_STAGE(PG8_SA(0, 1), cA + hstep, voffA);
    if (wr == 1) PG8_BAR;
    PG8_WAIT_V(2); PG8_BAR;
    PG8_STAGE(PG8_SB(1, 0), cB + kstep, voffB); PG8_STAGE(PG8_SA(1, 0), cA + kstep, voffA); PG8_STAGE(PG8_SB(1, 1), cB + hstep + kstep, voffB);
    PG8_WAIT_V(6); PG8_BAR;
    PG8_STAGE(PG8_SA(1, 1), cA + hstep + kstep, voffA);
    for (;;) {
        const bool has_next = S.next(ui + 1, nxt);
        const char* nA = has_next ? (const char*)g.A + (size_t)nxt.pm * tstep : cA; const char* nB = has_next ? (const char*)g.Bt + (size_t)nxt.pn * tstep : cB;
        {
            const char* a2 = cA + (size_t)2 * kstep; const char* b2 = cB + (size_t)2 * kstep; const char* a3 = a2 + kstep; const char* b3 = b2 + kstep;
            PG8_LDB(B0, 0, 0); PG8_LDB(B1, 0, 1); PG8_SCHED; PG8_LDA(At, 0, 0);
            PG8_WAIT_VS(pst); PG8_WAIT_L(0); PG8_BAR; PG8_MMA(0, 0, At, B0); PG8_MMA(0, 1, At, B1); PG8_BAR; PG8_SCHED;
            PG8_LDA(At, 0, 1); PG8_STAGE(PG8_SB(0, 0), b2, voffB); PG8_STAGE(PG8_SB(0, 1), b2 + hstep, voffB); PG8_STAGE(PG8_SA(0, 0), a2, voffA);
            PG8_WAIT_VS(pst); PG8_WAIT_L(0); PG8_BAR; PG8_MMA(1, 0, At, B0); PG8_MMA(1, 1, At, B1); PG8_BAR; PG8_SCHED;
            PG8_LDB(B0, 1, 0); PG8_LDB(B1, 1, 1); PG8_SCHED; PG8_LDA(At, 1, 0); PG8_STAGE(PG8_SA(0, 1), a2 + hstep, voffA);
            PG8_WAIT_VS(pst); PG8_WAIT_L(0); PG8_BAR; PG8_MMA(0, 0, At, B0); PG8_MMA(0, 1, At, B1); PG8_BAR; PG8_SCHED;
            PG8_LDA(At, 1, 1); PG8_STAGE(PG8_SB(1, 0), b3, voffB); PG8_STAGE(PG8_SB(1, 1), b3 + hstep, voffB); PG8_STAGE(PG8_SA(1, 0), a3, voffA);
            PG8_WAIT_V(8); PG8_WAIT_L(0); PG8_BAR; PG8_MMA(1, 0, At, B0); PG8_MMA(1, 1, At, B1); PG8_BAR; PG8_SCHED;
        }
        for (int t = 2; t < nt; t += 2) {
            const bool last = (t == nt - 2);
            const char* a1 = cA + (size_t)(t + 1) * kstep;
            const char* a2 = last ? nA : cA + (size_t)(t + 2) * kstep; const char* b2 = last ? nB : cB + (size_t)(t + 2) * kstep;
            const char* a3 = a2 + kstep; const char* b3 = b2 + kstep;
            if (last && has_next) S.a_ready(nxt);
            if (last) { unsigned zp_ = 0u; asm volatile("" : "+v"(zp_)); E.prefetch(cur, wid, (int)__builtin_amdgcn_mbcnt_hi(~0u, __builtin_amdgcn_mbcnt_lo(~0u, zp_))); }
            PG8_LDB(B0, 0, 0); PG8_LDB(B1, 0, 1); PG8_SCHED; PG8_LDA(At, 0, 0); PG8_STAGE(PG8_SA(1, 1), a1 + hstep, voffA);
            PG8_WAIT_V(8); PG8_WAIT_L(0); PG8_BAR; PG8_MMA(0, 0, At, B0); PG8_MMA(0, 1, At, B1); PG8_BAR; PG8_SCHED;
            PG8_LDA(At, 0, 1); PG8_STAGE(PG8_SB(0, 0), b2, voffB); PG8_STAGE(PG8_SB(0, 1), b2 + hstep, voffB); PG8_STAGE(PG8_SA(0, 0), a2, voffA);
            PG8_WAIT_V(8); PG8_WAIT_L(0); PG8_BAR; PG8_MMA(1, 0, At, B0); PG8_MMA(1, 1, At, B1); PG8_BAR; PG8_SCHED;
            PG8_LDB(B0, 1, 0); PG8_LDB(B1, 1, 1); PG8_SCHED; PG8_LDA(At, 1, 0); PG8_STAGE(PG8_SA(0, 1), a2 + hstep, voffA);
            PG8_WAIT_V(8); PG8_WAIT_L(0); PG8_BAR; PG8_MMA(0, 0, At, B0); PG8_MMA(0, 1, At, B1); PG8_BAR; PG8_SCHED;
            PG8_LDA(At, 1, 1); PG8_STAGE(PG8_SB(1, 0), b3, voffB); PG8_STAGE(PG8_SB(1, 1), b3 + hstep, voffB); PG8_STAGE(PG8_SA(1, 0), a3, voffA);
            PG8_WAIT_V(8); PG8_WAIT_L(0); PG8_BAR; PG8_MMA(1, 0, At, B0); PG8_MMA(1, 1, At, B1); PG8_BAR; PG8_SCHED;
            if (last) PG8_STAGE(PG8_SA(1, 1), a3 + hstep, voffA);
        }
        if constexpr (ALIGN_EPI) { if (wr == 0) PG8_BAR; }
        if constexpr (!Epi::AFTER_DRAIN) { unsigned ze_ = 0u; asm volatile("" : "+v"(ze_)); const int lane_e = (int)__builtin_amdgcn_mbcnt_hi(~0u, __builtin_amdgcn_mbcnt_lo(~0u, ze_)), fr_e = lane_e & 15, fq_e = lane_e >> 4;
            E(acc, cur, wr, wc, fr_e, fq_e); S.done(cur); pst = E.nstores(cur); }
        if (!has_next) break;
#pragma unroll
        for (int a = 0; a < 2; ++a)
#pragma unroll
            for (int b = 0; b < 2; ++b)
#pragma unroll
                for (int m = 0; m < 4; ++m)
#pragma unroll
                    for (int n = 0; n < 2; ++n) { acc[a][b][m][n] = (f32x4){0.f, 0.f, 0.f, 0.f}; asm volatile("" : "+v"(acc[a][b][m][n])); }
        cur = nxt; cA = nA; cB = nB; ++ui;
        if constexpr (ALIGN_EPI) { if (wr == 1) PG8_BAR; }
    }
    PG8_WAIT_V(0);
    if constexpr (!ALIGN_EPI) { if (wr == 0) PG8_BAR; }
    PG8_BAR;
    if constexpr (Epi::AFTER_DRAIN) { E.fused(acc, cur, wr, wc, fr, fq, lds, wid, lane); S.done(cur); }
#undef PG8_SA
#undef PG8_SB
#undef PG8_STAGE
#undef PG8_LDA
#undef PG8_LDB
#undef PG8_MMA
#undef PG8_WAIT_V
#undef PG8_WAIT_VS
#undef PG8_WAIT_L
#undef PG8_BAR
#undef PG8_SCHED
}
}

constexpr int NWAVES = 8;
constexpr int NB = 8, SEQ = 8192, D = 1024, DEPTH = 2, CCH = 512, CONVW = 31, RH = 4, RD = 128, RW = 512, RC = 128, FF = 4096, PLE = 256, INC = 3072;
constexpr int M = NB * SEQ;
constexpr int ZP = 2560;
constexpr float LN_EPS = 1e-5f;
constexpr size_t MiB = 1u << 20;
constexpr size_t WS_CTL = 0, CTL_ZERO_BYTES = 1 * MiB;
constexpr size_t WS_W = 2 * MiB, W_LAYER = 27 * MiB;
constexpr size_t WO_IN = 0, WO_OUT = 6 * MiB, WO_FF1 = 8 * MiB, WO_FF2 = 16 * MiB, WO_GATE = 24 * MiB, WO_PROJ = 26 * MiB;
constexpr size_t WS_SS = 56 * MiB, SS_SITE = 4 * MiB;
constexpr size_t WS_ROPE = 84 * MiB;
constexpr size_t WS_XB = 100 * MiB;
constexpr size_t WS_PB = 228 * MiB;
constexpr size_t WS_PROJ = 292 * MiB;
constexpr size_t WS_ZB = 420 * MiB;
constexpr size_t ZB_BATCH_PAD = 12582912, T_IN_ARENA = 40 * MiB;
constexpr size_t WS_HID = 420 * MiB;
constexpr size_t WS_END = 932 * MiB;
constexpr size_t WS_U = WS_XB, WS_S = WS_PROJ;
constexpr int CW_TMO = 0, CW_BAR = 4096, CW_GRP = 16384, CW_QUAD = 32768, CW_HAND = 131072, CW_WCNT = 204800;
constexpr int LDS_BYTES = 163840, RING_OFF = 0, MISC_OFF = 163840 - 256, ARGS_OFF = 163840 - 512, RED_OFF = 131072;

#define GAS __attribute__((address_space(1)))
#define LAS __attribute__((address_space(3)))
typedef unsigned short bf16;
typedef unsigned v4u __attribute__((ext_vector_type(4)));
typedef float f32x4 __attribute__((ext_vector_type(4)));
typedef GAS unsigned gu32;
#define RLX_AGENT __ATOMIC_RELAXED, __HIP_MEMORY_SCOPE_AGENT
#define LDS_WAIT() asm volatile("s_waitcnt lgkmcnt(0)" ::: "memory")
__device__ __forceinline__ unsigned f2bf(float f) { unsigned u = __builtin_bit_cast(unsigned, f); return (u + 0x7fffu + ((u >> 16) & 1u)) >> 16; }
__device__ __forceinline__ unsigned pk2(float lo, float hi) { return f2bf(lo) | (f2bf(hi) << 16); }
__device__ __forceinline__ float bf2f(unsigned short b) { return __uint_as_float(((unsigned)b) << 16); }

__device__ __forceinline__ float wave_sum(float v) {
#pragma unroll
    for (int o = 1; o < 64; o <<= 1) v += __shfl_xor(v, o);
    return v;
}
#define XB_TMO      128
#define XB_XCNT(j)  (256  + 64 * (j))
#define XB_XSUB(j)  (1280 + 64 * (j))
#define XB_XGEN(j)  (2304 + 64 * (j))
#define XB_TOP      3328
#define XB_TOPGEN   3392
#define XB_GCNT(j, g) (3456 + 8 * (j) + (g))
#define XCD_BAR_WORDS 3584
#define XB_SPIN_CAP (1u << 18)

__device__ __forceinline__ unsigned xb_ld(unsigned* p)              { return __hip_atomic_load(p, __ATOMIC_RELAXED, __HIP_MEMORY_SCOPE_AGENT); }
__device__ __forceinline__ unsigned xb_add(unsigned* p, unsigned v) { return __hip_atomic_fetch_add(p, v, __ATOMIC_RELAXED, __HIP_MEMORY_SCOPE_AGENT); }
__device__ __forceinline__ unsigned xb_xcc_id() { return (unsigned)__builtin_amdgcn_s_getreg((3 << 11) | 20) & 0xFu; }
#define XB_SPIN(cond, bar) do { unsigned _sp = 0; while (cond) { __builtin_amdgcn_s_sleep(1); \
    if ((++_sp & 255u) == 0u) { if (xb_ld(&(bar)[XB_TMO])) break; if (_sp > XB_SPIN_CAP) { atomicAdd(&(bar)[XB_TMO], 1u); break; } } } } while (0)

__device__ __forceinline__ int xb_fresh_lane() { unsigned z = 0u; asm volatile("" : "+v"(z)); return (int)__builtin_amdgcn_mbcnt_hi(~0u, __builtin_amdgcn_mbcnt_lo(~0u, z)); }
struct XcdBarrier {
    unsigned* bar; unsigned x; int wave;
    volatile LAS unsigned* st;
};

__device__ __forceinline__ XcdBarrier xcd_barrier_post(unsigned* bar, volatile LAS unsigned* st, int wave) {
    XcdBarrier b; b.bar = bar; b.x = xb_xcc_id(); b.st = st; b.wave = wave;
    return b;
}
__device__ __forceinline__ void xcd_barrier_complete(unsigned* bar, unsigned x, unsigned& nloc, unsigned& nx, unsigned& coloc) {
    const unsigned G = gridDim.x * gridDim.y * gridDim.z;
    unsigned sum, cnt, mine, split, sp = 0u;
    for (;;) {
        sum = 0u; cnt = 0u; mine = 0u; split = 0u;
#pragma unroll 1
        for (unsigned j = 0; j < 16; ++j) { unsigned c = 0u;
#pragma unroll
            for (unsigned g = 0; g < 8; ++g) { const unsigned cg = xb_ld(&bar[XB_GCNT(j, g)]); c += cg; split |= (cg != 0u && cg * 8u != G) ? 1u : 0u; }
            sum += c; cnt += (c > 0u) ? 1u : 0u; mine = (j == x) ? c : mine; }
        if (sum == G) break;
        __builtin_amdgcn_s_sleep(1);
        if ((++sp & 255u) == 0u) { if (xb_ld(&bar[XB_TMO])) { split = 1u; break; } if (sp > XB_SPIN_CAP) { atomicAdd(&bar[XB_TMO], 1u); split = 1u; break; } }
    }
    nloc = mine > 0u ? mine : 1u; nx = cnt > 0u ? cnt : 1u; coloc = (split == 0u && (G & 7u) == 0u) ? 1u : 0u;
}

__device__ __forceinline__ void xcd_barrier_setup(const XcdBarrier& b) {
    if (b.wave == 0 && xb_fresh_lane() == 0) {
        (void)xb_add(&b.bar[XB_GCNT(b.x, blockIdx.x & 7u)], 1u);
        unsigned nloc, nx, coloc; xcd_barrier_complete(b.bar, b.x, nloc, nx, coloc); b.st[0] = nloc; b.st[1] = nx; b.st[2] = coloc;
    }
}
__device__ __forceinline__ void xcd_barrier(const XcdBarrier& b, const bool light = false, const bool local = false) {
    asm volatile("s_waitcnt vmcnt(0)" ::: "memory");
    __syncthreads();
    if (b.wave == 0 && xb_fresh_lane() == 0) {
        unsigned* bar = b.bar;
        __builtin_amdgcn_s_waitcnt(0);
        const unsigned nloc = b.st[0], nx = b.st[1];
        const unsigned old = xb_add(&bar[XB_XSUB(b.x)], 1u);
        const unsigned gen = old / nloc;
        if (old + 1u == (gen + 1u) * nloc) {
            if (!(light && b.st[2] != 0u)) __builtin_amdgcn_fence(__ATOMIC_RELEASE, "agent");
            asm volatile("s_waitcnt vmcnt(0)" ::: "memory");
            if (!(local && light && b.st[2] != 0u)) {
            const unsigned og = xb_add(&bar[XB_TOP], 1u);
            const unsigned tg = og / nx;
            if (og + 1u == (tg + 1u) * nx) xb_add(&bar[XB_TOPGEN], 1u);
            else XB_SPIN(xb_ld(&bar[XB_TOPGEN]) == tg, bar);
            }
            __builtin_amdgcn_fence(__ATOMIC_ACQUIRE, "agent");
            xb_add(&bar[XB_XGEN(b.x)], 1u);
            asm volatile("s_waitcnt vmcnt(0)" ::: "memory");
        } else {
            XB_SPIN(xb_ld(&bar[XB_XGEN(b.x)]) == gen, bar);
            __builtin_amdgcn_fence(__ATOMIC_ACQUIRE, "agent");
            asm volatile("s_waitcnt vmcnt(0)" ::: "memory");
        }
    }
    __syncthreads();
}

__device__ __forceinline__ void quad_barrier(unsigned* cnt, unsigned* bar, int wave) {
    asm volatile("s_waitcnt vmcnt(0)" ::: "memory");
    __syncthreads();
    if (wave == 0 && xb_fresh_lane() == 0) {
        __builtin_amdgcn_s_waitcnt(0);
        (void)xb_add(cnt, 1u);
        XB_SPIN(xb_ld(cnt) < 4u, bar);
        __builtin_amdgcn_fence(__ATOMIC_ACQUIRE, "agent");
        asm volatile("s_waitcnt vmcnt(0)" ::: "memory");
    }
    __syncthreads();
}

namespace mx {
typedef short s16x4 __attribute__((ext_vector_type(4)));
typedef short v4i16_t __attribute__((ext_vector_type(4)));
typedef short bf16x8 __attribute__((ext_vector_type(8)));
typedef float f32x2 __attribute__((ext_vector_type(2)));
typedef unsigned u32x2 __attribute__((ext_vector_type(2)));
constexpr int KI = 0, VI = 32768, QI = 65536, SI = 98304, GNL = 131072;

__device__ __forceinline__ unsigned off_a(unsigned row, unsigned ch) { return 2048u * (row >> 3) + 512u * (ch >> 2) + 64u * (row & 7u) + 16u * ((ch & 3u) ^ ((row >> 2) & 3u)); }
struct LaneAddr { unsigned tr[2][2], row, kap[2]; };
__device__ __forceinline__ void lane_addr(LaneAddr& A, unsigned lane) {
    const unsigned g = lane >> 4, li = lane & 15u, q = li >> 2, p = lane & 3u;
#pragma unroll
    for (unsigned cp = 0; cp < 2; ++cp)
#pragma unroll
        for (unsigned t = 0; t < 2; ++t) A.tr[cp][t] = 2048u * g + 64u * q + 32u * (cp ^ (g & 1u)) + 16u * ((p >> 1) ^ t) + 8u * (p & 1u);
    A.row = 2048u * (li >> 3) + 64u * (li & 7u) + 16u * (g ^ ((li >> 2) & 3u));
#pragma unroll
    for (unsigned t = 0; t < 2; ++t) A.kap[t] = 2048u * (li >> 2) + 64u * (li & 3u) + 16u * ((g ^ (2u * ((li >> 2) & 1u))) ^ t);
}
__device__ __forceinline__ bf16x8 tr_frag(LAS const unsigned char* img, const LaneAddr& A, int c, int ks) {
    const s16x4 lo = __builtin_bit_cast(s16x4, __builtin_amdgcn_ds_read_tr16_b64_v4i16((LAS v4i16_t*)(img + A.tr[c & 1][0] + (8192 * ks + 512 * (c >> 1)))));
    const s16x4 hi = __builtin_bit_cast(s16x4, __builtin_amdgcn_ds_read_tr16_b64_v4i16((LAS v4i16_t*)(img + A.tr[c & 1][1] + (8192 * ks + 512 * (c >> 1) + 256))));
    return __builtin_shufflevector(lo, hi, 0, 1, 2, 3, 4, 5, 6, 7);
}
__device__ __forceinline__ bf16x8 row_frag(LAS const unsigned char* img, const LaneAddr& A, int rb, int s) { return *(LAS const bf16x8*)(img + A.row + (4096 * rb + 512 * s)); }
__device__ __forceinline__ bf16x8 kap_frag(LAS const unsigned char* img, const LaneAddr& A, int kp, int t, int ks) { return *(LAS const bf16x8*)(img + A.kap[t] + (8192 * kp + 512 * ks + 256 * t)); }
__device__ __forceinline__ float gamma_log(int h) { return logf(1.0f - exp2f(-5.0f - (float)h)); }
__device__ __forceinline__ float to_sgpr(float v) { return __builtin_bit_cast(float, __builtin_amdgcn_readfirstlane(__builtin_bit_cast(int, v))); }
__device__ __forceinline__ int opaque_s(int v) { asm volatile("" : "+s"(v)); return v; }

__device__ __forceinline__ void tile_load(v4u (&v)[4], const bf16* src, int tid) {
    const GAS v4u* g = (const GAS v4u*)(src + (size_t)(tid >> 2) * ZP + (tid & 3) * 32);
#pragma unroll
    for (int c = 0; c < 4; ++c) v[c] = g[(c + tid) & 3];
}
template <bool SCALE> __device__ __forceinline__ void tile_store(LAS unsigned char* img, const v4u (&v)[4], float rowscale, int tid) {
    const unsigned row = (unsigned)tid >> 2, sb = 2048u * (row >> 3) + 512u * ((unsigned)tid & 3u) + 64u * (row & 7u), r2 = (row >> 2) & 3u;
#pragma unroll
    for (int c = 0; c < 4; ++c) {
        v4u o = v[c];
        if (SCALE) {
            const unsigned w[4] = {o.x, o.y, o.z, o.w}; unsigned r[4];
#pragma unroll
            for (int i = 0; i < 4; ++i) r[i] = pg8::cvt_pk_bf16(__uint_as_float(w[i] << 16) * rowscale, __uint_as_float(w[i] & 0xffff0000u) * rowscale);
            o.x = r[0]; o.y = r[1]; o.z = r[2]; o.w = r[3];
        }
        *(LAS v4u*)(img + sb + 16u * ((((unsigned)c + (unsigned)tid) & 3u) ^ r2)) = o;
    }
}
#define MX_MFMA(a, b, c) __builtin_amdgcn_mfma_f32_16x16x32_bf16((a), (b), (c), 0, 0, 0)

#define MX_DPP(v, ctrl) __builtin_bit_cast(float, __builtin_amdgcn_mov_dpp(__builtin_bit_cast(int, (v)), (ctrl), 0xf, 0xf, true))
#define MX_SWZ(v, pat) __builtin_bit_cast(float, __builtin_amdgcn_ds_swizzle(__builtin_bit_cast(int, (v)), (pat)))
__device__ __forceinline__ void wave_sum4(float (&s)[4], int lane) {
    const bool b0 = (lane & 1) != 0, b1 = (lane & 2) != 0;
    float k0 = b0 ? s[2] : s[0], k1 = b0 ? s[3] : s[1];
    const float t0 = b0 ? s[0] : s[2], t1 = b0 ? s[1] : s[3];
    k0 += MX_DPP(t0, 0xB1); k1 += MX_DPP(t1, 0xB1);
    float k = b1 ? k1 : k0; const float t = b1 ? k0 : k1;
    k += MX_DPP(t, 0x4E);
    k += MX_SWZ(k, 0x101F); k += MX_SWZ(k, 0x201F); k += MX_SWZ(k, 0x401F); k += __shfl_xor(k, 32);
    s[0] = MX_DPP(k, 0x00); s[2] = MX_DPP(k, 0x55); s[1] = MX_DPP(k, 0xAA); s[3] = MX_DPP(k, 0xFF);
}
__device__ __forceinline__ void conv_phase(LAS unsigned char* L, const bf16* ZB, bf16* MIXB, const float* dw_w, const float* dw_b, const float* ln_g, const float* ln_b, int bx, int wave) {
    const int lane0 = xb_fresh_lane(), cp0 = (wave * 64 + lane0) & 255, half = wave >> 2;
    f32x2 w2[CONVW];
#pragma unroll
    for (int j = 0; j < CONVW; ++j) w2[j] = *(const GAS f32x2*)(dw_w + j * CCH + 2 * cp0);
    const f32x2 b2 = *(const GAS f32x2*)(dw_b + 2 * cp0);
    LAS float* CT = (LAS float*)L;
    unsigned u[32 + CONVW - 1];
#define CONV_LOAD(tl) do { const int mt_ = bx * 256 + 128 * half + (tl) * 32, rmin_ = (CONVW - 1) - (mt_ % SEQ);     \
        const __amdgpu_buffer_rsrc_t rs_ = __builtin_amdgcn_make_buffer_rsrc((void*)(ZB + ((long)mt_ - (CONVW - 1)) * ZP), 0, (32 + CONVW - 1) * ZP * 2, 0x00020000);     \
        if (rmin_ <= 0) { _Pragma("unroll") for (int r = 0; r < 32 + CONVW - 1; ++r) u[r] = (unsigned)__builtin_amdgcn_raw_buffer_load_b32(rs_, cpl * 4, r * ZP * 2, 0); } \
        else { int rv_ = rmin_; asm volatile("" : "+v"(rv_));     \
               _Pragma("unroll") for (int r = 0; r < 32 + CONVW - 1; ++r) u[r] = (unsigned)__builtin_amdgcn_raw_buffer_load_b32(rs_, cpl * 4 + (r < rv_ ? 0x40000000 : 0), r * ZP * 2, 0); } } while (0)
    { const int cpl = cp0; CONV_LOAD(0); }
    { const int t_ = wave * 64 + lane0; ((LAS float*)(L + 131072))[t_] = ln_g[t_]; ((LAS float*)(L + 131072 + 2048))[t_] = ln_b[t_]; }
    for (int tile = 0; tile < 4; ++tile) {
        int lane = lane0; asm volatile("" : "+v"(lane));
        const int cp = (wave * 64 + lane) & 255;
        const int mt = bx * 256 + tile * 32;
        f32x2 acc[32];
#pragma unroll
        for (int t = 0; t < 32; ++t) acc[t] = b2;
        const int mtn_ = bx * 256 + 128 * half + (tile < 3 ? tile + 1 : 3) * 32;
        const __amdgpu_buffer_rsrc_t rsn_ = __builtin_amdgcn_make_buffer_rsrc((void*)(ZB + ((long)mtn_ - (CONVW - 1)) * ZP), 0, (32 + CONVW - 1) * ZP * 2, 0x00020000);
        __builtin_amdgcn_sched_barrier(0);
#pragma unroll
        for (int r = 0; r < 32 + CONVW - 1; ++r) {
            const f32x2 h2 = {__uint_as_float(u[r] << 16), __uint_as_float(u[r] & 0xffff0000u)};
#pragma unroll
            for (int t = (r - (CONVW - 1) > 0 ? r - (CONVW - 1) : 0); t <= (r < 31 ? r : 31); ++t) acc[t] = w2[r - t] * h2 + acc[t];
            if (r < CONVW - 1) u[r] = (tile < 3) ? u[r + 32] : u[r]; else u[r] = (unsigned)__builtin_amdgcn_raw_buffer_load_b32(rsn_, cp * 4, r * ZP * 2, 0);
            __builtin_amdgcn_sched_barrier(0);
        }
#pragma unroll
        for (int t = 0; t < 32; ++t) *(LAS f32x2*)(CT + (32 * half + t) * CCH + 2 * cp) = acc[t];
        __builtin_amdgcn_sched_barrier(0);
        asm volatile("s_waitcnt lgkmcnt(0)" ::: "memory"); __builtin_amdgcn_s_barrier(); asm volatile("" ::: "memory");
        {
            const f32x4 g0 = *(const LAS f32x4*)(L + 131072 + 32 * lane), g1 = *(const LAS f32x4*)(L + 131072 + 32 * lane + 16), be0 = *(const LAS f32x4*)(L + 131072 + 2048 + 32 * lane), be1 = *(const LAS f32x4*)(L + 131072 + 2048 + 32 * lane + 16);
#pragma unroll
            for (int hb = 0; hb < 2; ++hb) {
                f32x4 v0[4], v1[4]; float sm[4];
#pragma unroll
                for (int i = 0; i < 4; ++i) { v0[i] = *(LAS f32x4*)(CT + (8 * wave + 4 * hb + i) * CCH + 8 * lane); v1[i] = *(LAS f32x4*)(CT + (8 * wave + 4 * hb + i) * CCH + 8 * lane + 4);
                    sm[i] = (v0[i][0] + v0[i][1]) + (v0[i][2] + v0[i][3]) + (v1[i][0] + v1[i][1]) + (v1[i][2] + v1[i][3]); }
                wave_sum4(sm, lane);
#pragma unroll
                for (int i = 0; i < 4; ++i) { const float mean = sm[i] * (1.0f / CCH); v0[i] = v0[i] - mean; v1[i] = v1[i] - mean;
                    sm[i] = (v0[i][0] * v0[i][0] + v0[i][1] * v0[i][1]) + (v0[i][2] * v0[i][2] + v0[i][3] * v0[i][3]) + (v1[i][0] * v1[i][0] + v1[i][1] * v1[i][1]) + (v1[i][2] * v1[i][2] + v1[i][3] * v1[i][3]); }
                wave_sum4(sm, lane);
#pragma unroll
                for (int i = 0; i < 4; ++i) { const float rstd = rsqrtf(sm[i] * (1.0f / CCH) + LN_EPS);
                    f32x4 y0 = v0[i] * rstd * g0 + be0, y1 = v1[i] * rstd * g1 + be1;
                    y0 = y0 * pg8::sig4(y0); y1 = y1 * pg8::sig4(y1);
                    *(GAS v4u*)(MIXB + (size_t)(mt + 128 * (wave >> 2) + 8 * (wave & 3) + 4 * hb + i) * D + 8 * lane) = pg8::pack8(y0, y1); }
                __builtin_amdgcn_sched_barrier(0);
            }
        }
        asm volatile("s_waitcnt lgkmcnt(0)" ::: "memory"); __builtin_amdgcn_s_barrier(); asm volatile("" ::: "memory");
    }
#undef CONV_LOAD
}

__device__ __forceinline__ void state_mfma(f32x4 (&sacc)[8], LAS const unsigned char* Kimg, LAS const unsigned char* Vimg, const LaneAddr& A, int wave) {
    LAS const unsigned char* Kw = Kimg + 512 * (wave >> 1);
#pragma unroll
    for (int kp = 0; kp < 4; ++kp) {
        const bf16x8 kf = (wave & 1) ? tr_frag(Kw, A, 1, kp) : tr_frag(Kw, A, 0, kp);
        bf16x8 vf[8];
#pragma unroll
        for (int eb = 0; eb < 8; ++eb) vf[eb] = tr_frag(Vimg, A, eb, kp);
#pragma unroll
        for (int eb = 0; eb < 8; ++eb) sacc[eb] = MX_MFMA(kf, vf[eb], sacc[eb]);
    }
}
__device__ __forceinline__ void ret_state_phase(LAS unsigned char* L, const bf16* ZB, float* Tf, int bx, int wave) {
    const int lane0 = xb_fresh_lane(), bh = bx >> 3, cg = bx & 7, b = bh >> 2, h = opaque_s(bh & 3);
    const float lg = to_sgpr(gamma_log(h)), kscale = expf(-(float)((wave * 64 + lane0) >> 2) * lg), g128 = to_sgpr(expf(128.0f * lg));
    f32x4 sacc[8];
#pragma unroll
    for (int eb = 0; eb < 8; ++eb) sacc[eb] = (f32x4){0.f, 0.f, 0.f, 0.f};
    v4u kr[2][4], vr[2][4];
    { const size_t m0 = (size_t)b * SEQ + (size_t)(cg * 8) * RC; const int tid0 = wave * 64 + lane0;
#pragma unroll
      for (int s2 = 0; s2 < 2; ++s2) { tile_load(kr[s2], ZB + (m0 + s2 * RC) * ZP + 512 + 512 * h + 128, tid0); tile_load(vr[s2], ZB + (m0 + s2 * RC) * ZP + 512 + 512 * h + 256, tid0); } }
    for (int j = 0; j < 8; j += 2) {
#pragma unroll
        for (int s2 = 0; s2 < 2; ++s2) {
            int lane = lane0; asm volatile("" : "+v"(lane));
            const int tid = wave * 64 + lane;
#ifdef STAMP_R1
            if (wave == 0) { __builtin_amdgcn_sched_barrier(0); asm volatile("s_memtime %0\n\ts_waitcnt lgkmcnt(0)" : "=s"(q_t0) :: "memory"); __builtin_amdgcn_sched_barrier(0); }
#endif
            tile_store<true>(L + KI, kr[s2], kscale, tid); tile_store<false>(L + VI, vr[s2], 1.0f, tid);
            asm volatile("s_waitcnt lgkmcnt(0)" ::: "memory"); __builtin_amdgcn_s_barrier(); asm volatile("" ::: "memory");
            if (j + s2 + 2 < 8) { const size_t m2 = (size_t)b * SEQ + (size_t)(cg * 8 + j + s2 + 2) * RC; tile_load(kr[s2], ZB + m2 * ZP + 512 + 512 * h + 128, tid); tile_load(vr[s2], ZB + m2 * ZP + 512 + 512 * h + 256, tid); }
#pragma unroll
            for (int eb = 0; eb < 8; ++eb) sacc[eb] = sacc[eb] * g128;
            LaneAddr A; lane_addr(A, (unsigned)lane);
            state_mfma(sacc, L + KI, L + VI, A, wave);
            asm volatile("s_waitcnt lgkmcnt(0)" ::: "memory"); __builtin_amdgcn_s_barrier(); asm volatile("" ::: "memory");
#ifdef STAMP_R1
            if (wave == 0) { unsigned long long t_; __builtin_amdgcn_sched_barrier(0); asm volatile("s_memtime %0\n\ts_waitcnt lgkmcnt(0)" : "=s"(t_) :: "memory"); __builtin_amdgcn_sched_barrier(0); q_sum += t_ - q_t0; }
#endif
        }
    }
    GAS f32x4* dst = (GAS f32x4*)Tf + (size_t)(bx * 8 + wave) * 8 * 64 + lane0;
#pragma unroll
    for (int eb = 0; eb < 8; ++eb) dst[eb * 64] = sacc[eb];
#ifdef STAMP_R1
    if (wave == 0 && bx == STAMP_BX) { const unsigned long long r0_ = __builtin_amdgcn_s_memrealtime(), dt_ = q_sum * 8ull; while (__builtin_amdgcn_s_memrealtime() - r0_ < dt_) __builtin_amdgcn_s_sleep(16); }
#endif
}
template <int ABL> __device__ __forceinline__ void ret_out_phase(LAS unsigned char* L, const bf16* ZB, bf16* MIXB, const float* Tf, const float* gn_g, const float* gn_b, int bx, int wave) {
    const int lane0 = xb_fresh_lane(), bh = bx >> 3, cg = bx & 7, b = bh >> 2, h = opaque_s(bh & 3);
    const float lg = to_sgpr(gamma_log(h)), kscale = expf(-(float)((wave * 64 + lane0) >> 2) * lg), qscale = expf((float)((wave * 64 + lane0) >> 2) * lg), g128 = to_sgpr(expf(128.0f * lg)), cd8 = to_sgpr(expf(1024.0f * lg));
    if (wave < 4) { const int t_ = wave * 64 + lane0, c_ = t_ & 127; ((LAS float*)(L + GNL))[t_] = (t_ < 128 ? gn_g : gn_b)[h * RD + c_]; }
    f32x4 sacc[8];
#pragma unroll
    for (int eb = 0; eb < 8; ++eb) sacc[eb] = (f32x4){0.f, 0.f, 0.f, 0.f};
    v4u kr[4], vr[4], qr[4];
    { const size_t m0 = (size_t)b * SEQ + (size_t)(cg * 8) * RC; const int tid0 = wave * 64 + lane0;
      if (!(ABL & 1)) { tile_load(kr, ZB + m0 * ZP + 512 + 512 * h + 128, tid0); tile_load(vr, ZB + m0 * ZP + 512 + 512 * h + 256, tid0); tile_load(qr, ZB + m0 * ZP + 512 + 512 * h, tid0); }
      else { for (int c = 0; c < 4; ++c) { kr[c] = (v4u){0u, 0u, 0u, 0u}; vr[c] = kr[c]; qr[c] = kr[c]; } } }
    { float coef = 1.0f;
      for (int g2 = cg - 1; g2 >= 0; g2 -= 4) {
          f32x4 tv[4][8]; float cf[4];
#pragma unroll
          for (int u = 0; u < 4; ++u) { const int gi = g2 - u, gc = gi < 0 ? 0 : gi; cf[u] = gi < 0 ? 0.f : coef; coef *= cd8;
              const GAS f32x4* src = (const GAS f32x4*)Tf + (size_t)((bh * 8 + gc) * 8 + wave) * 8 * 64 + lane0;
#pragma unroll
              for (int eb = 0; eb < 8; ++eb) tv[u][eb] = src[eb * 64]; }
#pragma unroll
          for (int u = 0; u < 4; ++u)
#pragma unroll
              for (int eb = 0; eb < 8; ++eb) sacc[eb] = sacc[eb] + tv[u][eb] * cf[u]; } }
    for (int j = 0; j < 8; ++j) {
        int lane = lane0; asm volatile("" : "+v"(lane));
        const int tid = wave * 64 + lane, g = lane >> 4, li = lane & 15;
        const int qb = wave < 4 ? wave : 11 - wave;
        const size_t m0 = (size_t)b * SEQ + (size_t)(cg * 8 + j) * RC;
        if (!(ABL & 2)) { tile_store<true>(L + KI, kr, kscale, tid); tile_store<false>(L + VI, vr, 1.0f, tid); tile_store<true>(L + QI, qr, qscale, tid); }
        LaneAddr A; lane_addr(A, (unsigned)lane);
        { const unsigned stb = 2048u * ((unsigned)li >> 3) + 512u * ((unsigned)wave >> 1) + 64u * ((unsigned)li & 7u) + 16u * ((2u * ((unsigned)wave & 1u) + ((unsigned)g >> 1)) ^ (((unsigned)li >> 2) & 3u)) + 8u * ((unsigned)g & 1u);
#pragma unroll
          for (int eb = 0; eb < 8; ++eb) { sacc[eb] = sacc[eb] * g128; const f32x4 sv = sacc[eb]; u32x2 w;     w.x = pg8::cvt_pk_bf16(sv[0], sv[1]); w.y = pg8::cvt_pk_bf16(sv[2], sv[3]);
              *(LAS u32x2*)(L + SI + stb + 4096 * eb) = w; } }
        asm volatile("s_waitcnt lgkmcnt(0)" ::: "memory"); __builtin_amdgcn_s_barrier(); asm volatile("" ::: "memory");
        const size_t m1 = m0 + RC; const bool pfn = (j < 7) && !(ABL & 1);
        const size_t mrow = m0 + 16 * qb + li;
        u32x2 gw[8];
#pragma unroll
        for (int eb = 0; eb < 8; ++eb) gw[eb] = (ABL & 1) ? (u32x2){0u, 0u} : *(const GAS u32x2*)(ZB + mrow * ZP + 512 + 512 * h + 384 + 16 * eb + 4 * g);
        if (pfn) tile_load(kr, ZB + m1 * ZP + 512 + 512 * h + 128, tid);
        __builtin_amdgcn_sched_barrier(0);
        f32x4 o[8];
#pragma unroll
        for (int eb = 0; eb < 8; ++eb) o[eb] = (f32x4){0.f, 0.f, 0.f, 0.f};
        if (!(ABL & 4)) {
        bf16x8 qf[4];
#pragma unroll
        for (int ks = 0; ks < 4; ++ks) qf[ks] = row_frag(L + QI + 4096 * qb, A, 0, ks);
        bf16x8 pf[4];
#pragma unroll
        for (int kp = 0; kp < 4; ++kp) {
            unsigned pw[4] = {0u, 0u, 0u, 0u};
            if (kp <= (qb >> 1)) {
#pragma unroll
                for (int t = 0; t < 2; ++t) {
                    f32x4 x = (f32x4){0.f, 0.f, 0.f, 0.f};
#pragma unroll
                    for (int ks = 0; ks < 4; ++ks) x = MX_MFMA(kap_frag(L + KI, A, kp, t, ks), qf[ks], x);
                    { const int key0 = 32 * kp + 8 * g + 4 * t, ql = 16 * qb + li;
#pragma unroll
                        for (int r = 0; r < 4; ++r) x[r] = (key0 + r <= ql) ? x[r] : 0.f; }
                    pw[2 * t] = pg8::cvt_pk_bf16(x[0], x[1]); pw[2 * t + 1] = pg8::cvt_pk_bf16(x[2], x[3]);
                }
            }
            pf[kp] = __builtin_bit_cast(bf16x8, (v4u){pw[0], pw[1], pw[2], pw[3]});
        }
        __builtin_amdgcn_sched_barrier(0); if (pfn) tile_load(vr, ZB + m1 * ZP + 512 + 512 * h + 256, tid); __builtin_amdgcn_sched_barrier(0);
#pragma unroll
        for (int eb = 0; eb < 8; ++eb) {
#pragma unroll
            for (int ks = 0; ks < 4; ++ks) o[eb] = MX_MFMA(row_frag(L + SI, A, eb, ks), qf[ks], o[eb]);
        }
        __builtin_amdgcn_sched_barrier(0); if (pfn) tile_load(qr, ZB + m1 * ZP + 512 + 512 * h, tid); __builtin_amdgcn_sched_barrier(0);
#pragma unroll
        for (int kp = 0; kp < 4; ++kp) {
            const bf16x8 kf = (wave & 1) ? tr_frag(L + KI + 512 * (wave >> 1), A, 1, kp) : tr_frag(L + KI + 512 * (wave >> 1), A, 0, kp);
            bf16x8 vf[8];
#pragma unroll
            for (int eb = 0; eb < 8; ++eb) vf[eb] = tr_frag(L + VI, A, eb, kp);
#pragma unroll
            for (int eb = 0; eb < 8; ++eb) {
                o[eb] = MX_MFMA(vf[eb], pf[kp], o[eb]);
                sacc[eb] = MX_MFMA(kf, vf[eb], sacc[eb]); }
        }
        }
        if (!(ABL & 8)) {
        float s1 = 0.f;
#pragma unroll
        for (int eb = 0; eb < 8; ++eb) s1 += (o[eb][0] + o[eb][1]) + (o[eb][2] + o[eb][3]);
        s1 += MX_SWZ(s1, 0x401F); s1 += __shfl_xor(s1, 32);
        const float mean = s1 * (1.0f / RD); float s2 = 0.f;
#pragma unroll
        for (int eb = 0; eb < 8; ++eb) { o[eb] = o[eb] - mean; s2 += (o[eb][0] * o[eb][0] + o[eb][1] * o[eb][1]) + (o[eb][2] * o[eb][2] + o[eb][3] * o[eb][3]); }
        s2 += MX_SWZ(s2, 0x401F); s2 += __shfl_xor(s2, 32);
        const float rstd = rsqrtf(s2 * (1.0f / RD) + LN_EPS);
#pragma unroll
        for (int eb = 0; eb < 8; ++eb) { const int e0 = h * RD + 16 * eb + 4 * g;
            const f32x4 gg = *(const LAS f32x4*)(L + GNL + 4 * (16 * eb + 4 * g)), gb = *(const LAS f32x4*)(L + GNL + 512 + 4 * (16 * eb + 4 * g));
            const f32x4 gt = (f32x4){__uint_as_float(gw[eb].x << 16), __uint_as_float(gw[eb].x & 0xffff0000u), __uint_as_float(gw[eb].y << 16), __uint_as_float(gw[eb].y & 0xffff0000u)};
            const f32x4 y = (o[eb] * rstd * gg + gb) * (gt * pg8::sig4(gt));
            u32x2 w; w.x = pg8::cvt_pk_bf16(y[0], y[1]); w.y = pg8::cvt_pk_bf16(y[2], y[3]);
            *(GAS u32x2*)(MIXB + mrow * D + CCH + e0) = w; }
        }
        asm volatile("s_waitcnt lgkmcnt(0)" ::: "memory"); __builtin_amdgcn_s_barrier(); asm volatile("" ::: "memory");
    }
}
#undef MX_MFMA
}

struct Args {
    const float* x; const float* p; const int* pos; const float* norm_mix_g; const float* w_in; const float* dw_w; const float* dw_b; const float* ln_g; const float* ln_b;
    const float* gn_g; const float* gn_b; const float* w_out; const float* norm_ffn_g; const float* w_ff1; const float* w_ff2; const float* norm_ple_g; const float* w_gate; const float* w_proj;
    const float* final_g; float* out; unsigned char* ws; int ph_lo, ph_hi, li, pad;
};
__device__ __forceinline__ int inmap(int s) {
    if (s < 512) return 256 * (s >> 7) + (s & 127);
    if (s < 1024) { const int ch = s - 512; return 256 * (ch >> 7) + 128 + (ch & 127); }
    if (s < 2048) { const int k = s >= 1536, r = s - (k ? 1536 : 1024), hq = r >> 7, dd = r & 127; return 256 * ((k ? 6 : 4) + (hq >> 1)) + 128 * (dd >> 6) + 64 * (hq & 1) + (dd & 63); }
    return s;
}
template <bool INMAP> __device__ __forceinline__ void tr_item(const float* W, int K, int N, const float* gain, bf16* WT, LAS float* scr, int item, int lane) {
    const int nblk = N / 32, kb = item / nblk, nb = item % nblk, k0 = 64 * kb, n0 = 32 * nb;
    float wv[32];
#pragma unroll
    for (int i = 0; i < 32; ++i) wv[i] = W[(size_t)(k0 + 2 * i + (lane >> 5)) * N + n0 + (lane & 31)];
#pragma unroll
    for (int i = 0; i < 32; ++i) { const int kk = 2 * i + (lane >> 5); scr[kk * 33 + (lane & 31)] = wv[i] * (gain ? gain[k0 + kk] : 1.0f); }
    LDS_WAIT(); asm volatile("" ::: "memory");
    const int c = lane & 7;
#pragma unroll
    for (int j = 0; j < 4; ++j) { const int n = (lane >> 3) + 8 * j; const LAS float* s = scr + (8 * c) * 33 + n;
        const int src = n0 + n; const int r = INMAP ? inmap(src) : src; const float cs = (INMAP && src >= 1536 && src < 2048) ? 0.088388347648318447f : 1.0f;
        v4u o; o.x = pk2(s[0 * 33] * cs, s[1 * 33] * cs); o.y = pk2(s[2 * 33] * cs, s[3 * 33] * cs); o.z = pk2(s[4 * 33] * cs, s[5 * 33] * cs); o.w = pk2(s[6 * 33] * cs, s[7 * 33] * cs);
        *(GAS v4u*)(WT + (size_t)r * K + k0 + 8 * c) = o; }
    LDS_WAIT(); asm volatile("" ::: "memory");
}

__device__ __forceinline__ const void* lds_ptr(LAS unsigned char* p) {
    const unsigned lo = __builtin_amdgcn_readfirstlane(((volatile LAS unsigned*)p)[0]), hi = __builtin_amdgcn_readfirstlane(((volatile LAS unsigned*)p)[1]);
    return (const void*)(((unsigned long long)hi << 32) | lo);
}
__device__ __forceinline__ void stagger_start(int bx, unsigned quarter_ticks) {
    const unsigned g = ((unsigned)bx >> 6) & 3u; if (g == 0u) return;
    const unsigned long long t0 = __builtin_amdgcn_s_memrealtime(), dt = (unsigned long long)g * quarter_ticks;
    while (__builtin_amdgcn_s_memrealtime() - t0 < dt) __builtin_amdgcn_s_sleep(32);
}
#ifndef STAGGER_TICKS
#define STAGGER_TICKS 0
#endif
#ifndef PROBE_DUP
#define PROBE_DUP (-1)
#endif
#ifndef PROBE_ABL
#define PROBE_ABL 0
#endif
#define DUPN(k) ((PROBE_DUP == (k)) ? 2 : 1)
__global__ void __launch_bounds__(NWAVES * 64, 2) mk_fwd(Args a) {
    extern __shared__ __attribute__((aligned(16))) unsigned char lds[];
    LAS unsigned char* const L = (LAS unsigned char*)lds;
    volatile LAS unsigned* MISC = (volatile LAS unsigned*)(L + MISC_OFF);
    const int wave = __builtin_amdgcn_readfirstlane(threadIdx.x >> 6);
#define LANE_ID() xb_fresh_lane()
    const int G = gridDim.x, bx = blockIdx.x;
    unsigned char* ws = a.ws;
    gu32* ctl = (gu32*)(ws + WS_CTL);
    if (threadIdx.x < 64) MISC[threadIdx.x] = 0u;
    if (threadIdx.x < sizeof(Args) / 4) ((volatile LAS unsigned*)(L + ARGS_OFF))[threadIdx.x] = ((const unsigned*)&a)[threadIdx.x];
    __syncthreads();
#define ARGP(field) ((decltype(a.field))lds_ptr(L + ARGS_OFF + offsetof(Args, field)))
    XcdBarrier bar = xcd_barrier_post((unsigned*)(ctl + CW_BAR) + a.li * XCD_BAR_WORDS, MISC + 8, wave);
    xcd_barrier_setup(bar);
#ifdef PROBE_SUB
    const int sub = a.pad;
#else
    constexpr int sub = 0;
#endif
    const int lo = a.ph_lo, hi = a.ph_hi;
#define IN(k) (lo <= (k) && (k) < hi)
#define SEAM(k) do { if (IN(k) && IN((k) + 1)) { if (SEAM_QUAD(k) && MISC[10] != 0u) quad_barrier((unsigned*)(ctl + CW_QUAD + ((k) * 64 + (bx & 7) * 8 + ((bx >> 3) & 7)) * 64), bar.bar, wave); else xcd_barrier(bar, (k) != 0 && (k) != 16, SEAM_LOCAL(k)); } } while (0)
#define SEAM_QUAD(k) ((k) == 4 || (k) == 5 || (k) == 6 || (k) == 12 || (k) == 13 || (k) == 14)
#define SEAM_LOCAL(k) ((k) != 0 && (k) != 16)
#define BXM (((int)blockIdx.x & 7) * 32 + ((int)blockIdx.x >> 3))
    const int gw = bx * NWAVES + wave, NGW = G * NWAVES;
    const size_t NGT = (size_t)G * NWAVES * 64;
    bf16* const XB = (bf16*)(ws + WS_XB); bf16* const ZB = (bf16*)(ws + WS_ZB); bf16* const HID = (bf16*)(ws + WS_HID);
    bf16* const XO = (bf16*)a.out;
    LAS float* const RED = (LAS float*)(L + RED_OFF);
    LAS float* const SSL = (LAS float*)(L + RED_OFF + 4096);
    bf16* const PROJ = (bf16*)(ws + WS_PROJ); bf16* const PB = (bf16*)(ws + WS_PB); unsigned* const ROPE = (unsigned*)(ws + WS_ROPE);

    if (IN(0))
#pragma clang loop unroll(full)
    for (int rep = 0; rep < DUPN(0); ++rep) {
        const int lane = LANE_ID(); const size_t gt = (size_t)bx * (NWAVES * 64) + wave * 64 + lane;
        LAS float* scr = (LAS float*)(L + RING_OFF + wave * 16384);
        constexpr int I_IN = (D / 64) * (INC / 32), I_OUT = (D / 64) * (D / 32), I_F1 = (D / 64) * (FF / 32), I_F2 = (FF / 64) * (D / 32), I_G = I_OUT, I_P = (PLE / 64) * (D / 32);
        constexpr int I_LAYER = I_IN + I_OUT + I_F1 + I_F2 + I_G + I_P;
        if (!(sub & 1)) for (int it = gw; it < DEPTH * I_LAYER; it += NGW) {
            const int l = it / I_LAYER; int r = it % I_LAYER; unsigned char* wl = ws + WS_W + (size_t)l * W_LAYER;
            if (r < I_IN) { tr_item<true>(a.w_in + (size_t)l * D * INC, D, INC, a.norm_mix_g + l * D, (bf16*)(wl + WO_IN), scr, r, lane); continue; } r -= I_IN;
            if (r < I_OUT) { tr_item<false>(a.w_out + (size_t)l * D * D, D, D, nullptr, (bf16*)(wl + WO_OUT), scr, r, lane); continue; } r -= I_OUT;
            if (r < I_F1) { tr_item<false>(a.w_ff1 + (size_t)l * D * FF, D, FF, a.norm_ffn_g + l * D, (bf16*)(wl + WO_FF1), scr, r, lane); continue; } r -= I_F1;
            if (r < I_F2) { tr_item<false>(a.w_ff2 + (size_t)l * FF * D, FF, D, nullptr, (bf16*)(wl + WO_FF2), scr, r, lane); continue; } r -= I_F2;
            if (r < I_G) { tr_item<false>(a.w_gate + (size_t)l * D * D, D, D, a.norm_ple_g + l * D, (bf16*)(wl + WO_GATE), scr, r, lane); continue; } r -= I_G;
            tr_item<false>(a.w_proj + (size_t)l * PLE * D, PLE, D, nullptr, (bf16*)(wl + WO_PROJ), scr, r, lane);
        }
        asm volatile("s_waitcnt vmcnt(0)" ::: "memory"); __syncthreads();
        if (wave == 0 && lane == 0 && rep == 0) { __builtin_amdgcn_fence(__ATOMIC_RELEASE, "agent"); asm volatile("s_waitcnt vmcnt(0)" ::: "memory"); (void)xb_add((unsigned*)(ctl + CW_WCNT), 1u); }
        const int rowb = (bx & 7) * SEQ + (bx >> 3) * 256;
        float* ss0 = (float*)(ws + WS_SS);
        const float inv_freq = 1.0f / powf(10000.0f, (float)lane * (2.0f / RD));
        if (!(sub & 2)) for (int t = 0; t < 8; ++t) {
            f32x4 v[4][4]; float s[4];
#pragma unroll
            for (int r = 0; r < 4; ++r) { const GAS f32x4* xr = (const GAS f32x4*)(a.x + (size_t)(rowb + wave + 8 * (4 * t + r)) * D) + 2 * lane;
                v[r][0] = xr[0]; v[r][1] = xr[1]; v[r][2] = xr[128]; v[r][3] = xr[129]; }
#pragma unroll
            for (int k = 4 * t; k < 4 * t + 4; ++k) { const size_t i = (size_t)rowb * 64 + (size_t)(wave * 64 + lane + k * (NWAVES * 64));
                const float ang = (float)a.pos[i >> 6] * inv_freq; float sn, cn; sincosf(ang, &sn, &cn);
                const pg8::f16x2 cs = {(_Float16)cn, (_Float16)sn};
                ROPE[i] = __builtin_bit_cast(unsigned, cs); }
#pragma unroll
            for (int r = 0; r < 4; ++r) { float q = 0.f;
#pragma unroll
                for (int j = 0; j < 4; ++j) q += (v[r][j].x * v[r][j].x + v[r][j].y * v[r][j].y) + (v[r][j].z * v[r][j].z + v[r][j].w * v[r][j].w);
                s[r] = q; }
#pragma unroll
            for (int o = 1; o < 64; o <<= 1) {
#pragma unroll
                for (int r = 0; r < 4; ++r) s[r] += __shfl_xor(s[r], o); }
#pragma unroll
            for (int r = 0; r < 4; ++r) { const size_t mr = (size_t)(rowb + wave + 8 * (4 * t + r));
                GAS v4u* o16 = (GAS v4u*)(XB + mr * D) + lane;
#pragma unroll
                for (int j = 0; j < 2; ++j) { v4u o; o.x = pk2(v[r][2 * j].x, v[r][2 * j].y); o.y = pk2(v[r][2 * j].z, v[r][2 * j].w); o.z = pk2(v[r][2 * j + 1].x, v[r][2 * j + 1].y); o.w = pk2(v[r][2 * j + 1].z, v[r][2 * j + 1].w); o16[64 * j] = o; }
                if (lane < 4) ss0[mr * 4 + lane] = lane == 0 ? s[r] : 0.f; }
        }
        if (!(sub & 4))
#pragma unroll
        for (int ll = 0; ll < DEPTH; ++ll) { const size_t e0 = ((size_t)ll * M + rowb) * PLE;
#pragma unroll 4
            for (int k = 0; k < 256 * PLE / 8 / (NWAVES * 64); ++k) { const size_t i = e0 + (size_t)(wave * 64 + lane + k * (NWAVES * 64)) * 8;
                const f32x4 p0 = *(const GAS f32x4*)(a.p + i), p1 = *(const GAS f32x4*)(a.p + i + 4);
                v4u o; o.x = pk2(p0.x, p0.y); o.y = pk2(p0.z, p0.w); o.z = pk2(p1.x, p1.y); o.w = pk2(p1.z, p1.w);
                *(GAS v4u*)(PB + i) = o; } }
        asm volatile("s_waitcnt vmcnt(0)" ::: "memory"); __syncthreads();
        if (wave == 0 && lane == 0) {
            if (rep == 0) { if (MISC[10] == 0u) { __builtin_amdgcn_fence(__ATOMIC_RELEASE, "agent"); asm volatile("s_waitcnt vmcnt(0)" ::: "memory"); }
                (void)xb_add((unsigned*)(ctl + CW_WCNT + 64 + (bx & 7) * 64), 1u); }
            XB_SPIN(xb_ld((unsigned*)(ctl + CW_WCNT)) < (unsigned)G, bar.bar); XB_SPIN(xb_ld((unsigned*)(ctl + CW_WCNT + 64 + (bx & 7) * 64)) < (unsigned)(G >> 3), bar.bar);
            __builtin_amdgcn_fence(__ATOMIC_ACQUIRE, "agent"); asm volatile("s_waitcnt vmcnt(0)" ::: "memory"); }
        __syncthreads();
    }
#pragma clang loop unroll(full)
    for (int l = 0; l < DEPTH; ++l) {
        const int pb = 1 + 8 * l;
        bf16* const XC = (l & 1) ? XO : XB; bf16* const XN = (l & 1) ? XB : XO;
        unsigned char* wl = ws + WS_W + (size_t)l * W_LAYER;
        const bf16* const ZBm = ZB + (size_t)(BXM >> 5) * ZB_BATCH_PAD;
        float* const TF = (float*)(ws + WS_HID + (size_t)(BXM >> 5) * (64 * MiB - 2 * MiB) + T_IN_ARENA);
        bf16* const MIXB = XN;
        float* const ss_a = (float*)(ws + WS_SS + (size_t)(3 * l + 0) * SS_SITE);
        float* const ss_b = (float*)(ws + WS_SS + (size_t)(3 * l + 1) * SS_SITE);
        float* const ss_c = (float*)(ws + WS_SS + (size_t)(3 * l + 2) * SS_SITE);
        float* const ss_d = (float*)(ws + WS_SS + (size_t)(3 * l + 3) * SS_SITE);
        gu32* const cntA = ctl + CW_HAND + ((l * 2 + 0) * 8 + (bx & 7)) * 64; gu32* const cntB = ctl + CW_HAND + ((l * 2 + 1) * 8 + (bx & 7)) * 64;
#define GROUP_SIGNAL(c) do { asm volatile("s_waitcnt vmcnt(0)" ::: "memory"); __syncthreads(); if (wave == 0 && LANE_ID() == 0) { \
            if (MISC[10] == 0u) { __builtin_amdgcn_fence(__ATOMIC_RELEASE, "agent"); asm volatile("s_waitcnt vmcnt(0)" ::: "memory"); }     \
            (void)xb_add((unsigned*)(c), 1u); } } while (0)
#define GROUP_WAIT(c, n) do { if (wave == 0 && LANE_ID() == 0) { XB_SPIN(xb_ld((unsigned*)(c)) < (n), bar.bar); __builtin_amdgcn_fence(__ATOMIC_ACQUIRE, "agent"); asm volatile("s_waitcnt vmcnt(0)" ::: "memory"); } __syncthreads(); } while (0)
#define PROJ_PART(first, count) do { pg8::Gemm gp_{PB + (size_t)l * M * PLE, (const bf16*)(wl + WO_PROJ), M, D, PLE}; pg8::RangeOrder Sp_; Sp_.init(M, D, G, bx); Sp_.i0 = (first); Sp_.n = (count); \
            pg8::EpiPlain Ep_{PROJ}; pg8::gemm_phase<pg8::EpiPlain, pg8::RangeOrder, true, true>(L + RING_OFF, gp_, Sp_, Ep_, wave); } while (0)
        if (IN(pb + 0))
#pragma clang loop unroll(full)
        for (int rep = 0; rep < DUPN(pb + 0); ++rep) {
            { pg8::Gemm g{XC, (const bf16*)(wl + WO_IN), M, INC, D}; pg8::StaticOrder S; S.init(M, INC, G, bx);
              pg8::EpiInProj E{ZB, ss_a, ROPE, SSL};
              pg8::gemm_phase<pg8::EpiInProj, pg8::StaticOrder, true, true>(L + RING_OFF, g, S, E, wave); }
            if (rep == 0) GROUP_SIGNAL(cntA);
        }
        gu32* const grp = ctl + CW_GRP + (l * 32 + (BXM >> 3)) * 64;
        if (IN(pb + 1))
#pragma clang loop unroll(full)
        for (int rep = 0; rep < DUPN(pb + 1); ++rep) {
            if (sub == 0) PROJ_PART(0, 2);
            GROUP_WAIT(cntA, 32u);
            if (!(DUPN(pb + 1) == 2 && rep == 0 && (PROBE_ABL & 2)) && sub != 1) mx::ret_state_phase(L, ZBm, TF, BXM, wave);
            asm volatile("s_waitcnt vmcnt(0)" ::: "memory"); __syncthreads();
            if (wave == 0 && LANE_ID() == 0 && rep == 0) {
                if (MISC[10] == 0u) { __builtin_amdgcn_fence(__ATOMIC_RELEASE, "agent"); asm volatile("s_waitcnt vmcnt(0)" ::: "memory"); }
                (void)xb_add((unsigned*)grp, 1u); }
            if (!(DUPN(pb + 1) == 2 && rep == 0 && (PROBE_ABL & 1)) && sub != 2) mx::conv_phase(L, ZBm, MIXB, ARGP(dw_w) + l * CONVW * CCH, ARGP(dw_b) + l * CCH, ARGP(ln_g) + l * CCH, ARGP(ln_b) + l * CCH, BXM, wave);
        }
        if (IN(pb + 2))
#pragma clang loop unroll(full)
        for (int rep = 0; rep < DUPN(pb + 2); ++rep) {
            if (wave == 0 && LANE_ID() == 0) { XB_SPIN(xb_ld((unsigned*)grp) < 8u, bar.bar); __builtin_amdgcn_fence(__ATOMIC_ACQUIRE, "agent"); asm volatile("s_waitcnt vmcnt(0)" ::: "memory"); }
            __syncthreads();
            if ((DUPN(pb + 2) == 2 && rep == 0) || sub != 0) mx::ret_out_phase<PROBE_ABL>(L, ZBm, MIXB, TF, ARGP(gn_g) + l * RW, ARGP(gn_b) + l * RW, BXM, wave);
            else mx::ret_out_phase<0>(L, ZBm, MIXB, TF, ARGP(gn_g) + l * RW, ARGP(gn_b) + l * RW, BXM, wave);
            if (rep == 0) GROUP_SIGNAL(cntB);
            if (sub == 0) PROJ_PART(2, 2);
            GROUP_WAIT(cntB, 32u);
        }
        if (IN(pb + 3))
#pragma clang loop unroll(full)
        for (int rep = 0; rep < 1; ++rep) {
            pg8::Gemm g{MIXB, (const bf16*)(wl + WO_OUT), M, D, D}; pg8::StaticOrder S; S.init(M, D, G, bx);
            pg8::EpiResid<0> E{XC, XC, ss_b, nullptr, nullptr, RED, SSL};
            pg8::gemm_phase<pg8::EpiResid<0>, pg8::StaticOrder, true, true>(L + RING_OFF, g, S, E, wave);
        }
        SEAM(pb + 3);
        if (IN(pb + 4))
#pragma clang loop unroll(full)
        for (int rep = 0; rep < DUPN(pb + 4); ++rep) {
            { pg8::Gemm g{XC, (const bf16*)(wl + WO_FF1), M, FF, D}; pg8::StaticOrder S; S.init(M, FF, G, bx);
              pg8::EpiFF1 E{HID, ss_b, sub, SSL};
              pg8::gemm_phase<pg8::EpiFF1, pg8::StaticOrder, true, true>(L + RING_OFF, g, S, E, wave); }
        }
        SEAM(pb + 4);
        if (IN(pb + 5))
#pragma clang loop unroll(full)
        for (int rep = 0; rep < DUPN(pb + 5); ++rep) {
            const bool dummy = (DUPN(pb + 5) == 2 && rep == 0);
            pg8::Gemm g{HID, (const bf16*)(wl + WO_FF2), M, D, FF}; pg8::StaticOrder S; S.init(M, D, G, bx);
            pg8::EpiResid<0> E{XC, dummy ? PROJ : XC, dummy ? (float*)(ws + WS_SS + (size_t)6 * SS_SITE) : ss_c, nullptr, nullptr, RED, SSL};
            pg8::gemm_phase<pg8::EpiResid<0>, pg8::StaticOrder, true, true>(L + RING_OFF, g, S, E, wave);
        }
        SEAM(pb + 5);
        if (IN(pb + 7)) {
            pg8::Gemm g{XC, (const bf16*)(wl + WO_GATE), M, D, D}; pg8::StaticOrder S; S.init(M, D, G, bx);
            pg8::EpiResid<1> E{XC, XN, ss_d, ss_c, PROJ, RED, SSL};
            pg8::gemm_phase<pg8::EpiResid<1>, pg8::StaticOrder, true, true>(L + RING_OFF, g, S, E, wave);
        }
        SEAM(pb + 7);
    }
    if (IN(17)) {
        const int lane = LANE_ID();
        const float* ssf = (const float*)(ws + WS_SS + (size_t)6 * SS_SITE);
        const bf16* XF = (DEPTH & 1) ? XO : XB;
        const GAS f32x4* gr = (const GAS f32x4*)ARGP(final_g) + 2 * lane; const f32x4 g0 = gr[0], g1 = gr[1], g2 = gr[128], g3 = gr[129];
        for (int m = gw; m < M; m += 4 * NGW) {
            f32x4 sp[4]; v4u xa[4], xb[4];
#pragma unroll
            for (int r = 0; r < 4; ++r) { const size_t mr = (size_t)(m + r * NGW); sp[r] = *(const GAS f32x4*)(ssf + mr * 4); const GAS v4u* xr = (const GAS v4u*)(XF + mr * D) + lane; xa[r] = xr[0]; xb[r] = xr[64]; }
#pragma unroll
            for (int r = 0; r < 4; ++r) { const float rs = pg8::rstd_from(sp[r]); GAS f32x4* orow = (GAS f32x4*)(a.out + (size_t)(m + r * NGW) * D) + 2 * lane;
                f32x4 a0, a1, b0, b1; pg8::unpack8(xa[r], a0, a1); pg8::unpack8(xb[r], b0, b1);
                orow[0] = a0 * rs * g0; orow[1] = a1 * rs * g1; orow[128] = b0 * rs * g2; orow[129] = b1 * rs * g3; }
        }
    }
#undef IN
#undef SEAM
}

extern "C" void kernel_launch(void* const* d_in, const int* in_sizes, int n_in, void* d_out, int out_size, void* d_ws, size_t ws_size, hipStream_t stream) {
    static int grid = 0;
    if (grid == 0) {
        if (n_in != 19 || out_size != M * D || ws_size < WS_END) { fprintf(stderr, "kernel_launch: unexpected problem (n_in %d, out %d, ws %zu < %zu); nothing launched\n", n_in, out_size, ws_size, (size_t)WS_END); grid = -1; return; }
        int dev = 0, cus = 0;
        if (hipGetDevice(&dev) != hipSuccess || hipDeviceGetAttribute(&cus, hipDeviceAttributeMultiprocessorCount, dev) != hipSuccess) { grid = -1; return; }
        if (hipFuncSetAttribute((const void*)mk_fwd, hipFuncAttributeMaxDynamicSharedMemorySize, LDS_BYTES) != hipSuccess) { fprintf(stderr, "kernel_launch: hipFuncSetAttribute failed\n"); grid = -1; return; }
        int per_cu = 0;
        if (hipOccupancyMaxActiveBlocksPerMultiprocessor(&per_cu, (const void*)mk_fwd, NWAVES * 64, LDS_BYTES) != hipSuccess || per_cu < 1) fprintf(stderr, "kernel_launch: occupancy query says %d\n", per_cu);
        (void)hipGetLastError();
        if (cus < 256) fprintf(stderr, "kernel_launch: %d CUs < 256: the grid cannot be resident\n", cus);
        grid = 256;
    }
    if (grid < 0) return;
    (void)hipMemsetAsync((char*)d_ws + WS_CTL, 0, CTL_ZERO_BYTES, stream);
    Args a{};
    a.x = (const float*)d_in[0]; a.p = (const float*)d_in[1]; a.pos = (const int*)d_in[2]; a.norm_mix_g = (const float*)d_in[3]; a.w_in = (const float*)d_in[4]; a.dw_w = (const float*)d_in[5];
    a.dw_b = (const float*)d_in[6]; a.ln_g = (const float*)d_in[7]; a.ln_b = (const float*)d_in[8]; a.gn_g = (const float*)d_in[9]; a.gn_b = (const float*)d_in[10]; a.w_out = (const float*)d_in[11];
    a.norm_ffn_g = (const float*)d_in[12]; a.w_ff1 = (const float*)d_in[13]; a.w_ff2 = (const float*)d_in[14]; a.norm_ple_g = (const float*)d_in[15]; a.w_gate = (const float*)d_in[16];
    a.w_proj = (const float*)d_in[17]; a.final_g = (const float*)d_in[18]; a.out = (float*)d_out; a.ws = (unsigned char*)d_ws;
    a.ph_lo = 0; a.ph_hi = 18; a.li = 0;
    hipLaunchKernelGGL(mk_fwd, dim3(grid), dim3(NWAVES * 64), LDS_BYTES, stream, a);
}
```
